# Optimizing an MI355X kernel written in HIP

```python
import jax, jax.numpy as jnp
from jax import lax
import numpy as np

D_MODEL = 1024
BATCH = 2
SEQ = 8192
DEPTH = 2
DEC_BATCH = 32
DEC_SEQ = 16
PAST_LEN = 1024

CHUNK = 64
N_HEADS = 16
HEAD_DIM = D_MODEL // N_HEADS
N_A_LAYERS = DEPTH // 2
N_B_LAYERS = DEPTH - N_A_LAYERS
BAND_CHUNKS = 8
BAND_PAST = BAND_CHUNKS * CHUNK
REL_CLIP = 128
N_REL = 2 * REL_CLIP + 1
D_FF = ((8 * D_MODEL // 3 + 255) // 256) * 256
Q_BLOCK = 128
EPS = 1e-6
NEG_INF = -1e30

kernel_name = "fox_yoco_chunkband_stream_step"


def rms_norm(x, g):
    xf = x.astype(jnp.float32)
    y = xf * lax.rsqrt(jnp.mean(xf * xf, axis=-1, keepdims=True) + EPS)
    return (y * g.astype(jnp.float32)).astype(x.dtype)


def swiglu(x, w_gate_up, w_down):
    gate, up = jnp.split(x @ w_gate_up, 2, axis=-1)
    return (jax.nn.silu(gate) * up) @ w_down


def split_heads(t):
    return t.reshape(t.shape[0], t.shape[1], N_HEADS, HEAD_DIM)


def merge_heads(t):
    return t.reshape(t.shape[0], t.shape[1], D_MODEL)


def fox_project(h, w_in, b_f):
    proj = h @ w_in
    q, k, v, f = jnp.split(proj, [D_MODEL, 2 * D_MODEL, 3 * D_MODEL], axis=-1)
    logf = jax.nn.log_sigmoid((f + b_f).astype(jnp.float32))
    return split_heads(q), split_heads(k), split_heads(v), logf


def fox_attention_prompt(q, k, v, logf):
    bsz, s_len = q.shape[0], q.shape[1]
    scale = HEAD_DIM ** -0.5
    cum = jnp.transpose(jnp.cumsum(logf, axis=1), (0, 2, 1))
    key_pos = jnp.arange(s_len)

    def block(i):
        start = i * Q_BLOCK
        qb = lax.dynamic_slice_in_dim(q, start, Q_BLOCK, axis=1)
        cq = lax.dynamic_slice_in_dim(cum, start, Q_BLOCK, axis=2)
        s = jnp.einsum('bqhd,bkhd->bhqk', qb, k).astype(jnp.float32) * scale
        s = s + cq[..., :, None] - cum[..., None, :]
        qpos = start + jnp.arange(Q_BLOCK)
        s = jnp.where(key_pos[None, :] <= qpos[:, None], s, NEG_INF)
        p = jax.nn.softmax(s, axis=-1).astype(v.dtype)
        return jnp.einsum('bhqk,bkhd->bqhd', p, v)

    out = lax.map(block, jnp.arange(s_len // Q_BLOCK))
    return jnp.moveaxis(out, 0, 1).reshape(bsz, s_len, N_HEADS, HEAD_DIM)


def fox_attention_sample(q, k_all, v_all, logf_all, past):
    t_len = q.shape[1]
    scale = HEAD_DIM ** -0.5
    cum = jnp.transpose(jnp.cumsum(logf_all, axis=1), (0, 2, 1))
    s = jnp.einsum('bqhd,bkhd->bhqk', q, k_all).astype(jnp.float32) * scale
    s = s + cum[..., past:, None] - cum[..., None, :]
    qpos = past + jnp.arange(t_len)
    kpos = jnp.arange(k_all.shape[1])
    s = jnp.where(kpos[None, :] <= qpos[:, None], s, NEG_INF)
    p = jax.nn.softmax(s, axis=-1).astype(v_all.dtype)
    return jnp.einsum('bhqk,bkhd->bqhd', p, v_all)


def rel_index(dist):
    return jnp.clip(dist, -REL_CLIP, REL_CLIP) + REL_CLIP


def band_attention_prompt(q, k, v, rel_bias):
    bsz, s_len = q.shape[0], q.shape[1]
    scale = HEAD_DIM ** -0.5
    band = BAND_PAST + CHUNK
    pad = ((0, 0), (BAND_PAST, 0), (0, 0), (0, 0))
    kp = jnp.pad(k, pad)
    vp = jnp.pad(v, pad)
    qi = jnp.arange(CHUNK)
    kj = jnp.arange(band)
    bias = rel_bias[:, rel_index(qi[:, None] + BAND_PAST - kj[None, :])].astype(jnp.float32)

    def chunk(c):
        qs = lax.dynamic_slice_in_dim(q, c * CHUNK, CHUNK, axis=1)
        ks = lax.dynamic_slice_in_dim(kp, c * CHUNK, band, axis=1)
        vs = lax.dynamic_slice_in_dim(vp, c * CHUNK, band, axis=1)
        s = jnp.einsum('bqhd,bkhd->bhqk', qs, ks).astype(jnp.float32) * scale + bias
        key_pos = c * CHUNK - BAND_PAST + kj
        s = jnp.where((key_pos >= 0)[None, :], s, NEG_INF)
        p = jax.nn.softmax(s, axis=-1).astype(vs.dtype)
        return jnp.einsum('bhqk,bkhd->bqhd', p, vs)

    out = lax.map(chunk, jnp.arange(s_len // CHUNK))
    return jnp.moveaxis(out, 0, 1).reshape(bsz, s_len, N_HEADS, HEAD_DIM)


def band_attention_sample(q, k_all, v_all, rel_bias, past):
    t_len, l_len = q.shape[1], k_all.shape[1]
    w_len = l_len - t_len
    scale = HEAD_DIM ** -0.5
    qpos = past + jnp.arange(t_len)
    kpos = past - w_len + jnp.arange(l_len)
    qc = qpos // CHUNK
    kc = kpos // CHUNK
    mask = (kc[None, :] <= qc[:, None]) & (kc[None, :] >= qc[:, None] - BAND_CHUNKS)
    bias = rel_bias[:, rel_index(qpos[:, None] - kpos[None, :])].astype(jnp.float32)
    s = jnp.einsum('bqhd,bkhd->bhqk', q, k_all).astype(jnp.float32) * scale + bias
    s = jnp.where(mask, s, NEG_INF)
    p = jax.nn.softmax(s, axis=-1).astype(v_all.dtype)
    return jnp.einsum('bhqk,bkhd->bqhd', p, v_all)


def shared_kv(h, g_kv, w_kv):
    kb, vb = jnp.split(rms_norm(h, g_kv) @ w_kv, 2, axis=-1)
    return split_heads(kb), split_heads(vb)


def setup_inputs(seed: int = 0) -> dict:
    key = jax.random.key(seed)
    ks = jax.random.split(key, 24)
    f32 = jnp.float32
    d_in = D_MODEL ** -0.5
    b_len = min(BAND_PAST, PAST_LEN)
    nrm = lambda k, shape, s: jax.random.normal(k, shape, f32) * s
    return {
        "x_prompt": nrm(ks[0], (BATCH, SEQ, D_MODEL), 1.0),
        "x_sample": nrm(ks[1], (DEC_BATCH, DEC_SEQ, D_MODEL), 1.0),
        "cache_a_k": nrm(ks[2], (N_A_LAYERS, DEC_BATCH, PAST_LEN, N_HEADS, HEAD_DIM), 1.0),
        "cache_a_v": nrm(ks[3], (N_A_LAYERS, DEC_BATCH, PAST_LEN, N_HEADS, HEAD_DIM), 1.0),
        "cache_a_logf": jax.nn.log_sigmoid(3.0 + nrm(ks[4], (N_A_LAYERS, DEC_BATCH, PAST_LEN, N_HEADS), 1.0)),
        "cache_b_k": nrm(ks[5], (DEC_BATCH, b_len, N_HEADS, HEAD_DIM), 1.0),
        "cache_b_v": nrm(ks[6], (DEC_BATCH, b_len, N_HEADS, HEAD_DIM), 1.0),
        "g_attn": 1.0 + nrm(ks[7], (DEPTH, D_MODEL), 0.02),
        "w_a_in": nrm(ks[8], (N_A_LAYERS, D_MODEL, 3 * D_MODEL + N_HEADS), d_in),
        "b_a_f": 3.0 + nrm(ks[9], (N_A_LAYERS, N_HEADS), 0.5),
        "w_a_out": nrm(ks[10], (N_A_LAYERS, D_MODEL, D_MODEL), d_in),
        "w_b_q": nrm(ks[11], (N_B_LAYERS, D_MODEL, D_MODEL), d_in),
        "rel_bias": nrm(ks[12], (N_B_LAYERS, N_HEADS, N_REL), 0.5),
        "w_b_out": nrm(ks[13], (N_B_LAYERS, D_MODEL, D_MODEL), d_in),
        "g_kv": 1.0 + nrm(ks[14], (D_MODEL,), 0.02),
        "w_kv": nrm(ks[15], (D_MODEL, 2 * D_MODEL), d_in),
        "g_ffn": 1.0 + nrm(ks[16], (DEPTH, D_MODEL), 0.02),
        "w_gate_up": nrm(ks[17], (DEPTH, D_MODEL, 2 * D_FF), d_in),
        "w_down": nrm(ks[18], (DEPTH, D_FF, D_MODEL), D_FF ** -0.5),
        "g_final": 1.0 + nrm(ks[19], (D_MODEL,), 0.02),
    }


def reference(x_prompt, x_sample, cache_a_k, cache_a_v, cache_a_logf, cache_b_k, cache_b_v,
              g_attn, w_a_in, b_a_f, w_a_out, w_b_q, rel_bias, w_b_out, g_kv, w_kv,
              g_ffn, w_gate_up, w_down, g_final):
    past = cache_a_k.shape[2]

    h = x_prompt
    ak_p, av_p, alf_p = [], [], []
    kb_p = vb_p = None
    for l in range(DEPTH):
        if l < N_A_LAYERS:
            q, k, v, lf = fox_project(rms_norm(h, g_attn[l]), w_a_in[l], b_a_f[l])
            h = h + merge_heads(fox_attention_prompt(q, k, v, lf)) @ w_a_out[l]
            ak_p.append(k); av_p.append(v); alf_p.append(lf)
        else:
            j = l - N_A_LAYERS
            if j == 0:
                kb_p, vb_p = shared_kv(h, g_kv, w_kv)
            q = split_heads(rms_norm(h, g_attn[l]) @ w_b_q[j])
            h = h + merge_heads(band_attention_prompt(q, kb_p, vb_p, rel_bias[j])) @ w_b_out[j]
        h = h + swiglu(rms_norm(h, g_ffn[l]), w_gate_up[l], w_down[l])
    y_prompt = rms_norm(h, g_final)
    keep_p = min(BAND_PAST, kb_p.shape[1])
    new_b_k_p = kb_p[:, kb_p.shape[1] - keep_p:]
    new_b_v_p = vb_p[:, vb_p.shape[1] - keep_p:]

    h = x_sample
    ak_s, av_s, alf_s = [], [], []
    kb_all = vb_all = None
    for l in range(DEPTH):
        if l < N_A_LAYERS:
            q, k, v, lf = fox_project(rms_norm(h, g_attn[l]), w_a_in[l], b_a_f[l])
            k_all = jnp.concatenate([cache_a_k[l].astype(k.dtype), k], axis=1)
            v_all = jnp.concatenate([cache_a_v[l].astype(v.dtype), v], axis=1)
            lf_all = jnp.concatenate([cache_a_logf[l].astype(jnp.float32), lf], axis=1)
            h = h + merge_heads(fox_attention_sample(q, k_all, v_all, lf_all, past)) @ w_a_out[l]
            ak_s.append(k); av_s.append(v); alf_s.append(lf)
        else:
            j = l - N_A_LAYERS
            if j == 0:
                kb_new, vb_new = shared_kv(h, g_kv, w_kv)
                kb_all = jnp.concatenate([cache_b_k.astype(kb_new.dtype), kb_new], axis=1)
                vb_all = jnp.concatenate([cache_b_v.astype(vb_new.dtype), vb_new], axis=1)
            q = split_heads(rms_norm(h, g_attn[l]) @ w_b_q[j])
            h = h + merge_heads(band_attention_sample(q, kb_all, vb_all, rel_bias[j], past)) @ w_b_out[j]
        h = h + swiglu(rms_norm(h, g_ffn[l]), w_gate_up[l], w_down[l])
    y_sample = rms_norm(h, g_final)
    keep_s = cache_b_k.shape[1]
    new_b_k_s = kb_all[:, kb_all.shape[1] - keep_s:]
    new_b_v_s = vb_all[:, vb_all.shape[1] - keep_s:]

    return (y_prompt, y_sample,
            jnp.stack(ak_p, 0), jnp.stack(av_p, 0), jnp.stack(alf_p, 0), new_b_k_p, new_b_v_p,
            jnp.stack(ak_s, 0), jnp.stack(av_s, 0), jnp.stack(alf_s, 0), new_b_k_s, new_b_v_s)
```

```cpp
#include <hip/hip_cooperative_groups.h>
#include <hip/hip_runtime.h>
#include <cstdio>
#include <cstdint>
namespace pg8 {
#define PG8_LAS __attribute__((address_space(3)))
typedef unsigned short bf16_t;
typedef short bf16x8 __attribute__((ext_vector_type(8)));
typedef float f32x4 __attribute__((ext_vector_type(4)));
typedef unsigned u32x4 __attribute__((ext_vector_type(4)));
constexpr int BM = 256, BK = 64, HALF = 128, HTB = HALF * BK * 2  , STAGE_BYTES = 8 * HTB, NXCD = 8, WGM = 8;

__host__ __device__ __forceinline__ int lds_byte(int r, int c) { const int st = (r >> 4) * 2 + (c >> 5), rr = r & 15, cc = c & 31, ob = rr * 64 + cc * 2; return st * 1024 + (ob ^ (((ob >> 9) & 1) << 5)); }
__host__ __device__ __forceinline__ void stage_rc(int b, int& R, int& C) { const int st = b / 1024, sb = b % 1024, swz = sb ^ (((sb >> 9) & 1) << 5); R = (st >> 1) * 16 + swz / 64; C = (st & 1) * 32 + (swz % 64) / 2; }
__host__ __device__ __forceinline__ int perm32(int rho) { const int n = rho >> 4, i = rho & 15; return 8 * (i >> 2) + 4 * n + (i & 3); }

struct Unit { int pm, pn; };
struct Gemm { const bf16_t* A; const bf16_t* Bt; int M, N, K; };

struct StaticOrder {
    int nM, nN, nwg, G, c;
    __host__ __device__ void init(int M, int N, int G_, int c_) { nM = M / BM; nN = N / BM; nwg = nM * nN; G = G_; c = c_; }
    __host__ __device__ bool next(int i, Unit& u) const {
        const long L = (long)i * G + c; if (L >= nwg) return false;
        int wgid = (int)L; { const int q = nwg / NXCD, r = nwg % NXCD, xcd = wgid % NXCD, off = wgid / NXCD; wgid = (xcd < r ? xcd * (q + 1) : r * (q + 1) + (xcd - r) * q) + off; }
        const int nig = WGM * nN, gid = wgid / nig, fm = gid * WGM, gsz = (nM - fm) < WGM ? (nM - fm) : WGM;
        u.pm = fm + ((wgid % nig) % gsz); u.pn = (wgid % nig) / gsz; return true;
    }
    __device__ __forceinline__ void a_ready(const Unit&) const {}
    __device__ __forceinline__ void done(const Unit&) const {}
};

__device__ __forceinline__ unsigned cvt_pk_bf16(float lo, float hi) { unsigned r; asm volatile("v_cvt_pk_bf16_f32 %0, %1, %2" : "=v"(r) : "v"(lo), "v"(hi)); return r; }
constexpr int MP_ROWS = 16384;
constexpr float RMS_EPS = 1e-6f;
__device__ __forceinline__ void row_rstd(float (&rs)[2][4], const float* ssp, int row0, int fq) {
#pragma unroll
    for (int ai = 0; ai < 2; ++ai)
#pragma unroll
        for (int m = 0; m < 4; ++m) { const f32x4 p = *(const f32x4*)(ssp + (size_t)(row0 + ai * HALF + m * 16) * 16 + 4 * fq);
            float s = (p[0] + p[1]) + (p[2] + p[3]); s += __shfl_xor(s, 16); s += __shfl_xor(s, 32);
            rs[ai][m] = 1.0f / sqrtf(s * (1.0f / 1024.0f) + RMS_EPS); }
}
struct EpiQKV {
    static constexpr bool PERM = true, AFTER_DRAIN = false;
    bf16_t *Qb, *Kb, *Vb; float *kp, *vp, *ks, *vs; const float* ssp; int layer; float qscale;
    __device__ __forceinline__ long frow(int row) const {
        if (layer == 0) return row < MP_ROWS ? (long)row * 1024 : (long)(row - MP_ROWS) * 1024;
        if (row < MP_ROWS) { const int t = row & 8191, b = row >> 13; return t >= 7680 ? (long)(b * 512 + t - 7680) * 1024 : -1; }
        const int sr = row - MP_ROWS; return (long)((sr >> 4) * 512 + 496 + (sr & 15)) * 1024;
    }
    __device__ __forceinline__ void operator()(const f32x4 (&acc)[2][2][4][2], const Unit& u, int wr, int wc, int fr, int fq) const {
        const int t = u.pn >> 2, colt = (u.pn & 3) * BM, row0 = u.pm * BM + wr * 64 + fr, col0 = colt + wc * 32 + 8 * fq;
        float rs[2][4]; row_rstd(rs, ssp, row0, fq);
        bf16_t* const qb_ = Qb; bf16_t* const kb_ = Kb; bf16_t* const vb_ = Vb; float* const kp_ = kp; float* const vp_ = vp; float* const ks_ = ks; float* const vs_ = vs;
        bf16_t* B = t == 0 ? qb_ : (t == 1 ? kb_ : vb_); const float sc = t == 0 ? qscale : 1.f;
        const bool prow = u.pm < 64;
        float* fb = t == 1 ? (prow ? kp_ : ks_) : (prow ? vp_ : vs_);
        const bool anyf = t > 0 && (layer == 0 || !prow || (u.pm & 31) >= 30);
#pragma unroll
        for (int ai = 0; ai < 2; ++ai)
#pragma unroll
            for (int m = 0; m < 4; ++m) { const int row = row0 + ai * HALF + m * 16; const float r = rs[ai][m];
                const long fo = anyf ? frow(row) : -1;
#pragma unroll
                for (int bj = 0; bj < 2; ++bj) { f32x4 v0 = acc[ai][bj][m][0] * r, v1 = acc[ai][bj][m][1] * r;
                    if (fo >= 0) { float* fp = fb + fo + col0 + bj * HALF; *(f32x4*)fp = v0; *(f32x4*)(fp + 4) = v1; }
                    v0 = v0 * sc; v1 = v1 * sc; u32x4 w; w.x = cvt_pk_bf16(v0[0], v0[1]); w.y = cvt_pk_bf16(v0[2], v0[3]); w.z = cvt_pk_bf16(v1[0], v1[1]); w.w = cvt_pk_bf16(v1[2], v1[3]);
                    *(u32x4*)(B + (size_t)row * 1024 + col0 + bj * HALF) = w; } }
    }
};
struct EpiRes {
    static constexpr bool PERM = true, AFTER_DRAIN = false;
    const float *base_p, *base_s; float* H; bf16_t* HB; float* ssp;
    __device__ __forceinline__ void operator()(const f32x4 (&acc)[2][2][4][2], const Unit& u, int wr, int wc, int fr, int fq) const {
        const int col0 = u.pn * BM + wc * 32 + 8 * fq, rl0 = wr * 64 + fr;
        const float* base = u.pm < 64 ? base_p + (size_t)u.pm * BM * 1024 : base_s + (size_t)(u.pm - 64) * BM * 1024;
#pragma unroll
        for (int ai = 0; ai < 2; ++ai)
#pragma unroll
            for (int m = 0; m < 4; ++m) { const int rl = rl0 + ai * HALF + m * 16; const size_t row = (size_t)u.pm * BM + rl; float ss = 0.f;
#pragma unroll
                for (int bj = 0; bj < 2; ++bj) { const float* bp = base + (size_t)rl * 1024 + col0 + bj * HALF;
                    const f32x4 v0 = acc[ai][bj][m][0] + *(const f32x4*)bp, v1 = acc[ai][bj][m][1] + *(const f32x4*)(bp + 4);
                    ss += (v0[0] * v0[0] + v0[1] * v0[1]) + (v0[2] * v0[2] + v0[3] * v0[3]) + (v1[0] * v1[0] + v1[1] * v1[1]) + (v1[2] * v1[2] + v1[3] * v1[3]);
                    float* hp = H + row * 1024 + col0 + bj * HALF; *(f32x4*)hp = v0; *(f32x4*)(hp + 4) = v1;
                    u32x4 w; w.x = cvt_pk_bf16(v0[0], v0[1]); w.y = cvt_pk_bf16(v0[2], v0[3]); w.z = cvt_pk_bf16(v1[0], v1[1]); w.w = cvt_pk_bf16(v1[2], v1[3]);
                    *(u32x4*)(HB + row * 1024 + col0 + bj * HALF) = w; }
                ss += __shfl_xor(ss, 16); ss += __shfl_xor(ss, 32);
                if (fq == 0) ssp[row * 16 + u.pn * 4 + wc] = ss;
                if (m & 1) asm volatile("" ::: "memory"); }
    }
};
struct EpiSwiGLU {
    static constexpr bool PERM = true, AFTER_DRAIN = false;
    bf16_t* ACT; const float* ssp;
    __device__ __forceinline__ void operator()(const f32x4 (&acc)[2][2][4][2], const Unit& u, int wr, int wc, int fr, int fq) const {
        const int row0 = u.pm * BM + wr * 64 + fr, col0 = u.pn * HALF + wc * 32 + 8 * fq;
        float rs[2][4]; row_rstd(rs, ssp, row0, fq);
#pragma unroll
        for (int ai = 0; ai < 2; ++ai)
#pragma unroll
            for (int m = 0; m < 4; ++m) { const int row = row0 + ai * HALF + m * 16; const float r = rs[ai][m]; float o[8];
#pragma unroll
                for (int n = 0; n < 2; ++n)
#pragma unroll
                    for (int e = 0; e < 4; ++e) { const float g = acc[ai][0][m][n][e] * r, up = acc[ai][1][m][n][e] * r;
                        o[n * 4 + e] = g * __builtin_amdgcn_rcpf(1.0f + __builtin_amdgcn_exp2f(g * -1.4426950408889634f)) * up; }
                u32x4 w; w.x = cvt_pk_bf16(o[0], o[1]); w.y = cvt_pk_bf16(o[2], o[3]); w.z = cvt_pk_bf16(o[4], o[5]); w.w = cvt_pk_bf16(o[6], o[7]);
                *(u32x4*)(ACT + (size_t)row * 2816 + col0) = w; }
    }
};

template <class Epi, class Sched, bool ALIGN_EPI = false, bool SP2 = false>
__device__ __forceinline__ void gemm_phase(PG8_LAS unsigned char* lds, const Gemm g, const Sched& S, const Epi& E) {
    int tid_ = threadIdx.x; asm volatile("" : "+v"(tid_));
    const int tid = tid_, wid = __builtin_amdgcn_readfirstlane(tid >> 6), lane = tid & 63, wr = wid >> 2, wc = wid & 3, fr = lane & 15, fq = lane >> 4;
    const int K = g.K, nt = K / BK;
    unsigned voffA[2], voffB[2];
#pragma unroll
    for (int i = 0; i < 2; ++i) { int R, C; stage_rc(tid * 16 + i * 8192, R, C); const int Rb = Epi::PERM ? ((R & ~31) + perm32(R & 31)) : R;
        voffA[i] = (unsigned)(R * K + C) * 2u; voffB[i] = (unsigned)(Rb * K + C) * 2u; }
    const size_t kstep = (size_t)(BK * 2);
    const size_t hstep = (size_t)HALF * K * 2;
    const size_t tstep = 2 * hstep;
    const unsigned ldsw = (unsigned)wid * 1024u;
    const int aoff = lds_byte(wr * 64 + fr, fq * 8), boff = lds_byte(wc * 32 + fr, fq * 8);
#define PG8_SA(b, h) (((b) * 2 + (h)) * HTB)
#define PG8_SB(b, h) ((4 + (b) * 2 + (h)) * HTB)
#define PG8_STAGE(bufoff, gbase, voff) do { _Pragma("unroll") for (int _i = 0; _i < 2; ++_i) \
        __builtin_amdgcn_global_load_lds((const unsigned*)((const char*)(gbase) + (voff)[_i]), (PG8_LAS unsigned*)(lds + (bufoff) + ldsw + _i * 8192), 16, 0, 0); } while (0)
#define PG8_LDA(dst, b, h) do { _Pragma("unroll") for (int m = 0; m < 4; ++m) _Pragma("unroll") for (int k = 0; k < 2; ++k) dst[m][k] = *(const PG8_LAS bf16x8*)(lds + PG8_SA(b, h) + aoff + m * 2048 + k * 1024); } while (0)
#define PG8_LDB(dst, b, h) do { _Pragma("unroll") for (int n = 0; n < 2; ++n) _Pragma("unroll") for (int k = 0; k < 2; ++k) dst[n][k] = *(const PG8_LAS bf16x8*)(lds + PG8_SB(b, h) + boff + n * 2048 + k * 1024); } while (0)
#define PG8_MMA(ai, bj, At, Bt) do { __builtin_amdgcn_s_setprio(1); _Pragma("unroll") for (int m = 0; m < 4; ++m) _Pragma("unroll") for (int n = 0; n < 2; ++n) _Pragma("unroll") for (int k = 0; k < 2; ++k) \
        acc[ai][bj][m][n] = __builtin_amdgcn_mfma_f32_16x16x32_bf16(Bt[n][k], At[m][k], acc[ai][bj][m][n], 0, 0, 0); __builtin_amdgcn_s_setprio(0); } while (0)
#define PG8_WAIT_V(n) asm volatile("s_waitcnt vmcnt(" #n ")" ::: "memory")
#define PG8_WAIT_L(n) asm volatile("s_waitcnt lgkmcnt(" #n ")" ::: "memory")
#define PG8_BAR __builtin_amdgcn_s_barrier()
#define PG8_SCHED __builtin_amdgcn_sched_barrier(0)
    Unit cur, nxt; int ui = 0;
    if (!S.next(0, cur)) return;
    f32x4 acc[2][2][4][2];
#pragma unroll
    for (int a = 0; a < 2; ++a)
#pragma unroll
        for (int b = 0; b < 2; ++b)
#pragma unroll
            for (int m = 0; m < 4; ++m)
#pragma unroll
                for (int n = 0; n < 2; ++n) acc[a][b][m][n] = (f32x4){0.f, 0.f, 0.f, 0.f};
    bf16x8 At[4][2], B0[2][2], B1[2][2];
    const char* cA = (const char*)g.A + (size_t)cur.pm * tstep; const char* cB = (const char*)g.Bt + (size_t)cur.pn * tstep;
    S.a_ready(cur);
    if constexpr (SP2) {
        PG8_STAGE(PG8_SB(0, 0), cB, voffB); PG8_STAGE(PG8_SB(0, 1), cB + hstep, voffB); PG8_STAGE(PG8_SA(0, 0), cA, voffA); PG8_STAGE(PG8_SA(0, 1), cA + hstep, voffA);
        if (wr == 1) PG8_BAR;
        PG8_WAIT_V(2); PG8_BAR;
        PG8_STAGE(PG8_SB(1, 0), cB + kstep, voffB); PG8_STAGE(PG8_SA(1, 0), cA + kstep, voffA); PG8_STAGE(PG8_SB(1, 1), cB + hstep + kstep, voffB);
        PG8_WAIT_V(6); PG8_BAR;
    } else {
        PG8_STAGE(PG8_SB(0, 0), cB, voffB); PG8_STAGE(PG8_SA(0, 0), cA, voffA); PG8_STAGE(PG8_SB(0, 1), cB + hstep, voffB); PG8_STAGE(PG8_SA(0, 1), cA + hstep, voffA);
        if (wr == 1) PG8_BAR;
        PG8_WAIT_V(4); PG8_BAR;
        PG8_STAGE(PG8_SB(1, 0), cB + kstep, voffB); PG8_STAGE(PG8_SA(1, 0), cA + kstep, voffA); PG8_STAGE(PG8_SB(1, 1), cB + hstep + kstep, voffB);
        PG8_WAIT_V(6); PG8_BAR;
    }
    for (;;) {
        const bool has_next = S.next(ui + 1, nxt);
        const char* nA = has_next ? (const char*)g.A + (size_t)nxt.pm * tstep : cA; const char* nB = has_next ? (const char*)g.Bt + (size_t)nxt.pn * tstep : cB;
        for (int t = 0; t < nt; t += 2) {
            const bool last = (t == nt - 2);
            const char* a1 = cA + (size_t)(t + 1) * kstep;
            const char* a2 = last ? nA : cA + (size_t)(t + 2) * kstep; const char* b2 = last ? nB : cB + (size_t)(t + 2) * kstep;
            const char* a3 = a2 + kstep; const char* b3 = b2 + kstep;
            if (last && has_next) S.a_ready(nxt);
            if constexpr (SP2) {
            PG8_LDB(B0, 0, 0); PG8_LDB(B1, 0, 1); PG8_SCHED; PG8_LDA(At, 0, 0); PG8_STAGE(PG8_SA(1, 1), a1 + hstep, voffA);
            PG8_WAIT_V(8); PG8_WAIT_L(0); PG8_BAR; PG8_MMA(0, 0, At, B0); PG8_MMA(0, 1, At, B1); PG8_BAR; PG8_SCHED;
            PG8_LDA(At, 0, 1); PG8_STAGE(PG8_SB(0, 0), b2, voffB); PG8_STAGE(PG8_SB(0, 1), b2 + hstep, voffB); PG8_STAGE(PG8_SA(0, 0), a2, voffA);
            PG8_WAIT_V(8); PG8_WAIT_L(0); PG8_BAR; PG8_MMA(1, 0, At, B0); PG8_MMA(1, 1, At, B1); PG8_BAR; PG8_SCHED;
            PG8_LDB(B0, 1, 0); PG8_LDB(B1, 1, 1); PG8_SCHED; PG8_LDA(At, 1, 0); PG8_STAGE(PG8_SA(0, 1), a2 + hstep, voffA);
            PG8_WAIT_V(8); PG8_WAIT_L(0); PG8_BAR; PG8_MMA(0, 0, At, B0); PG8_MMA(0, 1, At, B1); PG8_BAR; PG8_SCHED;
            PG8_LDA(At, 1, 1); PG8_STAGE(PG8_SB(1, 0), b3, voffB); PG8_STAGE(PG8_SB(1, 1), b3 + hstep, voffB); PG8_STAGE(PG8_SA(1, 0), a3, voffA);
            PG8_WAIT_V(8); PG8_WAIT_L(0); PG8_BAR; PG8_MMA(1, 0, At, B0); PG8_MMA(1, 1, At, B1); PG8_BAR; PG8_SCHED;
            } else {
            PG8_LDB(B0, 0, 0); PG8_SCHED; PG8_LDA(At, 0, 0); PG8_STAGE(PG8_SA(1, 1), a1 + hstep, voffA);
            PG8_WAIT_L(8); PG8_BAR; PG8_WAIT_L(0); PG8_MMA(0, 0, At, B0); PG8_BAR; PG8_SCHED;
            PG8_LDB(B1, 0, 1); PG8_STAGE(PG8_SB(0, 0), b2, voffB);
            PG8_BAR; PG8_WAIT_L(0); PG8_MMA(0, 1, At, B1); PG8_BAR;
            PG8_LDA(At, 0, 1); PG8_STAGE(PG8_SA(0, 0), a2, voffA);
            PG8_BAR; PG8_WAIT_L(0); PG8_MMA(1, 0, At, B0); PG8_BAR; PG8_SCHED;
            PG8_STAGE(PG8_SB(0, 1), b2 + hstep, voffB);
            PG8_WAIT_V(6); PG8_BAR; PG8_MMA(1, 1, At, B1); PG8_BAR;
            PG8_LDB(B0, 1, 0); PG8_SCHED; PG8_LDA(At, 1, 0); PG8_STAGE(PG8_SA(0, 1), a2 + hstep, voffA);
            PG8_WAIT_L(8); PG8_BAR; PG8_WAIT_L(0); PG8_MMA(0, 0, At, B0); PG8_BAR; PG8_SCHED;
            PG8_LDB(B1, 1, 1); PG8_STAGE(PG8_SB(1, 0), b3, voffB);
            PG8_BAR; PG8_WAIT_L(0); PG8_MMA(0, 1, At, B1); PG8_BAR;
            PG8_LDA(At, 1, 1); PG8_STAGE(PG8_SA(1, 0), a3, voffA);
            PG8_BAR; PG8_WAIT_L(0); PG8_MMA(1, 0, At, B0); PG8_BAR; PG8_SCHED;
            PG8_STAGE(PG8_SB(1, 1), b3 + hstep, voffB);
            PG8_WAIT_V(6); PG8_BAR; PG8_MMA(1, 1, At, B1); PG8_BAR;
            }
        }
        if constexpr (ALIGN_EPI) { if (wr == 0) PG8_BAR; }
        if constexpr (!Epi::AFTER_DRAIN) { E(acc, cur, wr, wc, fr, fq); S.done(cur); }
        if (!has_next) break;
#pragma unroll
        for (int a = 0; a < 2; ++a)
#pragma unroll
            for (int b = 0; b < 2; ++b)
#pragma unroll
                for (int m = 0; m < 4; ++m)
#pragma unroll
                    for (int n = 0; n < 2; ++n) acc[a][b][m][n] = (f32x4){0.f, 0.f, 0.f, 0.f};
        cur = nxt; cA = nA; cB = nB; ++ui;
        if constexpr (ALIGN_EPI) { if (wr == 1) PG8_BAR; }
    }
    PG8_WAIT_V(0);
    if constexpr (!ALIGN_EPI) { if (wr == 0) PG8_BAR; }
    PG8_BAR;
    if constexpr (Epi::AFTER_DRAIN) { E.fused(acc, cur, wr, wc, fr, fq, lds, wid, lane); S.done(cur); }
#undef PG8_SA
#undef PG8_SB
#undef PG8_STAGE
#undef PG8_LDA
#undef PG8_LDB
#undef PG8_MMA
#undef PG8_WAIT_V
#undef PG8_WAIT_L
#undef PG8_BAR
#undef PG8_SCHED
}
}

#ifndef PG8_SP2
#define PG8_SP2 true
#endif
#ifndef PG8_ALIGN
#define PG8_ALIGN true
#endif
#include <hip/hip_bf16.h>
#include <cmath>
namespace attn_body {
using bf16=__hip_bfloat16;
using bf16x8=__attribute__((ext_vector_type(8)))short;
using s16x4=__attribute__((ext_vector_type(4)))short;
using f32x16=__attribute__((ext_vector_type(16)))float;
using u32x4=__attribute__((ext_vector_type(4)))unsigned;
constexpr int BATCH=2,NHEAD=16,SEQ=8192,D=64,DM=NHEAD*D;
constexpr int NW=8,QBLK=32,QB=QBLK*NW,KVBLK=64,NQB=SEQ/QB;
constexpr int ATTN_PITCH=DM, ATTN_UNIT_ROWS=QB;
__device__ __forceinline__ int crow(int r,int hi){return (r&3)+8*(r>>2)+4*hi;}
#define SBAR() __builtin_amdgcn_sched_barrier(0)
__device__ __forceinline__ void cmask(f32x16&p0,f32x16&p1,int jb,int qrel,int hi){
  const float NEG=-INFINITY; int kb=64*jb+4*hi;
  #pragma unroll
  for(int r=0;r<16;++r){int kv=kb+(r&3)+8*(r>>2); if(kv>qrel)p0[r]=NEG; if(kv+32>qrel)p1[r]=NEG;}
}

constexpr int NSLOT=3, SLOTB=8192;
constexpr int LDS_K=0, LDS_V=NSLOT*SLOTB, LDS_WS=2*NSLOT*SLOTB, LDS_OST=LDS_WS+NW*64*4, LDS_X=LDS_OST+NW*4096, LDS_BT=LDS_X+NSLOT*2048, LDS_BYTES=LDS_BT+2048;
constexpr float C2=0.125f*1.4426950408889634f;
__device__ __forceinline__ void glds16(const void*gsrc,unsigned lds_dst){unsigned keep;
  asm volatile("s_mov_b32 %0, m0\n\ts_mov_b32 m0, %2\n\ts_nop 0\n\tglobal_load_lds_dwordx4 %1, off\n\ts_mov_b32 m0, %0":"=&s"(keep):"v"(gsrc),"s"(lds_dst):"memory");}
__device__ __forceinline__ void glds16s(const void*sbase,unsigned voff,unsigned lds_dst){unsigned keep;
  asm volatile("s_mov_b32 %0, m0\n\ts_mov_b32 m0, %3\n\ts_nop 0\n\tglobal_load_lds_dwordx4 %1, %2\n\ts_mov_b32 m0, %0":"=&s"(keep):"v"(voff),"s"(sbase),"s"(lds_dst):"memory");}
__device__ __forceinline__ void glds4s(const void*sbase,unsigned voff,unsigned lds_dst){unsigned keep;
  asm volatile("s_mov_b32 %0, m0\n\ts_mov_b32 m0, %3\n\ts_nop 0\n\tglobal_load_lds_dword %1, %2\n\ts_mov_b32 m0, %0":"=&s"(keep):"v"(voff),"s"(sbase),"s"(lds_dst):"memory");}
__device__ __forceinline__ void glds4(const void*gsrc,unsigned lds_dst){unsigned keep;
  asm volatile("s_mov_b32 %0, m0\n\ts_mov_b32 m0, %2\n\ts_nop 0\n\tglobal_load_lds_dword %1, off\n\ts_mov_b32 m0, %0":"=&s"(keep):"v"(gsrc),"s"(lds_dst):"memory");}
__device__ __forceinline__ float max3f(float a,float b,float c){float r;asm("v_max3_f32 %0, %1, %2, %3":"=v"(r):"v"(a),"v"(b),"v"(c));return r;}
__device__ __forceinline__ float max2f(float a,float b){float r;asm("v_max_f32_e32 %0, %1, %2":"=v"(r):"v"(a),"v"(b));return r;}
__device__ __forceinline__ float fadd_s(float a,float b){float r;asm("v_add_f32_e32 %0, %1, %2":"=v"(r):"v"(a),"v"(b));return r;}
__device__ __forceinline__ float fsub_s(float a,float b){float r;asm("v_sub_f32_e32 %0, %1, %2":"=v"(r):"v"(a),"v"(b));return r;}
typedef float f32x2_t __attribute__((ext_vector_type(2))); typedef __bf16 bf16x2_t __attribute__((ext_vector_type(2)));
__device__ __forceinline__ unsigned cvtpk_s(float lo,float hi){f32x2_t v={lo,hi};bf16x2_t b=__builtin_convertvector(v,bf16x2_t);return __builtin_bit_cast(unsigned,b);}
#define WAIT_BAR(N) asm volatile("s_waitcnt vmcnt(" #N ") lgkmcnt(0)\n\ts_barrier":::"memory")

__device__ __forceinline__ void qkt(f32x16&p0,f32x16&p1,const char*Kslot,const bf16x8*qr,bf16x8 kx0,bf16x8 kx1,bf16x8 qe,int r32,int hi){
  const char*kb=Kslot+hi*1024+r32*16;
  #pragma unroll
  for(int d0=0;d0<4;++d0){
    const bf16x8 b0=*reinterpret_cast<const bf16x8*>(kb+d0*2048);
    const bf16x8 b1=*reinterpret_cast<const bf16x8*>(kb+d0*2048+512);
    if(d0==0){const f32x16 z=f32x16{};p0=__builtin_amdgcn_mfma_f32_32x32x16_bf16(kx0,qe,z,0,0,0);p1=__builtin_amdgcn_mfma_f32_32x32x16_bf16(kx1,qe,z,0,0,0);}
    {p0=__builtin_amdgcn_mfma_f32_32x32x16_bf16(b0,qr[d0],p0,0,0,0);p1=__builtin_amdgcn_mfma_f32_32x32x16_bf16(b1,qr[d0],p1,0,0,0);}}
}
typedef __attribute__((address_space(3))) const char* lds_cptr;
typedef short v4i16_t __attribute__((ext_vector_type(4)));
__device__ __forceinline__ void kload8(bf16x8*kf,lds_cptr kp){
  kf[0]=*(const __attribute__((address_space(3))) bf16x8*)(kp);      kf[1]=*(const __attribute__((address_space(3))) bf16x8*)(kp+512);
  kf[2]=*(const __attribute__((address_space(3))) bf16x8*)(kp+2048); kf[3]=*(const __attribute__((address_space(3))) bf16x8*)(kp+2560);
  kf[4]=*(const __attribute__((address_space(3))) bf16x8*)(kp+4096); kf[5]=*(const __attribute__((address_space(3))) bf16x8*)(kp+4608);
  kf[6]=*(const __attribute__((address_space(3))) bf16x8*)(kp+6144); kf[7]=*(const __attribute__((address_space(3))) bf16x8*)(kp+6656);
}
__device__ __forceinline__ void kload2(bf16x8*kf,lds_cptr kp,int j){ kf[2*j]=*(const __attribute__((address_space(3))) bf16x8*)(kp+j*2048); kf[2*j+1]=*(const __attribute__((address_space(3))) bf16x8*)(kp+j*2048+512); }
__device__ __forceinline__ s16x4 vtr(lds_cptr p){ return __builtin_bit_cast(s16x4,__builtin_amdgcn_ds_read_tr16_b64_v4i16((__attribute__((address_space(3))) v4i16_t*)p)); }
__device__ __forceinline__ float rowmax(const f32x16&p0,const f32x16&p1){
  float a=max3f(p0[0],p0[1],p1[0]),b=max3f(p0[2],p0[3],p1[1]);a=max3f(a,p1[2],p1[3]);
  #pragma unroll
  for(int r=4;r<16;r+=4){a=max3f(a,p0[r],p0[r+1]);b=max3f(b,p0[r+2],p0[r+3]);a=max3f(a,p1[r],p1[r+1]);b=max3f(b,p1[r+2],p1[r+3]);}
  const float m=max2f(a,b);
  auto rr=__builtin_amdgcn_permlane32_swap(__float_as_uint(m),__float_as_uint(m),false,false);
  return max2f(__uint_as_float(rr[0]),__uint_as_float(rr[1]));
}
__device__ __forceinline__ void pv(f32x16*o,int vb,bf16x8 pa0,bf16x8 pa1,bf16x8 pa2,bf16x8 pa3){
  #pragma unroll
  for(int d0=0;d0<2;++d0){s16x4 lo[4],hi[4];
    #pragma unroll
    for(int ks=0;ks<4;++ks){
      asm volatile("ds_read_b64_tr_b16 %0,%1 offset:%c2":"=&v"(lo[ks]):"v"(vb),"i"(d0*4096+ks*1024):"memory");
      asm volatile("ds_read_b64_tr_b16 %0,%1 offset:%c2":"=&v"(hi[ks]):"v"(vb),"i"(d0*4096+ks*1024+512):"memory");}
    asm volatile("s_waitcnt lgkmcnt(0)":::"memory");SBAR();
    #define PK(k) (bf16x8){lo[k][0],lo[k][1],lo[k][2],lo[k][3],hi[k][0],hi[k][1],hi[k][2],hi[k][3]}
    o[d0]=__builtin_amdgcn_mfma_f32_32x32x16_bf16(pa0,PK(0),o[d0],0,0,0);
    o[d0]=__builtin_amdgcn_mfma_f32_32x32x16_bf16(pa1,PK(1),o[d0],0,0,0);
    o[d0]=__builtin_amdgcn_mfma_f32_32x32x16_bf16(pa2,PK(2),o[d0],0,0,0);
    o[d0]=__builtin_amdgcn_mfma_f32_32x32x16_bf16(pa3,PK(3),o[d0],0,0,0);
    #undef PK
  }
}

#ifndef ATTN_STORE16
#define ATTN_STORE16(p,v) (*(u32x4*)(p)=(v))
#endif
template<int MODE,int THRL> __device__ __forceinline__ void attn_unit(int b,int h,int qb,const bf16*Q,const bf16*K,const bf16*V,bf16*O,char*shm,const bf16*KX,const float*relb){
  int tid_=threadIdx.x; asm volatile("":"+v"(tid_));
  const int tid=tid_,lane=tid&63,r32=lane&31,hi=lane>>5; const int wid=__builtin_amdgcn_readfirstlane(tid>>6);
  const long rowbase=(long)b*SEQ; const int q0=qb*QB;
  const bf16*Qw=Q+(rowbase+q0+wid*QBLK)*DM+h*D;
  const int kc0=(MODE==1)?((4*qb-8)>0?(4*qb-8):0):0;
  const bf16*Kh=K+(rowbase+(long)kc0*KVBLK)*DM+h*D,*Vh=V+(rowbase+(long)kc0*KVBLK)*DM+h*D;
  const unsigned lds0=(unsigned)(uintptr_t)shm;
  float*wsf=(float*)(shm+LDS_WS)+wid*64;
  const unsigned kvo=(unsigned)(lane*DM+wid*8)*2u, vvo=(unsigned)((16*(wid&3)+(lane>>2))*DM+(wid>>2)*32+(lane&3)*8)*2u;
  const unsigned kdst=lds0+LDS_K+wid*1024, vdst=lds0+LDS_V+wid*1024;
  #define DMA_K(t,slot) glds16s(Kh+(long)(t)*KVBLK*DM,kvo,(unsigned)__builtin_amdgcn_readfirstlane(kdst+(slot)))
  #define DMA_V(t,slot) glds16s(Vh+(long)(t)*KVBLK*DM,vvo,(unsigned)__builtin_amdgcn_readfirstlane(vdst+(slot)))
  const bf16*xsrc=KX+((long)(b*NHEAD+h)*2*SEQ+(long)(wid>>2)*SEQ+16*(wid&3))*8; const unsigned xvo=(unsigned)lane*4u; const unsigned xdst=lds0+LDS_X+wid*256;
  #define DMA_E(t,slot) do{ if(MODE==0) glds4s(xsrc+(long)(t)*KVBLK*8,xvo,(unsigned)__builtin_amdgcn_readfirstlane(xdst+((slot)>>2))); }while(0)
  const lds_cptr xp0=(lds_cptr)shm+LDS_X+hi*1024+r32*16;
  #define XLD(sl) do{ if(MODE==0){ ke0=*(const __attribute__((address_space(3))) bf16x8*)(xp0+((sl)>>2)); ke1=*(const __attribute__((address_space(3))) bf16x8*)(xp0+((sl)>>2)+512); } }while(0)
  #define WAITB_A() do{ if(MODE==0){WAIT_BAR(3);}else{WAIT_BAR(2);} }while(0)
  const int vb0=(int)(lds0+LDS_V)+((lane>>4)&1)*32+(lane&3)*8+(4*hi+((lane&15)>>2))*64;
  const char*Kbase=shm+LDS_K; bf16x8 kf[8];
  const lds_cptr shm3=(lds_cptr)shm; const lds_cptr kp0=shm3+LDS_K+hi*1024+r32*16; const lds_cptr vp0=shm3+LDS_V+((lane>>4)&1)*32+(lane&3)*8+(4*hi+((lane&15)>>2))*64;
  const int NT=(q0+QB)/KVBLK-kc0;
  if(MODE==1){ float*bt=(float*)(shm+LDS_BT); if(tid<257) bt[tid]=(relb[tid]-relb[256])*1.4426950408889634f; }
  u32x4 qev=(u32x4){0x3F803F80u,0x3F80u,0u,0u};
  bf16x8 ke0,ke1; { const u32x4 kc_=(hi==0)?(u32x4){0u,0x3F800000u,0x3F803F80u,0u}:(u32x4){0u,0u,0u,0u}; ke0=__builtin_bit_cast(bf16x8,kc_); ke1=ke0; }
  #define QE() __builtin_bit_cast(bf16x8,qev)
  #define SETQE() do{ const float nm_=-mhat; const unsigned a_=cvtpk_s(nm_,0.f)&0xffffu; const float r1_=nm_-__uint_as_float(a_<<16); const unsigned b_=cvtpk_s(r1_,0.f)&0xffffu; \
    const float r2_=r1_-__uint_as_float(b_<<16); const unsigned c_=cvtpk_s(r2_,0.f)&0xffffu; qev[1]=0x3F80u|(a_<<16); qev[2]=b_|(c_<<16); }while(0)
  DMA_K(0,0);DMA_E(0,0);DMA_V(0,0);DMA_K(1,SLOTB);DMA_E(1,SLOTB);
  bf16x8 qr[4];
  #pragma unroll
  for(int d0=0;d0<4;++d0)qr[d0]=*reinterpret_cast<const bf16x8*>(&Qw[(long)r32*DM+d0*16+hi*8]);
  float mhat=0.f,l_reg=0.f;f32x16 o[2];o[0]=f32x16{};o[1]=f32x16{};
  const int qrel=wid*QBLK+r32;
  const int cw=4*qb+(wid>>1);
  #define BMASK(P0,P1,t) do{ const int kc_=kc0+(t); if(kc_>cw||kc_<cw-8){ _Pragma("unroll") for(int r=0;r<16;++r){P0[r]=-INFINITY;P1[r]=-INFINITY;} } \
    else if(kc_>=cw-2){ const float*bt_=(const float*)(shm+LDS_BT); const int dq_=64*(cw-kc_)+32*(wid&1)+r32-4*hi; \
      _Pragma("unroll") for(int r=0;r<16;++r){ const int d0_=dq_-((r&3)+8*(r>>2)), d1_=d0_-32; P0[r]+=bt_[(d0_<128?d0_:128)+128]; P1[r]+=bt_[(d1_<128?d1_:128)+128]; } } }while(0)
  #define CMASK(P0,P1,t) do{ if(MODE==1){BMASK(P0,P1,t);} else {int jb_=(t)-(NT-4); if(jb_>=0)cmask(P0,P1,jb_,qrel,hi);} }while(0)
  bool resc=false;
  #define START(P0,P1) do{ float rm=rowmax(P0,P1); if(MODE==1) rm=max2f(rm,-64.f); resc=false; \
    { const float dl=rm; mhat=fadd_s(mhat,dl); \
      _Pragma("unroll") for(int r=0;r<16;++r){P0[r]=fsub_s(P0[r],dl);P1[r]=fsub_s(P1[r],dl);} \
      SETQE(); } \
    _Pragma("unroll") for(int r=0;r<16;++r)P0[r]=__builtin_amdgcn_exp2f(P0[r]); }while(0)
  #define RESC() do{ if(resc){ asm volatile("s_waitcnt lgkmcnt(0)":::"memory"); \
      _Pragma("unroll") for(int d_=0;d_<2;++d_) _Pragma("unroll") for(int r=0;r<16;++r)o[d_][r]*=wsf[crow(r,hi)]; } }while(0)
  f32x16 pA0,pA1,pB0,pB1;
  int sl_prev=0,sl_cur=0,sl_next=SLOTB;
  #define ROT() do{sl_prev=sl_cur;sl_cur=sl_next;sl_next=(sl_next==(NSLOT-1)*SLOTB)?0:sl_next+SLOTB;}while(0)
  DMA_K(2,2*SLOTB);DMA_E(2,2*SLOTB);
  if(MODE==0){WAIT_BAR(5);}else{WAIT_BAR(3);}
  XLD(0);
  qkt(pA0,pA1,Kbase,qr,ke0,ke1,QE(),r32,hi);asm volatile("s_nop 15\n\ts_nop 7":"+v"(pA0),"+v"(pA1));CMASK(pA0,pA1,0);
  START(pA0,pA1);
  _Pragma("unroll") for(int r=0;r<16;++r)pA1[r]=__builtin_amdgcn_exp2f(pA1[r]);
  WAIT_BAR(0);
  DMA_K(3,0);DMA_E(3,0);DMA_V(1,SLOTB);
  ROT();
  kload8(kf,kp0+sl_cur); XLD(sl_cur);
  WAITB_A();
  s16x4 vlo[8],vhi[8]; u32x4 pw0,pw1,pw2,pw3;
  #define PKW(P,B) cvtpk_s(P[B],P[B+1])
  #define PAF(k) __builtin_bit_cast(bf16x8,pw##k)
  #define VFR(i) (bf16x8){vlo[i][0],vlo[i][1],vlo[i][2],vlo[i][3],vhi[i][0],vhi[i][1],vhi[i][2],vhi[i][3]}
  #define PIN(x) asm volatile("":"+v"(x))
  #define MX3(a,b,c) __builtin_fmaxf(__builtin_fmaxf((a),(b)),(c))
  #define GAPA(MF,A0,A1,A2,A3,W0,W1,PW) do{ MF; sacc+=A0; sacc+=A1; sacc+=A2; sacc+=A3; PIN(sacc); W0; W1; PIN(PW); SBAR(); }while(0)
  #define EX(v) __builtin_amdgcn_exp2f(v)
  #define GAPB(MF,X,B) do{ MF; X[B]=EX(X[B]); X[B+1]=EX(X[B+1]); X[B+2]=EX(X[B+2]); X[B+3]=EX(X[B+3]); PIN(X); SBAR(); }while(0)
  #define VRD(i) do{ vlo[i]=vtr(vp_+(((i)>>2)*4096+((i)&3)*1024)); vhi[i]=vtr(vp_+(((i)>>2)*4096+((i)&3)*1024+512)); }while(0)
  #define KRD(G,j) do{ if(G){ kload2(kf,kp0+sl_next,j); SBAR(); } }while(0)
  #define STEP(C0,C1,P0,P1,t,GK,GV,GL) do{ SBAR(); \
    const lds_cptr vp_=vp0+sl_prev; \
    { const f32x16 z_=f32x16{}; C0=__builtin_amdgcn_mfma_f32_32x32x16_bf16(ke0,QE(),z_,0,0,0); C1=__builtin_amdgcn_mfma_f32_32x32x16_bf16(ke1,QE(),z_,0,0,0); } SBAR(); \
    VRD(0); SBAR(); float sacc=(P0[0]+P0[1]); \
    GAPA(C0=__builtin_amdgcn_mfma_f32_32x32x16_bf16(kf[0],qr[0],C0,0,0,0), P0[2],P0[3],P0[4],P0[5],     pw0[0]=PKW(P0,0), pw0[1]=PKW(P0,2), pw0); \
    VRD(4); SBAR(); GAPA(C1=__builtin_amdgcn_mfma_f32_32x32x16_bf16(kf[1],qr[0],C1,0,0,0), P0[6],P0[7],P0[8],P0[9],     pw0[2]=PKW(P0,4), pw0[3]=PKW(P0,6), pw0); \
    VRD(1); SBAR(); GAPA(C0=__builtin_amdgcn_mfma_f32_32x32x16_bf16(kf[2],qr[1],C0,0,0,0),   P0[10],P0[11],P0[12],P0[13], pw1[0]=PKW(P0,8), pw1[1]=PKW(P0,10), pw1); \
    VRD(5); SBAR(); GAPA(C1=__builtin_amdgcn_mfma_f32_32x32x16_bf16(kf[3],qr[1],C1,0,0,0),   P0[14],P0[15],P1[0],P1[1],   pw1[2]=PKW(P0,12),pw1[3]=PKW(P0,14), pw1); \
    VRD(2); SBAR(); GAPA(C0=__builtin_amdgcn_mfma_f32_32x32x16_bf16(kf[4],qr[2],C0,0,0,0),   P1[2],P1[3],P1[4],P1[5],     pw2[0]=PKW(P1,0), pw2[1]=PKW(P1,2), pw2); \
    VRD(6); SBAR(); GAPA(C1=__builtin_amdgcn_mfma_f32_32x32x16_bf16(kf[5],qr[2],C1,0,0,0),   P1[6],P1[7],P1[8],P1[9],     pw2[2]=PKW(P1,4), pw2[3]=PKW(P1,6), pw2); \
    VRD(3); SBAR(); GAPA(C0=__builtin_amdgcn_mfma_f32_32x32x16_bf16(kf[6],qr[3],C0,0,0,0),   P1[10],P1[11],P1[12],P1[13], pw3[0]=PKW(P1,8), pw3[1]=PKW(P1,10), pw3); \
    VRD(7); SBAR(); GAPA(C1=__builtin_amdgcn_mfma_f32_32x32x16_bf16(kf[7],qr[3],C1,0,0,0),   P1[14],P1[15],0.f,0.f,       pw3[2]=PKW(P1,12),pw3[3]=PKW(P1,14), pw3); \
    l_reg+=sacc; \
    if(GK){DMA_K((t)+3,sl_cur);DMA_E((t)+3,sl_cur);} if(GV){DMA_V((t)+1,sl_next);} \
    CMASK(C0,C1,t); \
    { float a=MX3(C0[0],C0[1],C1[0]),b=MX3(C0[2],C0[3],C1[1]); a=MX3(a,C1[2],C1[3]); \
      _Pragma("unroll") for(int r=4;r<16;r+=4){a=MX3(a,C0[r],C0[r+1]);b=MX3(b,C0[r+2],C0[r+3]);a=MX3(a,C1[r],C1[r+1]);b=MX3(b,C1[r+2],C1[r+3]);} \
      float rm=__builtin_fmaxf(a,b); { auto rr=__builtin_amdgcn_permlane32_swap(__float_as_uint(rm),__float_as_uint(rm),false,false); rm=__builtin_fmaxf(__uint_as_float(rr[0]),__uint_as_float(rr[1])); } \
      resc=false; \
      if(__builtin_expect(__any(rm>(float)THRL),0)){ const float dl=__builtin_fmaxf(rm,0.f); mhat+=dl; \
        _Pragma("unroll") for(int r=0;r<16;++r){C0[r]-=dl;C1[r]-=dl;} \
        SETQE(); \
        const float f=__builtin_amdgcn_exp2f(-dl); l_reg*=f; if(hi==0)wsf[r32]=f; resc=true; } } \
    SBAR(); \
    GAPB(o[0]=__builtin_amdgcn_mfma_f32_32x32x16_bf16(PAF(0),VFR(0),o[0],0,0,0), C0,0); \
    GAPB(o[1]=__builtin_amdgcn_mfma_f32_32x32x16_bf16(PAF(0),VFR(4),o[1],0,0,0), C0,4); \
    KRD(GL,0); GAPB(o[0]=__builtin_amdgcn_mfma_f32_32x32x16_bf16(PAF(1),VFR(1),o[0],0,0,0), C0,8); \
    KRD(GL,1); GAPB(o[1]=__builtin_amdgcn_mfma_f32_32x32x16_bf16(PAF(1),VFR(5),o[1],0,0,0), C0,12); \
    KRD(GL,2); GAPB(o[0]=__builtin_amdgcn_mfma_f32_32x32x16_bf16(PAF(2),VFR(2),o[0],0,0,0), C1,0); \
    KRD(GL,3); GAPB(o[1]=__builtin_amdgcn_mfma_f32_32x32x16_bf16(PAF(2),VFR(6),o[1],0,0,0), C1,4); \
    if(GL){ XLD(sl_next); SBAR(); } GAPB(o[0]=__builtin_amdgcn_mfma_f32_32x32x16_bf16(PAF(3),VFR(3),o[0],0,0,0), C1,8); \
    GAPB(o[1]=__builtin_amdgcn_mfma_f32_32x32x16_bf16(PAF(3),VFR(7),o[1],0,0,0), C1,12); \
    }while(0)
  int t=1;
  #undef CMASK
  #define CMASK(P0,P1,t) do{}while(0)
  if(MODE==0) for(;t+5<NT;t+=2){
    STEP(pB0,pB1,pA0,pA1,t,true,true,true);     WAIT_BAR(3); RESC(); ROT();
    STEP(pA0,pA1,pB0,pB1,t+1,true,true,true);   WAIT_BAR(3); RESC(); ROT();
  }
  #undef CMASK
  #define CMASK(P0,P1,t) do{ if(MODE==1){BMASK(P0,P1,t);} else {int jb_=(t)-(NT-4); if(jb_>=0)cmask(P0,P1,jb_,qrel,hi);} }while(0)
  #define ENDW(tt) do{ if((tt)+3<NT){WAITB_A();} else if((tt)+2<NT){WAIT_BAR(1);} else {WAIT_BAR(0);} }while(0)
  for(;t+1<NT;t+=2){
    STEP(pB0,pB1,pA0,pA1,t,(t+3<NT),(t+1<NT),(t+1<NT));       ENDW(t);   RESC(); ROT();
    STEP(pA0,pA1,pB0,pB1,t+1,(t+4<NT),(t+2<NT),(t+2<NT));     ENDW(t+1); RESC(); ROT();
  }
  STEP(pB0,pB1,pA0,pA1,NT-1,false,false,false); RESC();
  { float sacc=pB0[0]+pB0[1]; _Pragma("unroll") for(int r=2;r<16;++r)sacc+=pB0[r]; _Pragma("unroll") for(int r=0;r<16;++r)sacc+=pB1[r]; l_reg+=sacc;
    pw0=(u32x4){PKW(pB0,0),PKW(pB0,2),PKW(pB0,4),PKW(pB0,6)};pw1=(u32x4){PKW(pB0,8),PKW(pB0,10),PKW(pB0,12),PKW(pB0,14)};pw2=(u32x4){PKW(pB1,0),PKW(pB1,2),PKW(pB1,4),PKW(pB1,6)};pw3=(u32x4){PKW(pB1,8),PKW(pB1,10),PKW(pB1,12),PKW(pB1,14)};
    SBAR(); pv(o,vb0+sl_cur,PAF(0),PAF(1),PAF(2),PAF(3)); }
  #undef PKW
  #undef PAF
  #undef VFR
  #undef PIN
  #undef MX3
  #undef GAPA
  #undef GAPB
  #undef EX
  #undef VRD
  #undef KRD
  #undef STEP
  #undef ENDW
  {auto rr=__builtin_amdgcn_permlane32_swap(__float_as_uint(l_reg),__float_as_uint(l_reg),false,false);l_reg=__uint_as_float(rr[0])+__uint_as_float(rr[1]);}
  if(hi==0)wsf[32+r32]=l_reg;asm volatile("s_waitcnt lgkmcnt(0)":::"memory");
  float rli[16];
  #pragma unroll
  for(int r=0;r<16;++r)rli[r]=__builtin_amdgcn_rcpf(wsf[32+crow(r,hi)]);
  bf16*Ow=O+(rowbase+q0+wid*QBLK)*DM+h*D;
  { bf16*stg=(bf16*)(shm+LDS_OST)+wid*2048;
    #pragma unroll
    for(int r=0;r<16;++r){const int orow=crow(r,hi);
      #pragma unroll
      for(int d0=0;d0<2;++d0)stg[orow*64+d0*32+r32]=__float2bfloat16(o[d0][r]*rli[r]);}
    asm volatile("s_waitcnt lgkmcnt(0)":::"memory");
    #pragma unroll
    for(int i=0;i<4;++i){const int row=i*8+(lane>>3),ch=lane&7; const u32x4 v=*(const u32x4*)(stg+row*64+ch*8); ATTN_STORE16(Ow+(long)row*DM+ch*8,v);} }
  asm volatile("s_waitcnt lgkmcnt(0)\n\ts_barrier":::"memory");
  #undef DMA_K
  #undef DMA_V
  #undef DMA_E
  #undef XLD
  #undef WAITB_A
  #undef QE
  #undef SETQE
  #undef BMASK
  #undef CMASK
  #undef START
  #undef RESC
  #undef ROT
}
constexpr int ATTN_LDS_BYTES=LDS_BYTES;
struct AttnTensors { const bf16* Q; const bf16* K; const bf16* V; bf16* O; const bf16* KX; const float* relb; };
struct AttnUnit { int bh; int qb; };
struct StaticOrder {
  int vcu;
  __device__ __forceinline__ explicit StaticOrder(int grid,int block):vcu((block%8)*(grid/8)+block/8){}
  __device__ __forceinline__ bool next(int i,AttnUnit&u)const{ if(i>=4)return false; const int s=vcu&7; u.bh=vcu>>3; u.qb=(i==0)?s:(i==1)?15-s:(i==2)?16+s:31-s; return true; }
  __device__ __forceinline__ bool next_band(int i,AttnUnit&u)const{ if(i>=4)return false; u.bh=vcu>>3; u.qb=(vcu&7)+8*i; return true; }
  __device__ __forceinline__ void a_ready(const AttnUnit&)const{}
  __device__ __forceinline__ void done(const AttnUnit&)const{}
};
template<int MODE,class Sched,int THRL=8> __device__ __forceinline__ void attn_phase(char*lds,const AttnTensors&T,const Sched&S){
  AttnUnit u;
  for(int i=0;(MODE==0?S.next(i,u):S.next_band(i,u));++i){ attn_unit<MODE,THRL>(u.bh/NHEAD,u.bh%NHEAD,u.qb,T.Q,T.K,T.V,T.O,lds,T.KX,T.relb+(MODE==1?(u.bh%NHEAD)*257:0)); }
}
#undef SBAR
#undef WAIT_BAR
}
namespace cg = cooperative_groups;
constexpr int NWAVES = 8;
#ifndef MK_PER_PHASE
#define MK_PER_PHASE 0
#endif
constexpr int N_PHASES = 12;
constexpr int MP = 16384, MS = 512, MT = MP + MS, DMODEL = 1024, DFF = 2816, NH = 16, SEQL = 8192;
constexpr int PAST = 1024, BPAST = 512, DECB = 32, DECT = 16;
constexpr size_t O_YP = 0, O_YS = 16777216, O_AKP = 17301504, O_AVP = 34078720, O_ALFP = 50855936, O_BKP = 51118080, O_BVP = 52166656,
                 O_AKS = 53215232, O_AVS = 53739520, O_ALFS = 54263808, O_BKS = 54272000, O_BVS = 71049216, O_END = 87826432;
constexpr size_t MiB = 1u << 20;
constexpr size_t WS_WQKV0 = 2 * MiB, WS_WO0 = 8 * MiB, WS_WGU0 = 10 * MiB, WS_WD0 = 21 * MiB, WS_WKVQ = 27 * MiB, WS_WO1 = 33 * MiB, WS_WGU1 = 35 * MiB, WS_WD1 = 46 * MiB;
constexpr size_t WS_SSP = 52 * MiB, SSP_STRIDE = 2 * MiB;
constexpr size_t WS_GS = 62 * MiB;
constexpr size_t WS_KX = 64 * MiB;
constexpr size_t WS_QO = 72 * MiB, WS_KB = 105 * MiB, WS_VB = 138 * MiB, WS_HB = 171 * MiB, WS_ACT = 204 * MiB, WS_END = 296 * MiB;
static_assert(WS_ACT + (size_t)MT * DFF * 2 <= WS_END && WS_QO + (size_t)MT * DMODEL * 2 <= WS_KB, "d_ws map");
constexpr int RING_BYTES = 131072, LDS_BYTES = 147456;
static_assert(attn_body::ATTN_LDS_BYTES <= RING_BYTES, "attention LDS");

#define GAS __attribute__((address_space(1)))
#define LAS __attribute__((address_space(3)))
typedef unsigned short bf16;
typedef unsigned v4u __attribute__((ext_vector_type(4)));
typedef float f32x4 __attribute__((ext_vector_type(4)));
typedef short bf16x8 __attribute__((ext_vector_type(8)));
#define LDS_WAIT() asm volatile("s_waitcnt lgkmcnt(0)" ::: "memory")
__device__ __forceinline__ unsigned f2bf(float f) { unsigned u = __builtin_bit_cast(unsigned, f); return (u + 0x7fffu + ((u >> 16) & 1u)) >> 16; }
__device__ __forceinline__ unsigned pk2(float lo, float hi) { return f2bf(lo) | (f2bf(hi) << 16); }
__device__ __forceinline__ float bf2f(unsigned short b) { return __uint_as_float((unsigned)b << 16); }

__device__ __forceinline__ void p0_transpose_item(const float* W, int ldw, int csrc, int k0, const float* gain, bf16* WT, int K, int drow, LAS float* scr, int lane) {
#pragma unroll 8
    for (int i = 0; i < 32; ++i) { const int kk = 2 * i + (lane >> 5); const float g = gain ? gain[k0 + kk] : 1.f; scr[kk * 33 + (lane & 31)] = W[(size_t)(k0 + kk) * ldw + csrc + (lane & 31)] * g; }
    LDS_WAIT(); asm volatile("" ::: "memory");
    const int c = lane & 7;
#pragma unroll
    for (int j = 0; j < 4; ++j) { const int n = (lane >> 3) + 8 * j; const LAS float* s = scr + (8 * c) * 33 + n;
        v4u o; o.x = pk2(s[0 * 33], s[1 * 33]); o.y = pk2(s[2 * 33], s[3 * 33]); o.z = pk2(s[4 * 33], s[5 * 33]); o.w = pk2(s[6 * 33], s[7 * 33]);
        *(v4u*)(WT + (size_t)(drow + n) * K + k0 + 8 * c) = o; }
    LDS_WAIT(); asm volatile("" ::: "memory");
}
struct KArgs { const float* in[20]; float* out; unsigned char* ws; int ph_lo, ph_hi; };

__device__ __forceinline__ void p0_weight_item(const KArgs& a, int it, LAS float* scr, int lane) {
    unsigned char* ws = a.ws;
    constexpr int I_QKV = 16 * 96, I_O = 16 * 32, I_GU = 16 * 176, I_D = 44 * 32, I_Q1 = 16 * 32, I_KV = 16 * 64;
    const float* W; int ldw, ncols, K, roff = 0; const float* gain = nullptr; bf16* dst; bool perm = false;
    int r = it;
    if (r < I_QKV) { W = a.in[8]; ldw = 3088; ncols = 3072; K = 1024; gain = a.in[7]; dst = (bf16*)(ws + WS_WQKV0); }
    else if ((r -= I_QKV) < I_O) { W = a.in[10]; ldw = 1024; ncols = 1024; K = 1024; dst = (bf16*)(ws + WS_WO0); }
    else if ((r -= I_O) < I_GU) { W = a.in[17]; ldw = 5632; ncols = 5632; K = 1024; gain = a.in[16]; dst = (bf16*)(ws + WS_WGU0); perm = true; }
    else if ((r -= I_GU) < I_D) { W = a.in[18]; ldw = 1024; ncols = 1024; K = 2816; dst = (bf16*)(ws + WS_WD0); }
    else if ((r -= I_D) < I_Q1) { W = a.in[11]; ldw = 1024; ncols = 1024; K = 1024; gain = a.in[7] + 1024; dst = (bf16*)(ws + WS_WKVQ); }
    else if ((r -= I_Q1) < I_KV) { W = a.in[15]; ldw = 2048; ncols = 2048; K = 1024; gain = a.in[14]; dst = (bf16*)(ws + WS_WKVQ); roff = 1024; }
    else if ((r -= I_KV) < I_O) { W = a.in[13]; ldw = 1024; ncols = 1024; K = 1024; dst = (bf16*)(ws + WS_WO1); }
    else if ((r -= I_O) < I_GU) { W = a.in[17] + (size_t)1024 * 5632; ldw = 5632; ncols = 5632; K = 1024; gain = a.in[16] + 1024; dst = (bf16*)(ws + WS_WGU1); perm = true; }
    else { r -= I_GU; W = a.in[18] + (size_t)2816 * 1024; ldw = 1024; ncols = 1024; K = 2816; dst = (bf16*)(ws + WS_WD1); }
    const int nblk = ncols / 32, kb = r / nblk, nb = r % nblk, n0 = 32 * nb;
    int drow = roff + n0;
    if (perm) { drow = n0 < 2816 ? 256 * (n0 / 128) + (n0 % 128) : 256 * ((n0 - 2816) / 128) + 128 + ((n0 - 2816) % 128); }
    p0_transpose_item(W, ldw, n0, 64 * kb, gain, dst, K, drow, scr, lane);
}
constexpr int P0_NITEMS = 16 * 96 + 16 * 32 + 16 * 176 + 44 * 32 + 16 * 32 + 16 * 64 + 16 * 32 + 16 * 176 + 44 * 32;

__device__ __forceinline__ void p0_row_group(const KArgs& a, int g, const LAS unsigned char* wf, int lane) {
    const int fr = lane & 15, fq = lane >> 4;
    const int row = g * 16 + fr;
    const float* xr = (g < 1024 ? a.in[0] + (size_t)row * 1024 : a.in[1] + (size_t)(row - MP) * 1024) + 8 * fq;
    bf16* hb = (bf16*)(a.ws + WS_HB) + (size_t)row * 1024 + 8 * fq;
    f32x4 acc = {0.f, 0.f, 0.f, 0.f}; float ss = 0.f;
#pragma unroll 4
    for (int ks = 0; ks < 32; ++ks) {
        const f32x4 x0 = *(const f32x4*)(xr + 32 * ks), x1 = *(const f32x4*)(xr + 32 * ks + 4);
        ss += (x0[0] * x0[0] + x0[1] * x0[1]) + (x0[2] * x0[2] + x0[3] * x0[3]) + (x1[0] * x1[0] + x1[1] * x1[1]) + (x1[2] * x1[2] + x1[3] * x1[3]);
        v4u w; w.x = pk2(x0[0], x0[1]); w.y = pk2(x0[2], x0[3]); w.z = pk2(x1[0], x1[1]); w.w = pk2(x1[2], x1[3]);
        *(v4u*)(hb + 32 * ks) = w;
        const bf16x8 bfrag = *(const LAS bf16x8*)(wf + (ks * 64 + lane) * 16);
        acc = __builtin_amdgcn_mfma_f32_16x16x32_bf16(bfrag, __builtin_bit_cast(bf16x8, w), acc, 0, 0, 0);
    }
    ss += __shfl_xor(ss, 16); ss += __shfl_xor(ss, 32);
    float* ssp = (float*)(a.ws + WS_SSP) + (size_t)row * 16 + 4 * fq;
    *(f32x4*)ssp = (f32x4){fq == 0 ? ss : 0.f, 0.f, 0.f, 0.f};
    const float rstd = 1.0f / sqrtf(ss * (1.0f / 1024.0f) + 1e-6f);
    const f32x4 bf = *(const f32x4*)(a.in[9] + 4 * fq);
    f32x4 lf;
#pragma unroll
    for (int e = 0; e < 4; ++e) { const float z = acc[e] * rstd + bf[e]; lf[e] = fminf(z, 0.f) - log1pf(expf(-fabsf(z))); }
    float* lo = (g < 1024 ? a.out + O_ALFP + (size_t)row * 16 : a.out + O_ALFS + (size_t)(row - MP) * 16) + 4 * fq;
    *(f32x4*)lo = lf;
    if (g < 1024) {
#pragma unroll
        for (int o = 1; o < 16; o <<= 1) { lf[0] += __shfl_xor(lf[0], o); lf[1] += __shfl_xor(lf[1], o); lf[2] += __shfl_xor(lf[2], o); lf[3] += __shfl_xor(lf[3], o); }
        if (fr == 0) *(f32x4*)((float*)(a.ws + WS_GS) + g * 16 + 4 * fq) = lf;
    }
}

__device__ __forceinline__ void p1_scan(const KArgs& a, int v, LAS float* red, int tid) {
    const int batch = v >> 7, g0 = batch * 512, g1 = 4 * v, h = tid & 15, part = tid >> 4;
    const float* gs = (const float*)(a.ws + WS_GS);
    float s = 0.f;
    for (int g = g0 + part; g < g1; g += 32) s += gs[g * 16 + h];
    red[part * 16 + h] = s;
    __syncthreads();
    if (tid < 16) {
        float cum = 0.f;
        for (int p = 0; p < 32; ++p) cum += red[p * 16 + tid];
        const float* lf = a.out + O_ALFP + (size_t)(64 * v) * 16 + tid;
        bf16* kx = (bf16*)(a.ws + WS_KX) + ((size_t)(batch * 16 + tid) * 2 * SEQL) * 8;
        const int t0 = (64 * v) & (SEQL - 1);
        for (int r = 0; r < 64; ++r) {
            cum += lf[r * 16];
            const float c = -cum * 1.4426950408889634f;
            const unsigned c1 = f2bf(c); const float r1 = c - bf2f((unsigned short)c1);
            const unsigned c2 = f2bf(r1); const float r2 = r1 - bf2f((unsigned short)c2);
            const unsigned c3 = f2bf(r2);
            *(v4u*)(kx + (size_t)(t0 + r) * 8) = (v4u){c1 | (c2 << 16), c3 | 0x3F800000u, 0x3F803F80u, 0u};
            *(v4u*)(kx + (size_t)(SEQL + t0 + r) * 8) = (v4u){0u, 0u, 0u, 0u};
        }
    }
    __syncthreads();
}

template <int MODE> __device__ __forceinline__ void sample_attn(const KArgs& a, int b, int h, LAS unsigned char* lds, int tid) {
    constexpr int NC = MODE == 0 ? PAST : BPAST, NK = NC + 16, NKP = 1056;
    constexpr float L2E = 1.4426950408889634f;
    LAS float* S = (LAS float*)lds;
    LAS float* Qs = S + 16 * NKP;
    LAS float* bias = Qs + 1024;
    LAS float* Op = bias + NKP;
    LAS float* rl = Op + 8 * 1024;
    const int lane = tid & 63, wid = __builtin_amdgcn_readfirstlane(tid >> 6);
    const float* ck = a.in[MODE == 0 ? 2 : 5]; const float* cv = a.in[MODE == 0 ? 3 : 6];
    const float* nk = a.out + (MODE == 0 ? O_AKS + (size_t)(b * 16) * 1024 : O_BKS + (size_t)(b * 512 + 496) * 1024) + h * 64;
    const float* nv = a.out + (MODE == 0 ? O_AVS + (size_t)(b * 16) * 1024 : O_BVS + (size_t)(b * 512 + 496) * 1024) + h * 64;
    const bf16* qo = (const bf16*)(a.ws + WS_QO) + (size_t)(MP + b * 16) * 1024 + h * 64;
    if (tid < 128) { const int q = tid >> 3, c = tid & 7; const v4u w = *(const v4u*)(qo + (size_t)q * 1024 + 8 * c);
        LAS float* d = Qs + q * 64 + 8 * c; d[0] = bf2f(w.x & 0xffff); d[1] = bf2f(w.x >> 16); d[2] = bf2f(w.y & 0xffff); d[3] = bf2f(w.y >> 16); d[4] = bf2f(w.z & 0xffff); d[5] = bf2f(w.z >> 16); d[6] = bf2f(w.w & 0xffff); d[7] = bf2f(w.w >> 16); }
    if (MODE == 0) {
        for (int j = tid; j < NK; j += 512) bias[j] = j < NC ? a.in[4][((size_t)b * NC + j) * 16 + h] : a.out[O_ALFS + (size_t)(b * 16 + (j - NC)) * 16 + h];
    } else {
        if (tid < 257) bias[tid] = a.in[12][h * 257 + tid] * L2E;
    }
    __syncthreads();
    if (MODE == 0) {
        if (wid == 0) { float carry = 0.f;
            for (int c = 0; c < (NK + 63) / 64; ++c) { const int j = 64 * c + lane; float v = j < NK ? bias[j] : 0.f;
#pragma unroll
                for (int o = 1; o < 64; o <<= 1) { const float t = __shfl_up(v, o); if (lane >= o) v += t; }
                v += carry; carry = __shfl(v, 63); if (j < NK) bias[j] = -v * L2E; } }
        __syncthreads();
    }
    for (int g = wid; g <= NC / 64; g += 8) {
        const bool isnew = g == NC / 64; const int j = 64 * g + lane;
        if (isnew && lane >= 16) continue;
        const float* kr = isnew ? nk + (size_t)lane * 1024 : ck + (((size_t)b * NC + j) * 16 + h) * 64;
        f32x4 k4[16];
#pragma unroll
        for (int i = 0; i < 16; ++i) k4[i] = *(const f32x4*)(kr + 4 * i);
        if (MODE == 1 && !isnew && j >= 16) { float* ok = a.out + O_BKS + (((size_t)b * 512 + (j - 16)) * 16 + h) * 64;
#pragma unroll
            for (int i = 0; i < 16; ++i) *(f32x4*)(ok + 4 * i) = k4[i]; }
#pragma unroll 2
        for (int q = 0; q < 16; ++q) { float s = 0.f;
#pragma unroll
            for (int i = 0; i < 16; ++i) { const f32x4 qv = *(const LAS f32x4*)(Qs + q * 64 + 4 * i); s += (qv[0] * k4[i][0] + qv[1] * k4[i][1]) + (qv[2] * k4[i][2] + qv[3] * k4[i][3]); }
            if (MODE == 0) { s += bias[j]; if (isnew && lane > q) s = -INFINITY; }
            else { const int d = 512 + q - j; s += bias[(d < 128 ? d : 128) + 128]; }
            S[q * NKP + j] = s; }
    }
    __syncthreads();
    for (int q = 2 * wid; q < 2 * wid + 2; ++q) { float m = -INFINITY;
        for (int j = lane; j < NK; j += 64) m = fmaxf(m, S[q * NKP + j]);
#pragma unroll
        for (int o = 1; o < 64; o <<= 1) m = fmaxf(m, __shfl_xor(m, o));
        float l = 0.f;
        for (int j = lane; j < NK; j += 64) { const float p = __builtin_amdgcn_exp2f(S[q * NKP + j] - m); S[q * NKP + j] = p; l += p; }
#pragma unroll
        for (int o = 1; o < 64; o <<= 1) l += __shfl_xor(l, o);
        if (lane == 0) rl[q] = 1.0f / l; }
    __syncthreads();
    { float acc[16];
#pragma unroll
        for (int q = 0; q < 16; ++q) acc[q] = 0.f;
        const int j0 = wid * (NK / 8), j1 = j0 + NK / 8;
#pragma unroll 4
        for (int j = j0; j < j1; ++j) {
            const float v = j < NC ? cv[(((size_t)b * NC + j) * 16 + h) * 64 + lane] : nv[(size_t)(j - NC) * 1024 + lane];
            if (MODE == 1 && j >= 16 && j < NC) a.out[O_BVS + (((size_t)b * 512 + (j - 16)) * 16 + h) * 64 + lane] = v;
#pragma unroll
            for (int q = 0; q < 16; ++q) acc[q] += S[q * NKP + j] * v; }
#pragma unroll
        for (int q = 0; q < 16; ++q) Op[(wid * 16 + q) * 64 + lane] = acc[q]; }
    __syncthreads();
    for (int e = tid; e < 1024; e += 512) { const int q = e >> 6, d = e & 63; float o = 0.f;
#pragma unroll
        for (int w = 0; w < 8; ++w) o += Op[(w * 16 + q) * 64 + d];
        ((bf16*)(a.ws + WS_QO))[(size_t)(MP + b * 16 + q) * 1024 + h * 64 + d] = (bf16)f2bf(o * rl[q]); }
    __syncthreads();
}

__device__ __forceinline__ KArgs load_args() {
#if !defined(__HIP_DEVICE_COMPILE__)
    return KArgs{};
#else
    auto p = __builtin_amdgcn_kernarg_segment_ptr(); asm volatile("" : "+s"(p)); return *(const __attribute__((address_space(4))) KArgs*)p;
#endif
}
__global__ void __launch_bounds__(NWAVES * 64, 2) fwd_mega(KArgs args_unused) {
    extern __shared__ __attribute__((aligned(16))) unsigned char lds[];
    LAS unsigned char* L = (LAS unsigned char*)lds;
    const int G = gridDim.x, bx = blockIdx.x, vcu = (G % 8 == 0) ? (bx % 8) * (G / 8) + bx / 8 : bx;
    int lo, hi; { const KArgs a0 = load_args(); lo = a0.ph_lo; hi = a0.ph_hi; }
#ifndef PHMASK
#define PHMASK 0xfff
#endif
#define IN(k) (((PHMASK >> (k)) & 1) && lo <= (k) && (k) < hi)
#define SEAM(k) do { if (IN(k) && IN((k) + 1)) { asm volatile("s_waitcnt vmcnt(0) lgkmcnt(0)" ::: "memory"); \
        if ((k) == 0) { __threadfence(); cg::this_grid().sync(); } \
        else { __syncthreads(); \
            if (threadIdx.x == 0) { unsigned* c_ = (unsigned*)(load_args().ws) + 1024 + 64 * (k); __builtin_amdgcn_fence(__ATOMIC_RELEASE, "agent"); asm volatile("s_waitcnt vmcnt(0)" ::: "memory"); \
                __hip_atomic_fetch_add(c_, 1u, __ATOMIC_RELAXED, __HIP_MEMORY_SCOPE_AGENT); \
                while (__hip_atomic_load(c_, __ATOMIC_RELAXED, __HIP_MEMORY_SCOPE_AGENT) < (unsigned)G) __builtin_amdgcn_s_sleep(2); \
                __builtin_amdgcn_fence(__ATOMIC_ACQUIRE, "agent"); asm volatile("s_waitcnt vmcnt(0)" ::: "memory"); } \
            __syncthreads(); } } } while (0)
#define PHASE_ARGS() int tid = threadIdx.x; asm volatile("" : "+v"(tid)); const int lane = tid & 63, wave = __builtin_amdgcn_readfirstlane(tid >> 6); (void)lane; (void)wave; const KArgs args = load_args(); unsigned char* ws = args.ws; float* out = args.out; (void)out; \
    bf16* QO = (bf16*)(ws + WS_QO); bf16* KB = (bf16*)(ws + WS_KB); bf16* VB = (bf16*)(ws + WS_VB); bf16* HB = (bf16*)(ws + WS_HB); bf16* ACT = (bf16*)(ws + WS_ACT); (void)QO; (void)KB; (void)VB; (void)HB; (void)ACT
#define SSPN(i) ((float*)(ws + WS_SSP + (size_t)(i) * SSP_STRIDE))

    if (IN(0)) {
        PHASE_ARGS();
        LAS unsigned char* wf = L + 98304;
        for (int e = tid; e < 32 * 64; e += NWAVES * 64) { const int ks = e >> 6, ln = e & 63, h = ln & 15, kq = ln >> 4, k0 = 32 * ks + 8 * kq; float v[8];
#pragma unroll
            for (int i = 0; i < 8; ++i) v[i] = args.in[8][(size_t)(k0 + i) * 3088 + 3072 + h] * args.in[7][k0 + i];
            *(LAS v4u*)(wf + e * 16) = (v4u){pk2(v[0], v[1]), pk2(v[2], v[3]), pk2(v[4], v[5]), pk2(v[6], v[7])}; }
        __syncthreads();
        { const int g = wave * G + vcu; if (g < MT / 16) p0_row_group(args, g, wf, lane); }
        LAS float* scr = (LAS float*)(L + wave * 8704);
        const int gw = vcu * NWAVES + wave, NGW = G * NWAVES;
        for (int it = gw; it < P0_NITEMS; it += NGW) p0_weight_item(args, it, scr, lane);
    }
    SEAM(0);
    if (IN(1)) {
        PHASE_ARGS();
        p1_scan(args, vcu, (LAS float*)L, tid);
        pg8::Gemm g{HB, (const bf16*)(ws + WS_WQKV0), MT, 3072, 1024}; pg8::StaticOrder S; S.init(MT, 3072, G, bx);
        pg8::EpiQKV E{QO, KB, VB, out + O_AKP, out + O_AVP, out + O_AKS, out + O_AVS, SSPN(0), 0, attn_body::C2};
        pg8::gemm_phase<pg8::EpiQKV, pg8::StaticOrder, PG8_ALIGN, PG8_SP2>(L, g, S, E);
    }
    SEAM(1);
    if (IN(2)) {
        PHASE_ARGS();
        for (int i = 0; i < 2; ++i) { const int u = 2 * vcu + i; if (u < DECB * NH) sample_attn<0>(args, u >> 4, u & 15, L, tid); }
        const attn_body::AttnTensors AT{(const attn_body::bf16*)QO, (const attn_body::bf16*)KB, (const attn_body::bf16*)VB, (attn_body::bf16*)QO, (const attn_body::bf16*)(ws + WS_KX), args.in[12]};
        const attn_body::StaticOrder S(G, bx);
        attn_body::attn_phase<0, attn_body::StaticOrder>((char*)lds, AT, S);
    }
    SEAM(2);
    if (IN(3)) {
        PHASE_ARGS();
        pg8::Gemm g{QO, (const bf16*)(ws + WS_WO0), MT, 1024, 1024}; pg8::StaticOrder S; S.init(MT, 1024, G, bx);
        pg8::EpiRes E{args.in[0], args.in[1], out, HB, SSPN(1)};
        pg8::gemm_phase<pg8::EpiRes, pg8::StaticOrder, PG8_ALIGN, PG8_SP2>(L, g, S, E);
    }
    SEAM(3);
    if (IN(4)) {
        PHASE_ARGS();
        pg8::Gemm g{HB, (const bf16*)(ws + WS_WGU0), MT, 5632, 1024}; pg8::StaticOrder S; S.init(MT, 5632, G, bx);
        pg8::EpiSwiGLU E{ACT, SSPN(1)};
        pg8::gemm_phase<pg8::EpiSwiGLU, pg8::StaticOrder, PG8_ALIGN, PG8_SP2>(L, g, S, E);
    }
    SEAM(4);
    if (IN(5)) {
        PHASE_ARGS();
        pg8::Gemm g{ACT, (const bf16*)(ws + WS_WD0), MT, 1024, 2816}; pg8::StaticOrder S; S.init(MT, 1024, G, bx);
        pg8::EpiRes E{out, out + (size_t)MP * 1024, out, HB, SSPN(2)};
        pg8::gemm_phase<pg8::EpiRes, pg8::StaticOrder, PG8_ALIGN, PG8_SP2>(L, g, S, E);
    }
    SEAM(5);
    if (IN(6)) {
        PHASE_ARGS();
        pg8::Gemm g{HB, (const bf16*)(ws + WS_WKVQ), MT, 3072, 1024}; pg8::StaticOrder S; S.init(MT, 3072, G, bx);
        pg8::EpiQKV E{QO, KB, VB, out + O_BKP, out + O_BVP, out + O_BKS, out + O_BVS, SSPN(2), 1, attn_body::C2};
        pg8::gemm_phase<pg8::EpiQKV, pg8::StaticOrder, PG8_ALIGN, PG8_SP2>(L, g, S, E);
    }
    SEAM(6);
    if (IN(7)) {
        PHASE_ARGS();
        for (int i = 0; i < 2; ++i) { const int u = 2 * vcu + i; if (u < DECB * NH) sample_attn<1>(args, u >> 4, u & 15, L, tid); }
        const attn_body::AttnTensors AT{(const attn_body::bf16*)QO, (const attn_body::bf16*)KB, (const attn_body::bf16*)VB, (attn_body::bf16*)QO, (const attn_body::bf16*)(ws + WS_KX), args.in[12]};
        const attn_body::StaticOrder S(G, bx);
        attn_body::attn_phase<1, attn_body::StaticOrder>((char*)lds, AT, S);
    }
    SEAM(7);
    if (IN(8)) {
        PHASE_ARGS();
        pg8::Gemm g{QO, (const bf16*)(ws + WS_WO1), MT, 1024, 1024}; pg8::StaticOrder S; S.init(MT, 1024, G, bx);
        pg8::EpiRes E{out, out + (size_t)MP * 1024, out, HB, SSPN(3)};
        pg8::gemm_phase<pg8::EpiRes, pg8::StaticOrder, PG8_ALIGN, PG8_SP2>(L, g, S, E);
    }
    SEAM(8);
    if (IN(9)) {
        PHASE_ARGS();
        pg8::Gemm g{HB, (const bf16*)(ws + WS_WGU1), MT, 5632, 1024}; pg8::StaticOrder S; S.init(MT, 5632, G, bx);
        pg8::EpiSwiGLU E{ACT, SSPN(3)};
        pg8::gemm_phase<pg8::EpiSwiGLU, pg8::StaticOrder, PG8_ALIGN, PG8_SP2>(L, g, S, E);
    }
    SEAM(9);
    if (IN(10)) {
        PHASE_ARGS();
        pg8::Gemm g{ACT, (const bf16*)(ws + WS_WD1), MT, 1024, 2816}; pg8::StaticOrder S; S.init(MT, 1024, G, bx);
        pg8::EpiRes E{out, out + (size_t)MP * 1024, out, HB, SSPN(4)};
        pg8::gemm_phase<pg8::EpiRes, pg8::StaticOrder, PG8_ALIGN, PG8_SP2>(L, g, S, E);
    }
    SEAM(10);
    if (IN(11)) {
        PHASE_ARGS();
        const int gw = vcu * NWAVES + wave, NGW = G * NWAVES; const float* gf = args.in[19]; const float* ssp = SSPN(4);
        f32x4 gv[4];
#pragma unroll
        for (int j = 0; j < 4; ++j) gv[j] = *(const f32x4*)(gf + 256 * j + 4 * lane);
        for (int m = gw; m < MT; m += NGW) {
            float s = 0.f;
#pragma unroll
            for (int j = 0; j < 4; ++j) { const f32x4 p = *(const f32x4*)(ssp + (size_t)m * 16 + 4 * j); s += (p[0] + p[1]) + (p[2] + p[3]); }
            const float rstd = 1.0f / sqrtf(s * (1.0f / 1024.0f) + 1e-6f);
            float* r = out + (size_t)m * 1024 + 4 * lane;
#pragma unroll
            for (int j = 0; j < 4; ++j) { f32x4 v = *(f32x4*)(r + 256 * j); v = v * rstd * gv[j]; *(f32x4*)(r + 256 * j) = v; }
        }
    }
#undef IN
#undef SEAM
}

extern "C" void kernel_launch(void* const* d_in, const int* in_sizes, int n_in, void* d_out, int out_size, void* d_ws, size_t ws_size, hipStream_t stream) {
    static int grid = 0;
    if (grid == 0) {
        if (n_in != 20 || (size_t)out_size != O_END || ws_size < WS_END) { fprintf(stderr, "kernel_launch: unexpected shapes (n_in %d out %d ws %zu)\n", n_in, out_size, ws_size); grid = -1; return; }
        int dev = 0, cus = 0, per_cu = 0;
        hipGetDevice(&dev); hipDeviceGetAttribute(&cus, hipDeviceAttributeMultiprocessorCount, dev);
        if (hipFuncSetAttribute((const void*)fwd_mega, hipFuncAttributeMaxDynamicSharedMemorySize, LDS_BYTES) != hipSuccess) { fprintf(stderr, "kernel_launch: hipFuncSetAttribute failed\n"); grid = -1; return; }
        if (hipOccupancyMaxActiveBlocksPerMultiprocessor(&per_cu, (const void*)fwd_mega, NWAVES * 64, LDS_BYTES) != hipSuccess || per_cu < 1) { fprintf(stderr, "kernel_launch: occupancy query says %d\n", per_cu); per_cu = 1; }
        (void)hipGetLastError();
        grid = cus * per_cu;
        if (grid != 256) fprintf(stderr, "kernel_launch: grid %d (expected 256)\n", grid);
    }
    if (grid < 0) return;
    if (hipMemsetAsync(d_ws, 0, 65536, stream) != hipSuccess) { fprintf(stderr, "kernel_launch: memset failed\n"); return; }
    KArgs a{};
    for (int i = 0; i < 20; ++i) a.in[i] = (const float*)d_in[i];
    a.out = (float*)d_out; a.ws = (unsigned char*)d_ws;
#if MK_PER_PHASE
    for (int p = 0; p < N_PHASES; ++p) { a.ph_lo = p; a.ph_hi = p + 1; void* kargs[] = {&a};
        hipError_t e = hipLaunchCooperativeKernel((const void*)fwd_mega, dim3(grid), dim3(NWAVES * 64), kargs, LDS_BYTES, stream);
        if (e != hipSuccess) { fprintf(stderr, "kernel_launch: launch %d failed: %s\n", p, hipGetErrorString(e)); break; } }
#else
    a.ph_lo = 0; a.ph_hi = N_PHASES; void* kargs[] = {&a};
    hipError_t e = hipLaunchCooperativeKernel((const void*)fwd_mega, dim3(grid), dim3(NWAVES * 64), kargs, LDS_BYTES, stream);
    if (e != hipSuccess) fprintf(stderr, "kernel_launch: cooperative launch failed: %s (grid %d)\n", hipGetErrorString(e), grid);
#endif
}
```

```cpp
#include <hip/hip_cooperative_groups.h>
#include <hip/hip_runtime.h>
#include <cstdio>
#include <cstdint>
namespace pg8 {
#define PG8_LAS __attribute__((address_space(3)))
typedef unsigned short bf16_t;
typedef short bf16x8 __attribute__((ext_vector_type(8)));
typedef float f32x4 __attribute__((ext_vector_type(4)));
typedef unsigned u32x4 __attribute__((ext_vector_type(4)));
constexpr int BM = 256, BK = 64, HALF = 128, HTB = HALF * BK * 2  , STAGE_BYTES = 8 * HTB, NXCD = 8, WGM = 8;

__host__ __device__ __forceinline__ int lds_byte(int r, int c) { const int st = (r >> 4) * 2 + (c >> 5), rr = r & 15, cc = c & 31, ob = rr * 64 + cc * 2; return st * 1024 + (ob ^ (((ob >> 9) & 1) << 5)); }
__host__ __device__ __forceinline__ void stage_rc(int b, int& R, int& C) { const int st = b / 1024, sb = b % 1024, swz = sb ^ (((sb >> 9) & 1) << 5); R = (st >> 1) * 16 + swz / 64; C = (st & 1) * 32 + (swz % 64) / 2; }
__host__ __device__ __forceinline__ int perm32(int rho) { const int n = rho >> 4, i = rho & 15; return 8 * (i >> 2) + 4 * n + (i & 3); }

struct Unit { int pm, pn; };
struct Gemm { const bf16_t* A; const bf16_t* Bt; int M, N, K; };

struct StaticOrder {
    int nM, nN, nwg, G, c;
    __host__ __device__ void init(int M, int N, int G_, int c_) { nM = M / BM; nN = N / BM; nwg = nM * nN; G = G_; c = c_; }
    __host__ __device__ bool next(int i, Unit& u) const {
        const long L = (long)i * G + c; if (L >= nwg) return false;
        int wgid = (int)L; { const int q = nwg / NXCD, r = nwg % NXCD, xcd = wgid % NXCD, off = wgid / NXCD; wgid = (xcd < r ? xcd * (q + 1) : r * (q + 1) + (xcd - r) * q) + off; }
        const int nig = WGM * nN, gid = wgid / nig, fm = gid * WGM, gsz = (nM - fm) < WGM ? (nM - fm) : WGM;
        u.pm = fm + ((wgid % nig) % gsz); u.pn = (wgid % nig) / gsz; return true;
    }
    __device__ __forceinline__ void a_ready(const Unit&) const {}
    __device__ __forceinline__ void done(const Unit&) const {}
};

__device__ __forceinline__ unsigned cvt_pk_bf16(float lo, float hi) { unsigned r; asm volatile("v_cvt_pk_bf16_f32 %0, %1, %2" : "=v"(r) : "v"(lo), "v"(hi)); return r; }
constexpr int MP_ROWS = 16384;
constexpr float RMS_EPS = 1e-6f;
__device__ __forceinline__ void row_rstd(float (&rs)[2][4], const float* ssp, int row0, int fq) {
#pragma unroll
    for (int ai = 0; ai < 2; ++ai)
#pragma unroll
        for (int m = 0; m < 4; ++m) { const f32x4 p = *(const f32x4*)(ssp + (size_t)(row0 + ai * HALF + m * 16) * 16 + 4 * fq);
            float s = (p[0] + p[1]) + (p[2] + p[3]); s += __shfl_xor(s, 16); s += __shfl_xor(s, 32);
            rs[ai][m] = 1.0f / sqrtf(s * (1.0f / 1024.0f) + RMS_EPS); }
}
struct EpiQKV {
    static constexpr bool PERM = true, AFTER_DRAIN = false;
    bf16_t *Qb, *Kb, *Vb; float *kp, *vp, *ks, *vs; const float* ssp; int layer; float qscale;
    __device__ __forceinline__ long frow(int row) const {
        if (layer == 0) return row < MP_ROWS ? (long)row * 1024 : (long)(row - MP_ROWS) * 1024;
        if (row < MP_ROWS) { const int t = row & 8191, b = row >> 13; return t >= 7680 ? (long)(b * 512 + t - 7680) * 1024 : -1; }
        const int sr = row - MP_ROWS; return (long)((sr >> 4) * 512 + 496 + (sr & 15)) * 1024;
    }
    __device__ __forceinline__ void operator()(const f32x4 (&acc)[2][2][4][2], const Unit& u, int wr, int wc, int fr, int fq) const {
        const int t = u.pn >> 2, colt = (u.pn & 3) * BM, row0 = u.pm * BM + wr * 64 + fr, col0 = colt + wc * 32 + 8 * fq;
        float rs[2][4]; row_rstd(rs, ssp, row0, fq);
        bf16_t* const qb_ = Qb; bf16_t* const kb_ = Kb; bf16_t* const vb_ = Vb; float* const kp_ = kp; float* const vp_ = vp; float* const ks_ = ks; float* const vs_ = vs;
        bf16_t* B = t == 0 ? qb_ : (t == 1 ? kb_ : vb_); const float sc = t == 0 ? qscale : 1.f;
        const bool prow = u.pm < 64;
        float* fb = t == 1 ? (prow ? kp_ : ks_) : (prow ? vp_ : vs_);
        const bool anyf = t > 0 && (layer == 0 || !prow || (u.pm & 31) >= 30);
#pragma unroll
        for (int ai = 0; ai < 2; ++ai)
#pragma unroll
            for (int m = 0; m < 4; ++m) { const int row = row0 + ai * HALF + m * 16; const float r = rs[ai][m];
                const long fo = anyf ? frow(row) : -1;
#pragma unroll
                for (int bj = 0; bj < 2; ++bj) { f32x4 v0 = acc[ai][bj][m][0] * r, v1 = acc[ai][bj][m][1] * r;
                    if (fo >= 0) { float* fp = fb + fo + col0 + bj * HALF; *(f32x4*)fp = v0; *(f32x4*)(fp + 4) = v1; }
                    v0 = v0 * sc; v1 = v1 * sc; u32x4 w; w.x = cvt_pk_bf16(v0[0], v0[1]); w.y = cvt_pk_bf16(v0[2], v0[3]); w.z = cvt_pk_bf16(v1[0], v1[1]); w.w = cvt_pk_bf16(v1[2], v1[3]);
                    *(u32x4*)(B + (size_t)row * 1024 + col0 + bj * HALF) = w; } }
    }
};
struct EpiRes {
    static constexpr bool PERM = true, AFTER_DRAIN = false;
    const float *base_p, *base_s; float* H; bf16_t* HB; float* ssp;
    __device__ __forceinline__ void operator()(const f32x4 (&acc)[2][2][4][2], const Unit& u, int wr, int wc, int fr, int fq) const {
        const int col0 = u.pn * BM + wc * 32 + 8 * fq, rl0 = wr * 64 + fr;
        const float* base = u.pm < 64 ? base_p + (size_t)u.pm * BM * 1024 : base_s + (size_t)(u.pm - 64) * BM * 1024;
#pragma unroll
        for (int ai = 0; ai < 2; ++ai)
#pragma unroll
            for (int m = 0; m < 4; ++m) { const int rl = rl0 + ai * HALF + m * 16; const size_t row = (size_t)u.pm * BM + rl; float ss = 0.f;
#pragma unroll
                for (int bj = 0; bj < 2; ++bj) { const float* bp = base + (size_t)rl * 1024 + col0 + bj * HALF;
                    const f32x4 v0 = acc[ai][bj][m][0] + *(const f32x4*)bp, v1 = acc[ai][bj][m][1] + *(const f32x4*)(bp + 4);
                    ss += (v0[0] * v0[0] + v0[1] * v0[1]) + (v0[2] * v0[2] + v0[3] * v0[3]) + (v1[0] * v1[0] + v1[1] * v1[1]) + (v1[2] * v1[2] + v1[3] * v1[3]);
                    float* hp = H + row * 1024 + col0 + bj * HALF; *(f32x4*)hp = v0; *(f32x4*)(hp + 4) = v1;
                    u32x4 w; w.x = cvt_pk_bf16(v0[0], v0[1]); w.y = cvt_pk_bf16(v0[2], v0[3]); w.z = cvt_pk_bf16(v1[0], v1[1]); w.w = cvt_pk_bf16(v1[2], v1[3]);
                    *(u32x4*)(HB + row * 1024 + col0 + bj * HALF) = w; }
                ss += __shfl_xor(ss, 16); ss += __shfl_xor(ss, 32);
                if (fq == 0) ssp[row * 16 + u.pn * 4 + wc] = ss;
                if (m & 1) asm volatile("" ::: "memory"); }
    }
};
struct EpiSwiGLU {
    static constexpr bool PERM = true, AFTER_DRAIN = false;
    bf16_t* ACT; const float* ssp;
    __device__ __forceinline__ void operator()(const f32x4 (&acc)[2][2][4][2], const Unit& u, int wr, int wc, int fr, int fq) const {
        const int row0 = u.pm * BM + wr * 64 + fr, col0 = u.pn * HALF + wc * 32 + 8 * fq;
        float rs[2][4]; row_rstd(rs, ssp, row0, fq);
#pragma unroll
        for (int ai = 0; ai < 2; ++ai)
#pragma unroll
            for (int m = 0; m < 4; ++m) { const int row = row0 + ai * HALF + m * 16; const float r = rs[ai][m]; float o[8];
#pragma unroll
                for (int n = 0; n < 2; ++n)
#pragma unroll
                    for (int e = 0; e < 4; ++e) { const float g = acc[ai][0][m][n][e] * r, up = acc[ai][1][m][n][e] * r;
                        o[n * 4 + e] = g * __builtin_amdgcn_rcpf(1.0f + __builtin_amdgcn_exp2f(g * -1.4426950408889634f)) * up; }
                u32x4 w; w.x = cvt_pk_bf16(o[0], o[1]); w.y = cvt_pk_bf16(o[2], o[3]); w.z = cvt_pk_bf16(o[4], o[5]); w.w = cvt_pk_bf16(o[6], o[7]);
                *(u32x4*)(ACT + (size_t)row * 2816 + col0) = w; }
    }
};

template <class Epi, class Sched, bool ALIGN_EPI = false, bool SP2 = false>
__device__ __forceinline__ void gemm_phase(PG8_LAS unsigned char* lds, const Gemm g, const Sched& S, const Epi& E) {
    int tid_ = threadIdx.x; asm volatile("" : "+v"(tid_));
    const int tid = tid_, wid = __builtin_amdgcn_readfirstlane(tid >> 6), lane = tid & 63, wr = wid >> 2, wc = wid & 3, fr = lane & 15, fq = lane >> 4;
    const int K = g.K, nt = K / BK;
    unsigned voffA[2], voffB[2];
#pragma unroll
    for (int i = 0; i < 2; ++i) { int R, C; stage_rc(tid * 16 + i * 8192, R, C); const int Rb = Epi::PERM ? ((R & ~31) + perm32(R & 31)) : R;
        voffA[i] = (unsigned)(R * K + C) * 2u; voffB[i] = (unsigned)(Rb * K + C) * 2u; }
    const size_t kstep = (size_t)(BK * 2);
    const size_t hstep = (size_t)HALF * K * 2;
    const size_t tstep = 2 * hstep;
    const unsigned ldsw = (unsigned)wid * 1024u;
    const int aoff = lds_byte(wr * 64 + fr, fq * 8), boff = lds_byte(wc * 32 + fr, fq * 8);
#define PG8_SA(b, h) (((b) * 2 + (h)) * HTB)
#define PG8_SB(b, h) ((4 + (b) * 2 + (h)) * HTB)
#define PG8_STAGE(bufoff, gbase, voff) do { _Pragma("unroll") for (int _i = 0; _i < 2; ++_i) \
        __builtin_amdgcn_global_load_lds((const unsigned*)((const char*)(gbase) + (voff)[_i]), (PG8_LAS unsigned*)(lds + (bufoff) + ldsw + _i * 8192), 16, 0, 0); } while (0)
#define PG8_LDA(dst, b, h) do { _Pragma("unroll") for (int m = 0; m < 4; ++m) _Pragma("unroll") for (int k = 0; k < 2; ++k) dst[m][k] = *(const PG8_LAS bf16x8*)(lds + PG8_SA(b, h) + aoff + m * 2048 + k * 1024); } while (0)
#define PG8_LDB(dst, b, h) do { _Pragma("unroll") for (int n = 0; n < 2; ++n) _Pragma("unroll") for (int k = 0; k < 2; ++k) dst[n][k] = *(const PG8_LAS bf16x8*)(lds + PG8_SB(b, h) + boff + n * 2048 + k * 1024); } while (0)
#define PG8_MMA(ai, bj, At, Bt) do { __builtin_amdgcn_s_setprio(1); _Pragma("unroll") for (int m = 0; m < 4; ++m) _Pragma("unroll") for (int n = 0; n < 2; ++n) _Pragma("unroll") for (int k = 0; k < 2; ++k) \
        acc[ai][bj][m][n] = __builtin_amdgcn_mfma_f32_16x16x32_bf16(Bt[n][k], At[m][k], acc[ai][bj][m][n], 0, 0, 0); __builtin_amdgcn_s_setprio(0); } while (0)
#define PG8_WAIT_V(n) asm volatile("s_waitcnt vmcnt(" #n ")" ::: "memory")
#define PG8_WAIT_L(n) asm volatile("s_waitcnt lgkmcnt(" #n ")" ::: "memory")
#define PG8_BAR __builtin_amdgcn_s_barrier()
#define PG8_SCHED __builtin_amdgcn_sched_barrier(0)
    Unit cur, nxt; int ui = 0;
    if (!S.next(0, cur)) return;
    f32x4 acc[2][2][4][2];
#pragma unroll
    for (int a = 0; a < 2; ++a)
#pragma unroll
        for (int b = 0; b < 2; ++b)
#pragma unroll
            for (int m = 0; m < 4; ++m)
#pragma unroll
                for (int n = 0; n < 2; ++n) acc[a][b][m][n] = (f32x4){0.f, 0.f, 0.f, 0.f};
    bf16x8 At[4][2], B0[2][2], B1[2][2];
    const char* cA = (const char*)g.A + (size_t)cur.pm * tstep; const char* cB = (const char*)g.Bt + (size_t)cur.pn * tstep;
    S.a_ready(cur);
    if constexpr (SP2) {
        PG8_STAGE(PG8_SB(0, 0), cB, voffB); PG8_STAGE(PG8_SB(0, 1), cB + hstep, voffB); PG8_STAGE(PG8_SA(0, 0), cA, voffA); PG8_STAGE(PG8_SA(0, 1), cA + hstep, voffA);
        if (wr == 1) PG8_BAR;
        PG8_WAIT_V(2); PG8_BAR;
        PG8_STAGE(PG8_SB(1, 0), cB + kstep, voffB); PG8_STAGE(PG8_SA(1, 0), cA + kstep, voffA); PG8_STAGE(PG8_SB(1, 1), cB + hstep + kstep, voffB);
        PG8_WAIT_V(6); PG8_BAR;
    } else {
        PG8_STAGE(PG8_SB(0, 0), cB, voffB); PG8_STAGE(PG8_SA(0, 0), cA, voffA); PG8_STAGE(PG8_SB(0, 1), cB + hstep, voffB); PG8_STAGE(PG8_SA(0, 1), cA + hstep, voffA);
        if (wr == 1) PG8_BAR;
        PG8_WAIT_V(4); PG8_BAR;
        PG8_STAGE(PG8_SB(1, 0), cB + kstep, voffB); PG8_STAGE(PG8_SA(1, 0), cA + kstep, voffA); PG8_STAGE(PG8_SB(1, 1), cB + hstep + kstep, voffB);
        PG8_WAIT_V(6); PG8_BAR;
    }
    for (;;) {
        const bool has_next = S.next(ui + 1, nxt);
        const char* nA = has_next ? (const char*)g.A + (size_t)nxt.pm * tstep : cA; const char* nB = has_next ? (const char*)g.Bt + (size_t)nxt.pn * tstep : cB;
        for (int t = 0; t < nt; t += 2) {
            const bool last = (t == nt - 2);
            const char* a1 = cA + (size_t)(t + 1) * kstep;
            const char* a2 = last ? nA : cA + (size_t)(t + 2) * kstep; const char* b2 = last ? nB : cB + (size_t)(t + 2) * kstep;
            const char* a3 = a2 + kstep; const char* b3 = b2 + kstep;
            if (last && has_next) S.a_ready(nxt);
            if constexpr (SP2) {
            PG8_LDB(B0, 0, 0); PG8_LDB(B1, 0, 1); PG8_SCHED; PG8_LDA(At, 0, 0); PG8_STAGE(PG8_SA(1, 1), a1 + hstep, voffA);
            PG8_WAIT_V(8); PG8_WAIT_L(0); PG8_BAR; PG8_MMA(0, 0, At, B0); PG8_MMA(0, 1, At, B1); PG8_BAR; PG8_SCHED;
            PG8_LDA(At, 0, 1); PG8_STAGE(PG8_SB(0, 0), b2, voffB); PG8_STAGE(PG8_SB(0, 1), b2 + hstep, voffB); PG8_STAGE(PG8_SA(0, 0), a2, voffA);
            PG8_WAIT_V(8); PG8_WAIT_L(0); PG8_BAR; PG8_MMA(1, 0, At, B0); PG8_MMA(1, 1, At, B1); PG8_BAR; PG8_SCHED;
            PG8_LDB(B0, 1, 0); PG8_LDB(B1, 1, 1); PG8_SCHED; PG8_LDA(At, 1, 0); PG8_STAGE(PG8_SA(0, 1), a2 + hstep, voffA);
            PG8_WAIT_V(8); PG8_WAIT_L(0); PG8_BAR; PG8_MMA(0, 0, At, B0); PG8_MMA(0, 1, At, B1); PG8_BAR; PG8_SCHED;
            PG8_LDA(At, 1, 1); PG8_STAGE(PG8_SB(1, 0), b3, voffB); PG8_STAGE(PG8_SB(1, 1), b3 + hstep, voffB); PG8_STAGE(PG8_SA(1, 0), a3, voffA);
            PG8_WAIT_V(8); PG8_WAIT_L(0); PG8_BAR; PG8_MMA(1, 0, At, B0); PG8_MMA(1, 1, At, B1); PG8_BAR; PG8_SCHED;
            } else {
            PG8_LDB(B0, 0, 0); PG8_SCHED; PG8_LDA(At, 0, 0); PG8_STAGE(PG8_SA(1, 1), a1 + hstep, voffA);
            PG8_WAIT_L(8); PG8_BAR; PG8_WAIT_L(0); PG8_MMA(0, 0, At, B0); PG8_BAR; PG8_SCHED;
            PG8_LDB(B1, 0, 1); PG8_STAGE(PG8_SB(0, 0), b2, voffB);
            PG8_BAR; PG8_WAIT_L(0); PG8_MMA(0, 1, At, B1); PG8_BAR;
            PG8_LDA(At, 0, 1); PG8_STAGE(PG8_SA(0, 0), a2, voffA);
            PG8_BAR; PG8_WAIT_L(0); PG8_MMA(1, 0, At, B0); PG8_BAR; PG8_SCHED;
            PG8_STAGE(PG8_SB(0, 1), b2 + hstep, voffB);
            PG8_WAIT_V(6); PG8_BAR; PG8_MMA(1, 1, At, B1); PG8_BAR;
            PG8_LDB(B0, 1, 0); PG8_SCHED; PG8_LDA(At, 1, 0); PG8_STAGE(PG8_SA(0, 1), a2 + hstep, voffA);
            PG8_WAIT_L(8); PG8_BAR; PG8_WAIT_L(0); PG8_MMA(0, 0, At, B0); PG8_BAR; PG8_SCHED;
            PG8_LDB(B1, 1, 1); PG8_STAGE(PG8_SB(1, 0), b3, voffB);
            PG8_BAR; PG8_WAIT_L(0); PG8_MMA(0, 1, At, B1); PG8_BAR;
            PG8_LDA(At, 1, 1); PG8_STAGE(PG8_SA(1, 0), a3, voffA);
            PG8_BAR; PG8_WAIT_L(0); PG8_MMA(1, 0, At, B0); PG8_BAR; PG8_SCHED;
            PG8_STAGE(PG8_SB(1, 1), b3 + hstep, voffB);
            PG8_WAIT_V(6); PG8_BAR; PG8_MMA(1, 1, At, B1); PG8_BAR;
            }
        }
        if constexpr (ALIGN_EPI) { if (wr == 0) PG8_BAR; }
        if constexpr (!Epi::AFTER_DRAIN) { E(acc, cur, wr, wc, fr, fq); S.done(cur); }
        if (!has_next) break;
#pragma unroll
        for (int a = 0; a < 2; ++a)
#pragma unroll
            for (int b = 0; b < 2; ++b)
#pragma unroll
                for (int m = 0; m < 4; ++m)
#pragma unroll
                    for (int n = 0; n < 2; ++n) acc[a][b][m][n] = (f32x4){0.f, 0.f, 0.f, 0.f};
        cur = nxt; cA = nA; cB = nB; ++ui;
        if constexpr (ALIGN_EPI) { if (wr == 1) PG8_BAR; }
    }
    PG8_WAIT_V(0);
    if constexpr (!ALIGN_EPI) { if (wr == 0) PG8_BAR; }
    PG8_BAR;
    if constexpr (Epi::AFTER_DRAIN) { E.fused(acc, cur, wr, wc, fr, fq, lds, wid, lane); S.done(cur); }
#undef PG8_SA
#undef PG8_SB
#undef PG8_STAGE
#undef PG8_LDA
#undef PG8_LDB
#undef PG8_MMA
#undef PG8_WAIT_V
#undef PG8_WAIT_L
#undef PG8_BAR
#undef PG8_SCHED
}
}

#ifndef PG8_SP2
#define PG8_SP2 true
#endif
#ifndef PG8_ALIGN
#define PG8_ALIGN true
#endif
#include <hip/hip_bf16.h>
#include <cmath>
namespace attn_body {
using bf16=__hip_bfloat16;
using bf16x8=__attribute__((ext_vector_type(8)))short;
using s16x4=__attribute__((ext_vector_type(4)))short;
using f32x16=__attribute__((ext_vector_type(16)))float;
using u32x4=__attribute__((ext_vector_type(4)))unsigned;
constexpr int BATCH=2,NHEAD=16,SEQ=8192,D=64,DM=NHEAD*D;
constexpr int NW=8,QBLK=32,QB=QBLK*NW,KVBLK=64,NQB=SEQ/QB;
constexpr int ATTN_PITCH=DM, ATTN_UNIT_ROWS=QB;
__device__ __forceinline__ int crow(int r,int hi){return (r&3)+8*(r>>2)+4*hi;}
#define SBAR() __builtin_amdgcn_sched_barrier(0)
__device__ __forceinline__ void cmask(f32x16&p0,f32x16&p1,int jb,int qrel,int hi){
  const float NEG=-INFINITY; int kb=64*jb+4*hi;
  #pragma unroll
  for(int r=0;r<16;++r){int kv=kb+(r&3)+8*(r>>2); if(kv>qrel)p0[r]=NEG; if(kv+32>qrel)p1[r]=NEG;}
}

constexpr int NSLOT=3, SLOTB=8192;
constexpr int LDS_K=0, LDS_V=NSLOT*SLOTB, LDS_WS=2*NSLOT*SLOTB, LDS_OST=LDS_WS+NW*64*4, LDS_X=LDS_OST+NW*4096, LDS_BT=LDS_X+NSLOT*2048, LDS_BYTES=LDS_BT+2048;
constexpr float C2=0.125f*1.4426950408889634f;
__device__ __forceinline__ void glds16(const void*gsrc,unsigned lds_dst){unsigned keep;
  asm volatile("s_mov_b32 %0, m0\n\ts_mov_b32 m0, %2\n\ts_nop 0\n\tglobal_load_lds_dwordx4 %1, off\n\ts_mov_b32 m0, %0":"=&s"(keep):"v"(gsrc),"s"(lds_dst):"memory");}
__device__ __forceinline__ void glds16s(const void*sbase,unsigned voff,unsigned lds_dst){unsigned keep;
  asm volatile("s_mov_b32 %0, m0\n\ts_mov_b32 m0, %3\n\ts_nop 0\n\tglobal_load_lds_dwordx4 %1, %2\n\ts_mov_b32 m0, %0":"=&s"(keep):"v"(voff),"s"(sbase),"s"(lds_dst):"memory");}
__device__ __forceinline__ void glds4s(const void*sbase,unsigned voff,unsigned lds_dst){unsigned keep;
  asm volatile("s_mov_b32 %0, m0\n\ts_mov_b32 m0, %3\n\ts_nop 0\n\tglobal_load_lds_dword %1, %2\n\ts_mov_b32 m0, %0":"=&s"(keep):"v"(voff),"s"(sbase),"s"(lds_dst):"memory");}
__device__ __forceinline__ void glds4(const void*gsrc,unsigned lds_dst){unsigned keep;
  asm volatile("s_mov_b32 %0, m0\n\ts_mov_b32 m0, %2\n\ts_nop 0\n\tglobal_load_lds_dword %1, off\n\ts_mov_b32 m0, %0":"=&s"(keep):"v"(gsrc),"s"(lds_dst):"memory");}
__device__ __forceinline__ float max3f(float a,float b,float c){float r;asm("v_max3_f32 %0, %1, %2, %3":"=v"(r):"v"(a),"v"(b),"v"(c));return r;}
__device__ __forceinline__ float max2f(float a,float b){float r;asm("v_max_f32_e32 %0, %1, %2":"=v"(r):"v"(a),"v"(b));return r;}
__device__ __forceinline__ float fadd_s(float a,float b){float r;asm("v_add_f32_e32 %0, %1, %2":"=v"(r):"v"(a),"v"(b));return r;}
__device__ __forceinline__ float fsub_s(float a,float b){float r;asm("v_sub_f32_e32 %0, %1, %2":"=v"(r):"v"(a),"v"(b));return r;}
typedef float f32x2_t __attribute__((ext_vector_type(2))); typedef __bf16 bf16x2_t __attribute__((ext_vector_type(2)));
__device__ __forceinline__ unsigned cvtpk_s(float lo,float hi){f32x2_t v={lo,hi};bf16x2_t b=__builtin_convertvector(v,bf16x2_t);return __builtin_bit_cast(unsigned,b);}
#define WAIT_BAR(N) asm volatile("s_waitcnt vmcnt(" #N ") lgkmcnt(0)\n\ts_barrier":::"memory")

__device__ __forceinline__ void qkt(f32x16&p0,f32x16&p1,const char*Kslot,const bf16x8*qr,bf16x8 kx0,bf16x8 kx1,bf16x8 qe,int r32,int hi){
  const char*kb=Kslot+hi*1024+r32*16;
  #pragma unroll
  for(int d0=0;d0<4;++d0){
    const bf16x8 b0=*reinterpret_cast<const bf16x8*>(kb+d0*2048);
    const bf16x8 b1=*reinterpret_cast<const bf16x8*>(kb+d0*2048+512);
    if(d0==0){const f32x16 z=f32x16{};p0=__builtin_amdgcn_mfma_f32_32x32x16_bf16(kx0,qe,z,0,0,0);p1=__builtin_amdgcn_mfma_f32_32x32x16_bf16(kx1,qe,z,0,0,0);}
    {p0=__builtin_amdgcn_mfma_f32_32x32x16_bf16(b0,qr[d0],p0,0,0,0);p1=__builtin_amdgcn_mfma_f32_32x32x16_bf16(b1,qr[d0],p1,0,0,0);}}
}
typedef __attribute__((address_space(3))) const char* lds_cptr;
typedef short v4i16_t __attribute__((ext_vector_type(4)));
__device__ __forceinline__ void kload8(bf16x8*kf,lds_cptr kp){
  kf[0]=*(const __attribute__((address_space(3))) bf16x8*)(kp);      kf[1]=*(const __attribute__((address_space(3))) bf16x8*)(kp+512);
  kf[2]=*(const __attribute__((address_space(3))) bf16x8*)(kp+2048); kf[3]=*(const __attribute__((address_space(3))) bf16x8*)(kp+2560);
  kf[4]=*(const __attribute__((address_space(3))) bf16x8*)(kp+4096); kf[5]=*(const __attribute__((address_space(3))) bf16x8*)(kp+4608);
  kf[6]=*(const __attribute__((address_space(3))) bf16x8*)(kp+6144); kf[7]=*(const __attribute__((address_space(3))) bf16x8*)(kp+6656);
}
__device__ __forceinline__ void kload2(bf16x8*kf,lds_cptr kp,int j){ kf[2*j]=*(const __attribute__((address_space(3))) bf16x8*)(kp+j*2048); kf[2*j+1]=*(const __attribute__((address_space(3))) bf16x8*)(kp+j*2048+512); }
__device__ __forceinline__ s16x4 vtr(lds_cptr p){ return __builtin_bit_cast(s16x4,__builtin_amdgcn_ds_read_tr16_b64_v4i16((__attribute__((address_space(3))) v4i16_t*)p)); }
__device__ __forceinline__ float rowmax(const f32x16&p0,const f32x16&p1){
  float a=max3f(p0[0],p0[1],p1[0]),b=max3f(p0[2],p0[3],p1[1]);a=max3f(a,p1[2],p1[3]);
  #pragma unroll
  for(int r=4;r<16;r+=4){a=max3f(a,p0[r],p0[r+1]);b=max3f(b,p0[r+2],p0[r+3]);a=max3f(a,p1[r],p1[r+1]);b=max3f(b,p1[r+2],p1[r+3]);}
  const float m=max2f(a,b);
  auto rr=__builtin_amdgcn_permlane32_swap(__float_as_uint(m),__float_as_uint(m),false,false);
  return max2f(__uint_as_float(rr[0]),__uint_as_float(rr[1]));
}
__device__ __forceinline__ void pv(f32x16*o,int vb,bf16x8 pa0,bf16x8 pa1,bf16x8 pa2,bf16x8 pa3){
  #pragma unroll
  for(int d0=0;d0<2;++d0){s16x4 lo[4],hi[4];
    #pragma unroll
    for(int ks=0;ks<4;++ks){
      asm volatile("ds_read_b64_tr_b16 %0,%1 offset:%c2":"=&v"(lo[ks]):"v"(vb),"i"(d0*4096+ks*1024):"memory");
      asm volatile("ds_read_b64_tr_b16 %0,%1 offset:%c2":"=&v"(hi[ks]):"v"(vb),"i"(d0*4096+ks*1024+512):"memory");}
    asm volatile("s_waitcnt lgkmcnt(0)":::"memory");SBAR();
    #define PK(k) (bf16x8){lo[k][0],lo[k][1],lo[k][2],lo[k][3],hi[k][0],hi[k][1],hi[k][2],hi[k][3]}
    o[d0]=__builtin_amdgcn_mfma_f32_32x32x16_bf16(pa0,PK(0),o[d0],0,0,0);
    o[d0]=__builtin_amdgcn_mfma_f32_32x32x16_bf16(pa1,PK(1),o[d0],0,0,0);
    o[d0]=__builtin_amdgcn_mfma_f32_32x32x16_bf16(pa2,PK(2),o[d0],0,0,0);
    o[d0]=__builtin_amdgcn_mfma_f32_32x32x16_bf16(pa3,PK(3),o[d0],0,0,0);
    #undef PK
  }
}

#ifndef ATTN_STORE16
#define ATTN_STORE16(p,v) (*(u32x4*)(p)=(v))
#endif
template<int MODE,int THRL> __device__ __forceinline__ void attn_unit(int b,int h,int qb,const bf16*Q,const bf16*K,const bf16*V,bf16*O,char*shm,const bf16*KX,const float*relb){
  int tid_=threadIdx.x; asm volatile("":"+v"(tid_));
  const int tid=tid_,lane=tid&63,r32=lane&31,hi=lane>>5; const int wid=__builtin_amdgcn_readfirstlane(tid>>6);
  const long rowbase=(long)b*SEQ; const int q0=qb*QB;
  const bf16*Qw=Q+(rowbase+q0+wid*QBLK)*DM+h*D;
  const int kc0=(MODE==1)?((4*qb-8)>0?(4*qb-8):0):0;
  const bf16*Kh=K+(rowbase+(long)kc0*KVBLK)*DM+h*D,*Vh=V+(rowbase+(long)kc0*KVBLK)*DM+h*D;
  const unsigned lds0=(unsigned)(uintptr_t)shm;
  float*wsf=(float*)(shm+LDS_WS)+wid*64;
  const unsigned kvo=(unsigned)(lane*DM+wid*8)*2u, vvo=(unsigned)((16*(wid&3)+(lane>>2))*DM+(wid>>2)*32+(lane&3)*8)*2u;
  const unsigned kdst=lds0+LDS_K+wid*1024, vdst=lds0+LDS_V+wid*1024;
  #define DMA_K(t,slot) glds16s(Kh+(long)(t)*KVBLK*DM,kvo,(unsigned)__builtin_amdgcn_readfirstlane(kdst+(slot)))
  #define DMA_V(t,slot) glds16s(Vh+(long)(t)*KVBLK*DM,vvo,(unsigned)__builtin_amdgcn_readfirstlane(vdst+(slot)))
  const bf16*xsrc=KX+((long)(b*NHEAD+h)*2*SEQ+(long)(wid>>2)*SEQ+16*(wid&3))*8; const unsigned xvo=(unsigned)lane*4u; const unsigned xdst=lds0+LDS_X+wid*256;
  #define DMA_E(t,slot) do{ if(MODE==0) glds4s(xsrc+(long)(t)*KVBLK*8,xvo,(unsigned)__builtin_amdgcn_readfirstlane(xdst+((slot)>>2))); }while(0)
  const lds_cptr xp0=(lds_cptr)shm+LDS_X+hi*1024+r32*16;
  #define XLD(sl) do{ if(MODE==0){ ke0=*(const __attribute__((address_space(3))) bf16x8*)(xp0+((sl)>>2)); ke1=*(const __attribute__((address_space(3))) bf16x8*)(xp0+((sl)>>2)+512); } }while(0)
  #define WAITB_A() do{ if(MODE==0){WAIT_BAR(3);}else{WAIT_BAR(2);} }while(0)
  const int vb0=(int)(lds0+LDS_V)+((lane>>4)&1)*32+(lane&3)*8+(4*hi+((lane&15)>>2))*64;
  const char*Kbase=shm+LDS_K; bf16x8 kf[8];
  const lds_cptr shm3=(lds_cptr)shm; const lds_cptr kp0=shm3+LDS_K+hi*1024+r32*16; const lds_cptr vp0=shm3+LDS_V+((lane>>4)&1)*32+(lane&3)*8+(4*hi+((lane&15)>>2))*64;
  const int NT=(q0+QB)/KVBLK-kc0;
  if(MODE==1){ float*bt=(float*)(shm+LDS_BT); if(tid<257) bt[tid]=(relb[tid]-relb[256])*1.4426950408889634f; }
  u32x4 qev=(u32x4){0x3F803F80u,0x3F80u,0u,0u};
  bf16x8 ke0,ke1; { const u32x4 kc_=(hi==0)?(u32x4){0u,0x3F800000u,0x3F803F80u,0u}:(u32x4){0u,0u,0u,0u}; ke0=__builtin_bit_cast(bf16x8,kc_); ke1=ke0; }
  #define QE() __builtin_bit_cast(bf16x8,qev)
  #define SETQE() do{ const float nm_=-mhat; const unsigned a_=cvtpk_s(nm_,0.f)&0xffffu; const float r1_=nm_-__uint_as_float(a_<<16); const unsigned b_=cvtpk_s(r1_,0.f)&0xffffu; \
    const float r2_=r1_-__uint_as_float(b_<<16); const unsigned c_=cvtpk_s(r2_,0.f)&0xffffu; qev[1]=0x3F80u|(a_<<16); qev[2]=b_|(c_<<16); }while(0)
  DMA_K(0,0);DMA_E(0,0);DMA_V(0,0);DMA_K(1,SLOTB);DMA_E(1,SLOTB);
  bf16x8 qr[4];
  #pragma unroll
  for(int d0=0;d0<4;++d0)qr[d0]=*reinterpret_cast<const bf16x8*>(&Qw[(long)r32*DM+d0*16+hi*8]);
  float mhat=0.f,l_reg=0.f;f32x16 o[2];o[0]=f32x16{};o[1]=f32x16{};
  const int qrel=wid*QBLK+r32;
  const int cw=4*qb+(wid>>1);
  #define BMASK(P0,P1,t) do{ const int kc_=kc0+(t); if(kc_>cw||kc_<cw-8){ _Pragma("unroll") for(int r=0;r<16;++r){P0[r]=-INFINITY;P1[r]=-INFINITY;} } \
    else if(kc_>=cw-2){ const float*bt_=(const float*)(shm+LDS_BT); const int dq_=64*(cw-kc_)+32*(wid&1)+r32-4*hi; \
      _Pragma("unroll") for(int r=0;r<16;++r){ const int d0_=dq_-((r&3)+8*(r>>2)), d1_=d0_-32; P0[r]+=bt_[(d0_<128?d0_:128)+128]; P1[r]+=bt_[(d1_<128?d1_:128)+128]; } } }while(0)
  #define CMASK(P0,P1,t) do{ if(MODE==1){BMASK(P0,P1,t);} else {int jb_=(t)-(NT-4); if(jb_>=0)cmask(P0,P1,jb_,qrel,hi);} }while(0)
  bool resc=false;
  #define START(P0,P1) do{ float rm=rowmax(P0,P1); if(MODE==1) rm=max2f(rm,-64.f); resc=false; \
    { const float dl=rm; mhat=fadd_s(mhat,dl); \
      _Pragma("unroll") for(int r=0;r<16;++r){P0[r]=fsub_s(P0[r],dl);P1[r]=fsub_s(P1[r],dl);} \
      SETQE(); } \
    _Pragma("unroll") for(int r=0;r<16;++r)P0[r]=__builtin_amdgcn_exp2f(P0[r]); }while(0)
  #define RESC() do{ if(resc){ asm volatile("s_waitcnt lgkmcnt(0)":::"memory"); \
      _Pragma("unroll") for(int d_=0;d_<2;++d_) _Pragma("unroll") for(int r=0;r<16;++r)o[d_][r]*=wsf[crow(r,hi)]; } }while(0)
  f32x16 pA0,pA1,pB0,pB1;
  int sl_prev=0,sl_cur=0,sl_next=SLOTB;
  #define ROT() do{sl_prev=sl_cur;sl_cur=sl_next;sl_next=(sl_next==(NSLOT-1)*SLOTB)?0:sl_next+SLOTB;}while(0)
  DMA_K(2,2*SLOTB);DMA_E(2,2*SLOTB);
  if(MODE==0){WAIT_BAR(5);}else{WAIT_BAR(3);}
  XLD(0);
  qkt(pA0,pA1,Kbase,qr,ke0,ke1,QE(),r32,hi);asm volatile("s_nop 15\n\ts_nop 7":"+v"(pA0),"+v"(pA1));CMASK(pA0,pA1,0);
  START(pA0,pA1);
  _Pragma("unroll") for(int r=0;r<16;++r)pA1[r]=__builtin_amdgcn_exp2f(pA1[r]);
  WAIT_BAR(0);
  DMA_K(3,0);DMA_E(3,0);DMA_V(1,SLOTB);
  ROT();
  kload8(kf,kp0+sl_cur); XLD(sl_cur);
  WAITB_A();
  s16x4 vlo[8],vhi[8]; u32x4 pw0,pw1,pw2,pw3;
  #define PKW(P,B) cvtpk_s(P[B],P[B+1])
  #define PAF(k) __builtin_bit_cast(bf16x8,pw##k)
  #define VFR(i) (bf16x8){vlo[i][0],vlo[i][1],vlo[i][2],vlo[i][3],vhi[i][0],vhi[i][1],vhi[i][2],vhi[i][3]}
  #define PIN(x) asm volatile("":"+v"(x))
  #define MX3(a,b,c) __builtin_fmaxf(__builtin_fmaxf((a),(b)),(c))
  #define GAPA(MF,A0,A1,A2,A3,W0,W1,PW) do{ MF; sacc+=A0; sacc+=A1; sacc+=A2; sacc+=A3; PIN(sacc); W0; W1; PIN(PW); SBAR(); }while(0)
  #define EX(v) __builtin_amdgcn_exp2f(v)
  #define GAPB(MF,X,B) do{ MF; X[B]=EX(X[B]); X[B+1]=EX(X[B+1]); X[B+2]=EX(X[B+2]); X[B+3]=EX(X[B+3]); PIN(X); SBAR(); }while(0)
  #define VRD(i) do{ vlo[i]=vtr(vp_+(((i)>>2)*4096+((i)&3)*1024)); vhi[i]=vtr(vp_+(((i)>>2)*4096+((i)&3)*1024+512)); }while(0)
  #define KRD(G,j) do{ if(G){ kload2(kf,kp0+sl_next,j); SBAR(); } }while(0)
  #define STEP(C0,C1,P0,P1,t,GK,GV,GL) do{ SBAR(); \
    const lds_cptr vp_=vp0+sl_prev; \
    { const f32x16 z_=f32x16{}; C0=__builtin_amdgcn_mfma_f32_32x32x16_bf16(ke0,QE(),z_,0,0,0); C1=__builtin_amdgcn_mfma_f32_32x32x16_bf16(ke1,QE(),z_,0,0,0); } SBAR(); \
    VRD(0); SBAR(); float sacc=(P0[0]+P0[1]); \
    GAPA(C0=__builtin_amdgcn_mfma_f32_32x32x16_bf16(kf[0],qr[0],C0,0,0,0), P0[2],P0[3],P0[4],P0[5],     pw0[0]=PKW(P0,0), pw0[1]=PKW(P0,2), pw0); \
    VRD(4); SBAR(); GAPA(C1=__builtin_amdgcn_mfma_f32_32x32x16_bf16(kf[1],qr[0],C1,0,0,0), P0[6],P0[7],P0[8],P0[9],     pw0[2]=PKW(P0,4), pw0[3]=PKW(P0,6), pw0); \
    VRD(1); SBAR(); GAPA(C0=__builtin_amdgcn_mfma_f32_32x32x16_bf16(kf[2],qr[1],C0,0,0,0),   P0[10],P0[11],P0[12],P0[13], pw1[0]=PKW(P0,8), pw1[1]=PKW(P0,10), pw1); \
    VRD(5); SBAR(); GAPA(C1=__builtin_amdgcn_mfma_f32_32x32x16_bf16(kf[3],qr[1],C1,0,0,0),   P0[14],P0[15],P1[0],P1[1],   pw1[2]=PKW(P0,12),pw1[3]=PKW(P0,14), pw1); \
    VRD(2); SBAR(); GAPA(C0=__builtin_amdgcn_mfma_f32_32x32x16_bf16(kf[4],qr[2],C0,0,0,0),   P1[2],P1[3],P1[4],P1[5],     pw2[0]=PKW(P1,0), pw2[1]=PKW(P1,2), pw2); \
    VRD(6); SBAR(); GAPA(C1=__builtin_amdgcn_mfma_f32_32x32x16_bf16(kf[5],qr[2],C1,0,0,0),   P1[6],P1[7],P1[8],P1[9],     pw2[2]=PKW(P1,4), pw2[3]=PKW(P1,6), pw2); \
    VRD(3); SBAR(); GAPA(C0=__builtin_amdgcn_mfma_f32_32x32x16_bf16(kf[6],qr[3],C0,0,0,0),   P1[10],P1[11],P1[12],P1[13], pw3[0]=PKW(P1,8), pw3[1]=PKW(P1,10), pw3); \
    VRD(7); SBAR(); GAPA(C1=__builtin_amdgcn_mfma_f32_32x32x16_bf16(kf[7],qr[3],C1,0,0,0),   P1[14],P1[15],0.f,0.f,       pw3[2]=PKW(P1,12),pw3[3]=PKW(P1,14), pw3); \
    l_reg+=sacc; \
    if(GK){DMA_K((t)+3,sl_cur);DMA_E((t)+3,sl_cur);} if(GV){DMA_V((t)+1,sl_next);} \
    CMASK(C0,C1,t); \
    { float a=MX3(C0[0],C0[1],C1[0]),b=MX3(C0[2],C0[3],C1[1]); a=MX3(a,C1[2],C1[3]); \
      _Pragma("unroll") for(int r=4;r<16;r+=4){a=MX3(a,C0[r],C0[r+1]);b=MX3(b,C0[r+2],C0[r+3]);a=MX3(a,C1[r],C1[r+1]);b=MX3(b,C1[r+2],C1[r+3]);} \
      float rm=__builtin_fmaxf(a,b); { auto rr=__builtin_amdgcn_permlane32_swap(__float_as_uint(rm),__float_as_uint(rm),false,false); rm=__builtin_fmaxf(__uint_as_float(rr[0]),__uint_as_float(rr[1])); } \
      resc=false; \
      if(__builtin_expect(__any(rm>(float)THRL),0)){ const float dl=__builtin_fmaxf(rm,0.f); mhat+=dl; \
        _Pragma("unroll") for(int r=0;r<16;++r){C0[r]-=dl;C1[r]-=dl;} \
        SETQE(); \
        const float f=__builtin_amdgcn_exp2f(-dl); l_reg*=f; if(hi==0)wsf[r32]=f; resc=true; } } \
    SBAR(); \
    GAPB(o[0]=__builtin_amdgcn_mfma_f32_32x32x16_bf16(PAF(0),VFR(0),o[0],0,0,0), C0,0); \
    GAPB(o[1]=__builtin_amdgcn_mfma_f32_32x32x16_bf16(PAF(0),VFR(4),o[1],0,0,0), C0,4); \
    KRD(GL,0); GAPB(o[0]=__builtin_amdgcn_mfma_f32_32x32x16_bf16(PAF(1),VFR(1),o[0],0,0,0), C0,8); \
    KRD(GL,1); GAPB(o[1]=__builtin_amdgcn_mfma_f32_32x32x16_bf16(PAF(1),VFR(5),o[1],0,0,0), C0,12); \
    KRD(GL,2); GAPB(o[0]=__builtin_amdgcn_mfma_f32_32x32x16_bf16(PAF(2),VFR(2),o[0],0,0,0), C1,0); \
    KRD(GL,3); GAPB(o[1]=__builtin_amdgcn_mfma_f32_32x32x16_bf16(PAF(2),VFR(6),o[1],0,0,0), C1,4); \
    if(GL){ XLD(sl_next); SBAR(); } GAPB(o[0]=__builtin_amdgcn_mfma_f32_32x32x16_bf16(PAF(3),VFR(3),o[0],0,0,0), C1,8); \
    GAPB(o[1]=__builtin_amdgcn_mfma_f32_32x32x16_bf16(PAF(3),VFR(7),o[1],0,0,0), C1,12); \
    }while(0)
  int t=1;
  #undef CMASK
  #define CMASK(P0,P1,t) do{}while(0)
  if(MODE==0) for(;t+5<NT;t+=2){
    STEP(pB0,pB1,pA0,pA1,t,true,true,true);     WAIT_BAR(3); RESC(); ROT();
    STEP(pA0,pA1,pB0,pB1,t+1,true,true,true);   WAIT_BAR(3); RESC(); ROT();
  }
  #undef CMASK
  #define CMASK(P0,P1,t) do{ if(MODE==1){BMASK(P0,P1,t);} else {int jb_=(t)-(NT-4); if(jb_>=0)cmask(P0,P1,jb_,qrel,hi);} }while(0)
  #define ENDW(tt) do{ if((tt)+3<NT){WAITB_A();} else if((tt)+2<NT){WAIT_BAR(1);} else {WAIT_BAR(0);} }while(0)
  for(;t+1<NT;t+=2){
    STEP(pB0,pB1,pA0,pA1,t,(t+3<NT),(t+1<NT),(t+1<NT));       ENDW(t);   RESC(); ROT();
    STEP(pA0,pA1,pB0,pB1,t+1,(t+4<NT),(t+2<NT),(t+2<NT));     ENDW(t+1); RESC(); ROT();
  }
  STEP(pB0,pB1,pA0,pA1,NT-1,false,false,false); RESC();
  { float sacc=pB0[0]+pB0[1]; _Pragma("unroll") for(int r=2;r<16;++r)sacc+=pB0[r]; _Pragma("unroll") for(int r=0;r<16;++r)sacc+=pB1[r]; l_reg+=sacc;
    pw0=(u32x4){PKW(pB0,0),PKW(pB0,2),PKW(pB0,4),PKW(pB0,6)};pw1=(u32x4){PKW(pB0,8),PKW(pB0,10),PKW(pB0,12),PKW(pB0,14)};pw2=(u32x4){PKW(pB1,0),PKW(pB1,2),PKW(pB1,4),PKW(pB1,6)};pw3=(u32x4){PKW(pB1,8),PKW(pB1,10),PKW(pB1,12),PKW(pB1,14)};
    SBAR(); pv(o,vb0+sl_cur,PAF(0),PAF(1),PAF(2),PAF(3)); }
  #undef PKW
  #undef PAF
  #undef VFR
  #undef PIN
  #undef MX3
  #undef GAPA
  #undef GAPB
  #undef EX
  #undef VRD
  #undef KRD
  #undef STEP
  #undef ENDW
  {auto rr=__builtin_amdgcn_permlane32_swap(__float_as_uint(l_reg),__float_as_uint(l_reg),false,false);l_reg=__uint_as_float(rr[0])+__uint_as_float(rr[1]);}
  if(hi==0)wsf[32+r32]=l_reg;asm volatile("s_waitcnt lgkmcnt(0)":::"memory");
  float rli[16];
  #pragma unroll
  for(int r=0;r<16;++r)rli[r]=__builtin_amdgcn_rcpf(wsf[32+crow(r,hi)]);
  bf16*Ow=O+(rowbase+q0+wid*QBLK)*DM+h*D;
  { bf16*stg=(bf16*)(shm+LDS_OST)+wid*2048;
    #pragma unroll
    for(int r=0;r<16;++r){const int orow=crow(r,hi);
      #pragma unroll
      for(int d0=0;d0<2;++d0)stg[orow*64+d0*32+r32]=__float2bfloat16(o[d0][r]*rli[r]);}
    asm volatile("s_waitcnt lgkmcnt(0)":::"memory");
    #pragma unroll
    for(int i=0;i<4;++i){const int row=i*8+(lane>>3),ch=lane&7; const u32x4 v=*(const u32x4*)(stg+row*64+ch*8); ATTN_STORE16(Ow+(long)row*DM+ch*8,v);} }
  asm volatile("s_waitcnt lgkmcnt(0)\n\ts_barrier":::"memory");
  #undef DMA_K
  #undef DMA_V
  #undef DMA_E
  #undef XLD
  #undef WAITB_A
  #undef QE
  #undef SETQE
  #undef BMASK
  #undef CMASK
  #undef START
  #undef RESC
  #undef ROT
}
constexpr int ATTN_LDS_BYTES=LDS_BYTES;
struct AttnTensors { const bf16* Q; const bf16* K; const bf16* V; bf16* O; const bf16* KX; const float* relb; };
struct AttnUnit { int bh; int qb; };
struct StaticOrder {
  int vcu;
  __device__ __forceinline__ explicit StaticOrder(int grid,int block):vcu((block%8)*(grid/8)+block/8){}
  __device__ __forceinline__ bool next(int i,AttnUnit&u)const{ if(i>=4)return false; const int s=vcu&7; u.bh=vcu>>3; u.qb=(i==0)?s:(i==1)?15-s:(i==2)?16+s:31-s; return true; }
  __device__ __forceinline__ bool next_band(int i,AttnUnit&u)const{ if(i>=4)return false; u.bh=vcu>>3; u.qb=(vcu&7)+8*i; return true; }
  __device__ __forceinline__ void a_ready(const AttnUnit&)const{}
  __device__ __forceinline__ void done(const AttnUnit&)const{}
};
template<int MODE,class Sched,int THRL=8> __device__ __forceinline__ void attn_phase(char*lds,const AttnTensors&T,const Sched&S){
  AttnUnit u;
  for(int i=0;(MODE==0?S.next(i,u):S.next_band(i,u));++i){ attn_unit<MODE,THRL>(u.bh/NHEAD,u.bh%NHEAD,u.qb,T.Q,T.K,T.V,T.O,lds,T.KX,T.relb+(MODE==1?(u.bh%NHEAD)*257:0)); }
}
#undef SBAR
#undef WAIT_BAR
}
namespace cg = cooperative_groups;
constexpr int NWAVES = 8;
#ifndef MK_PER_PHASE
#define MK_PER_PHASE 0
#endif
constexpr int N_PHASES = 12;
constexpr int MP = 16384, MS = 512, MT = MP + MS, DMODEL = 1024, DFF = 2816, NH = 16, SEQL = 8192;
constexpr int PAST = 1024, BPAST = 512, DECB = 32, DECT = 16;
constexpr size_t O_YP = 0, O_YS = 16777216, O_AKP = 17301504, O_AVP = 34078720, O_ALFP = 50855936, O_BKP = 51118080, O_BVP = 52166656,
                 O_AKS = 53215232, O_AVS = 53739520, O_ALFS = 54263808, O_BKS = 54272000, O_BVS = 71049216, O_END = 87826432;
constexpr size_t MiB = 1u << 20;
constexpr size_t WS_WQKV0 = 2 * MiB, WS_WO0 = 8 * MiB, WS_WGU0 = 10 * MiB, WS_WD0 = 21 * MiB, WS_WKVQ = 27 * MiB, WS_WO1 = 33 * MiB, WS_WGU1 = 35 * MiB, WS_WD1 = 46 * MiB;
constexpr size_t WS_SSP = 52 * MiB, SSP_STRIDE = 2 * MiB;
constexpr size_t WS_GS = 62 * MiB;
constexpr size_t WS_KX = 64 * MiB;
constexpr size_t WS_QO = 72 * MiB, WS_KB = 105 * MiB, WS_VB = 138 * MiB, WS_HB = 171 * MiB, WS_ACT = 204 * MiB, WS_END = 296 * MiB;
static_assert(WS_ACT + (size_t)MT * DFF * 2 <= WS_END && WS_QO + (size_t)MT * DMODEL * 2 <= WS_KB, "d_ws map");
constexpr int RING_BYTES = 131072, LDS_BYTES = 147456;
static_assert(attn_body::ATTN_LDS_BYTES <= RING_BYTES, "attention LDS");

#define GAS __attribute__((address_space(1)))
#define LAS __attribute__((address_space(3)))
typedef unsigned short bf16;
typedef unsigned v4u __attribute__((ext_vector_type(4)));
typedef float f32x4 __attribute__((ext_vector_type(4)));
typedef short bf16x8 __attribute__((ext_vector_type(8)));
#define LDS_WAIT() asm volatile("s_waitcnt lgkmcnt(0)" ::: "memory")
__device__ __forceinline__ unsigned f2bf(float f) { unsigned u = __builtin_bit_cast(unsigned, f); return (u + 0x7fffu + ((u >> 16) & 1u)) >> 16; }
__device__ __forceinline__ unsigned pk2(float lo, float hi) { return f2bf(lo) | (f2bf(hi) << 16); }
__device__ __forceinline__ float bf2f(unsigned short b) { return __uint_as_float((unsigned)b << 16); }

__device__ __forceinline__ void p0_transpose_item(const float* W, int ldw, int csrc, int k0, const float* gain, bf16* WT, int K, int drow, LAS float* scr, int lane) {
    float wv[32]; const float gl = gain ? gain[k0 + lane] : 1.f;
#pragma unroll
    for (int i = 0; i < 32; ++i) wv[i] = W[(size_t)(k0 + 2 * i + (lane >> 5)) * ldw + csrc + (lane & 31)];
#pragma unroll
    for (int i = 0; i < 32; ++i) { const int kk = 2 * i + (lane >> 5); scr[kk * 33 + (lane & 31)] = wv[i] * __shfl(gl, kk); }
    LDS_WAIT(); asm volatile("" ::: "memory");
    const int c = lane & 7;
#pragma unroll
    for (int j = 0; j < 4; ++j) { const int n = (lane >> 3) + 8 * j; const LAS float* s = scr + (8 * c) * 33 + n;
        v4u o; o.x = pk2(s[0 * 33], s[1 * 33]); o.y = pk2(s[2 * 33], s[3 * 33]); o.z = pk2(s[4 * 33], s[5 * 33]); o.w = pk2(s[6 * 33], s[7 * 33]);
        *(v4u*)(WT + (size_t)(drow + n) * K + k0 + 8 * c) = o; }
    LDS_WAIT(); asm volatile("" ::: "memory");
}
struct KArgs { const float* in[20]; float* out; unsigned char* ws; int ph_lo, ph_hi; };

__device__ __forceinline__ void p0_weight_item(const KArgs& a, int it, LAS float* scr, int lane) {
    unsigned char* ws = a.ws;
    constexpr int I_QKV = 16 * 96, I_O = 16 * 32, I_GU = 16 * 176, I_D = 44 * 32, I_Q1 = 16 * 32, I_KV = 16 * 64;
    const float* W; int ldw, ncols, K, roff = 0; const float* gain = nullptr; bf16* dst; bool perm = false;
    int r = it;
    if (r < I_QKV) { W = a.in[8]; ldw = 3088; ncols = 3072; K = 1024; gain = a.in[7]; dst = (bf16*)(ws + WS_WQKV0); }
    else if ((r -= I_QKV) < I_O) { W = a.in[10]; ldw = 1024; ncols = 1024; K = 1024; dst = (bf16*)(ws + WS_WO0); }
    else if ((r -= I_O) < I_GU) { W = a.in[17]; ldw = 5632; ncols = 5632; K = 1024; gain = a.in[16]; dst = (bf16*)(ws + WS_WGU0); perm = true; }
    else if ((r -= I_GU) < I_D) { W = a.in[18]; ldw = 1024; ncols = 1024; K = 2816; dst = (bf16*)(ws + WS_WD0); }
    else if ((r -= I_D) < I_Q1) { W = a.in[11]; ldw = 1024; ncols = 1024; K = 1024; gain = a.in[7] + 1024; dst = (bf16*)(ws + WS_WKVQ); }
    else if ((r -= I_Q1) < I_KV) { W = a.in[15]; ldw = 2048; ncols = 2048; K = 1024; gain = a.in[14]; dst = (bf16*)(ws + WS_WKVQ); roff = 1024; }
    else if ((r -= I_KV) < I_O) { W = a.in[13]; ldw = 1024; ncols = 1024; K = 1024; dst = (bf16*)(ws + WS_WO1); }
    else if ((r -= I_O) < I_GU) { W = a.in[17] + (size_t)1024 * 5632; ldw = 5632; ncols = 5632; K = 1024; gain = a.in[16] + 1024; dst = (bf16*)(ws + WS_WGU1); perm = true; }
    else { r -= I_GU; W = a.in[18] + (size_t)2816 * 1024; ldw = 1024; ncols = 1024; K = 2816; dst = (bf16*)(ws + WS_WD1); }
    const int nblk = ncols / 32, kb = r / nblk, nb = r % nblk, n0 = 32 * nb;
    int drow = roff + n0;
    if (perm) { drow = n0 < 2816 ? 256 * (n0 / 128) + (n0 % 128) : 256 * ((n0 - 2816) / 128) + 128 + ((n0 - 2816) % 128); }
    p0_transpose_item(W, ldw, n0, 64 * kb, gain, dst, K, drow, scr, lane);
}
constexpr int P0_NITEMS = 16 * 96 + 16 * 32 + 16 * 176 + 44 * 32 + 16 * 32 + 16 * 64 + 16 * 32 + 16 * 176 + 44 * 32;

__device__ __forceinline__ void p0_row_group(const KArgs& a, int g, const LAS unsigned char* wf, int lane) {
    const int fr = lane & 15, fq = lane >> 4;
    const int row = g * 16 + fr;
    const float* xr = (g < 1024 ? a.in[0] + (size_t)row * 1024 : a.in[1] + (size_t)(row - MP) * 1024) + 8 * fq;
    bf16* hb = (bf16*)(a.ws + WS_HB) + (size_t)row * 1024 + 8 * fq;
    f32x4 acc = {0.f, 0.f, 0.f, 0.f}; float ss = 0.f;
#pragma unroll 4
    for (int ks = 0; ks < 32; ++ks) {
        const f32x4 x0 = *(const f32x4*)(xr + 32 * ks), x1 = *(const f32x4*)(xr + 32 * ks + 4);
        ss += (x0[0] * x0[0] + x0[1] * x0[1]) + (x0[2] * x0[2] + x0[3] * x0[3]) + (x1[0] * x1[0] + x1[1] * x1[1]) + (x1[2] * x1[2] + x1[3] * x1[3]);
        v4u w; w.x = pk2(x0[0], x0[1]); w.y = pk2(x0[2], x0[3]); w.z = pk2(x1[0], x1[1]); w.w = pk2(x1[2], x1[3]);
        *(v4u*)(hb + 32 * ks) = w;
        const bf16x8 bfrag = *(const LAS bf16x8*)(wf + (ks * 64 + lane) * 16);
        acc = __builtin_amdgcn_mfma_f32_16x16x32_bf16(bfrag, __builtin_bit_cast(bf16x8, w), acc, 0, 0, 0);
    }
    ss += __shfl_xor(ss, 16); ss += __shfl_xor(ss, 32);
    float* ssp = (float*)(a.ws + WS_SSP) + (size_t)row * 16 + 4 * fq;
    *(f32x4*)ssp = (f32x4){fq == 0 ? ss : 0.f, 0.f, 0.f, 0.f};
    const float rstd = 1.0f / sqrtf(ss * (1.0f / 1024.0f) + 1e-6f);
    const f32x4 bf = *(const f32x4*)(a.in[9] + 4 * fq);
    f32x4 lf;
#pragma unroll
    for (int e = 0; e < 4; ++e) { const float z = acc[e] * rstd + bf[e]; lf[e] = fminf(z, 0.f) - log1pf(expf(-fabsf(z))); }
    float* lo = (g < 1024 ? a.out + O_ALFP + (size_t)row * 16 : a.out + O_ALFS + (size_t)(row - MP) * 16) + 4 * fq;
    *(f32x4*)lo = lf;
    if (g < 1024) {
#pragma unroll
        for (int o = 1; o < 16; o <<= 1) { lf[0] += __shfl_xor(lf[0], o); lf[1] += __shfl_xor(lf[1], o); lf[2] += __shfl_xor(lf[2], o); lf[3] += __shfl_xor(lf[3], o); }
        if (fr == 0) *(f32x4*)((float*)(a.ws + WS_GS) + g * 16 + 4 * fq) = lf;
    }
}

__device__ __forceinline__ void p1_scan(const KArgs& a, int v, LAS float* red, int tid) {
    const int batch = v >> 7, g0 = batch * 512, g1 = 4 * v, h = tid & 15, part = tid >> 4;
    const float* gs = (const float*)(a.ws + WS_GS);
    float s = 0.f;
    for (int g = g0 + part; g < g1; g += 32) s += gs[g * 16 + h];
    red[part * 16 + h] = s;
    __syncthreads();
    LAS float* lfs = red + 512;
    for (int e = tid; e < 1024; e += 512) lfs[e] = a.out[O_ALFP + (size_t)(64 * v) * 16 + e];
    __syncthreads();
    if (tid < 16) {
        float cum = 0.f;
        for (int p = 0; p < 32; ++p) cum += red[p * 16 + tid];
        bf16* kx = (bf16*)(a.ws + WS_KX) + ((size_t)(batch * 16 + tid) * 2 * SEQL) * 8;
        const int t0 = (64 * v) & (SEQL - 1);
#pragma unroll 8
        for (int r = 0; r < 64; ++r) {
            cum += lfs[r * 16 + tid];
            const float c = -cum * 1.4426950408889634f;
            const unsigned c1 = f2bf(c); const float r1 = c - bf2f((unsigned short)c1);
            const unsigned c2 = f2bf(r1); const float r2 = r1 - bf2f((unsigned short)c2);
            const unsigned c3 = f2bf(r2);
            *(v4u*)(kx + (size_t)(t0 + r) * 8) = (v4u){c1 | (c2 << 16), c3 | 0x3F800000u, 0x3F803F80u, 0u};
            *(v4u*)(kx + (size_t)(SEQL + t0 + r) * 8) = (v4u){0u, 0u, 0u, 0u};
        }
    }
    __syncthreads();
}

template <int MODE> __device__ __forceinline__ void sample_attn(const KArgs& a, int b, int h, LAS unsigned char* lds, int tid) {
    constexpr int NC = MODE == 0 ? PAST : BPAST, NK = NC + 16, NKP = 1056;
    constexpr float L2E = 1.4426950408889634f;
    LAS float* S = (LAS float*)lds;
    LAS float* Qs = S + 16 * NKP;
    LAS float* bias = Qs + 1024;
    LAS float* Op = bias + NKP;
    LAS float* rl = Op + 8 * 1024;
    const int lane = tid & 63, wid = __builtin_amdgcn_readfirstlane(tid >> 6);
    const float* ck = a.in[MODE == 0 ? 2 : 5]; const float* cv = a.in[MODE == 0 ? 3 : 6];
    const float* nk = a.out + (MODE == 0 ? O_AKS + (size_t)(b * 16) * 1024 : O_BKS + (size_t)(b * 512 + 496) * 1024) + h * 64;
    const float* nv = a.out + (MODE == 0 ? O_AVS + (size_t)(b * 16) * 1024 : O_BVS + (size_t)(b * 512 + 496) * 1024) + h * 64;
    const bf16* qo = (const bf16*)(a.ws + WS_QO) + (size_t)(MP + b * 16) * 1024 + h * 64;
    if (tid < 128) { const int q = tid >> 3, c = tid & 7; const v4u w = *(const v4u*)(qo + (size_t)q * 1024 + 8 * c);
        LAS float* d = Qs + q * 64 + 8 * c; d[0] = bf2f(w.x & 0xffff); d[1] = bf2f(w.x >> 16); d[2] = bf2f(w.y & 0xffff); d[3] = bf2f(w.y >> 16); d[4] = bf2f(w.z & 0xffff); d[5] = bf2f(w.z >> 16); d[6] = bf2f(w.w & 0xffff); d[7] = bf2f(w.w >> 16); }
    if (MODE == 0) {
        for (int j = tid; j < NK; j += 512) bias[j] = j < NC ? a.in[4][((size_t)b * NC + j) * 16 + h] : a.out[O_ALFS + (size_t)(b * 16 + (j - NC)) * 16 + h];
    } else {
        if (tid < 257) bias[tid] = a.in[12][h * 257 + tid] * L2E;
    }
    __syncthreads();
    if (MODE == 0) {
        if (wid == 0) { float carry = 0.f;
            for (int c = 0; c < (NK + 63) / 64; ++c) { const int j = 64 * c + lane; float v = j < NK ? bias[j] : 0.f;
#pragma unroll
                for (int o = 1; o < 64; o <<= 1) { const float t = __shfl_up(v, o); if (lane >= o) v += t; }
                v += carry; carry = __shfl(v, 63); if (j < NK) bias[j] = -v * L2E; } }
        __syncthreads();
    }
    for (int g = wid; g <= NC / 64; g += 8) {
        const bool isnew = g == NC / 64; const int j = 64 * g + lane;
        if (isnew && lane >= 16) continue;
        const float* kr = isnew ? nk + (size_t)lane * 1024 : ck + (((size_t)b * NC + j) * 16 + h) * 64;
        f32x4 k4[16];
#pragma unroll
        for (int i = 0; i < 16; ++i) k4[i] = *(const f32x4*)(kr + 4 * i);
        if (MODE == 1 && !isnew && j >= 16) { float* ok = a.out + O_BKS + (((size_t)b * 512 + (j - 16)) * 16 + h) * 64;
#pragma unroll
            for (int i = 0; i < 16; ++i) *(f32x4*)(ok + 4 * i) = k4[i]; }
#pragma unroll 2
        for (int q = 0; q < 16; ++q) { float s = 0.f;
#pragma unroll
            for (int i = 0; i < 16; ++i) { const f32x4 qv = *(const LAS f32x4*)(Qs + q * 64 + 4 * i); s += (qv[0] * k4[i][0] + qv[1] * k4[i][1]) + (qv[2] * k4[i][2] + qv[3] * k4[i][3]); }
            if (MODE == 0) { s += bias[j]; if (isnew && lane > q) s = -INFINITY; }
            else { const int d = 512 + q - j; s += bias[(d < 128 ? d : 128) + 128]; }
            S[q * NKP + j] = s; }
    }
    __syncthreads();
    for (int q = 2 * wid; q < 2 * wid + 2; ++q) { float m = -INFINITY;
        for (int j = lane; j < NK; j += 64) m = fmaxf(m, S[q * NKP + j]);
#pragma unroll
        for (int o = 1; o < 64; o <<= 1) m = fmaxf(m, __shfl_xor(m, o));
        float l = 0.f;
        for (int j = lane; j < NK; j += 64) { const float p = __builtin_amdgcn_exp2f(S[q * NKP + j] - m); S[q * NKP + j] = p; l += p; }
#pragma unroll
        for (int o = 1; o < 64; o <<= 1) l += __shfl_xor(l, o);
        if (lane == 0) rl[q] = 1.0f / l; }
    __syncthreads();
    { float acc[16];
#pragma unroll
        for (int q = 0; q < 16; ++q) acc[q] = 0.f;
        for (int c = wid; c < NK / 16; c += 8) { const int j0 = 16 * c; float v[16];
#pragma unroll
            for (int u = 0; u < 16; ++u) { const int j = j0 + u; v[u] = j0 < NC ? cv[(((size_t)b * NC + j) * 16 + h) * 64 + lane] : nv[(size_t)(j - NC) * 1024 + lane]; }
            if (MODE == 1 && j0 < NC) {
#pragma unroll
                for (int u = 0; u < 16; ++u) { const int j = j0 + u; if (j >= 16) a.out[O_BVS + (((size_t)b * 512 + (j - 16)) * 16 + h) * 64 + lane] = v[u]; } }
#pragma unroll
            for (int q = 0; q < 16; ++q) {
#pragma unroll
                for (int u4 = 0; u4 < 4; ++u4) { const f32x4 p = *(const LAS f32x4*)(S + q * NKP + j0 + 4 * u4);
                    acc[q] += (p[0] * v[4 * u4] + p[1] * v[4 * u4 + 1]) + (p[2] * v[4 * u4 + 2] + p[3] * v[4 * u4 + 3]); } } }
#pragma unroll
        for (int q = 0; q < 16; ++q) Op[(wid * 16 + q) * 64 + lane] = acc[q]; }
    __syncthreads();
    for (int e = tid; e < 1024; e += 512) { const int q = e >> 6, d = e & 63; float o = 0.f;
#pragma unroll
        for (int w = 0; w < 8; ++w) o += Op[(w * 16 + q) * 64 + d];
        ((bf16*)(a.ws + WS_QO))[(size_t)(MP + b * 16 + q) * 1024 + h * 64 + d] = (bf16)f2bf(o * rl[q]); }
    __syncthreads();
}

#define RLX_AGENT __ATOMIC_RELAXED, __HIP_MEMORY_SCOPE_AGENT
#define XB_TMO      128
#define XB_XCNT(j)  (256  + 64 * (j))
#define XB_XSUB(j)  (1280 + 64 * (j))
#define XB_XGEN(j)  (2304 + 64 * (j))
#define XB_TOP      3328
#define XB_TOPGEN   3392
#define XCD_BAR_WORDS 3456
#define XB_SPIN_CAP (1u << 18)

__device__ __forceinline__ unsigned xb_ld(unsigned* p)              { return __hip_atomic_load(p, __ATOMIC_RELAXED, __HIP_MEMORY_SCOPE_AGENT); }
__device__ __forceinline__ unsigned xb_add(unsigned* p, unsigned v) { return __hip_atomic_fetch_add(p, v, __ATOMIC_RELAXED, __HIP_MEMORY_SCOPE_AGENT); }
__device__ __forceinline__ unsigned xb_xcc_id() { return (unsigned)__builtin_amdgcn_s_getreg((3 << 11) | 20) & 0xFu; }
#define XB_SPIN(cond, bar) do { unsigned _sp = 0; while (cond) { __builtin_amdgcn_s_sleep(1); \
    if ((++_sp & 255u) == 0u) { if (xb_ld(&(bar)[XB_TMO])) break; if (_sp > XB_SPIN_CAP) { atomicAdd(&(bar)[XB_TMO], 1u); break; } } } } while (0)

struct XcdBarrier {
    unsigned* bar; unsigned x;
    volatile LAS unsigned* st;
};

__device__ __forceinline__ XcdBarrier xcd_barrier_post(unsigned* bar, volatile LAS unsigned* st) {
    XcdBarrier b; b.bar = bar; b.x = xb_xcc_id(); b.st = st;
    if (threadIdx.x == 0) (void)xb_add(&bar[XB_XCNT(b.x)], 1u);
    return b;
}
__device__ __forceinline__ void xcd_barrier_complete(unsigned* bar, unsigned x, unsigned& nloc, unsigned& nx) {
    const unsigned G = gridDim.x * gridDim.y * gridDim.z;
    unsigned sum, cnt, mine, sp = 0u;
    for (;;) {
        sum = 0u; cnt = 0u; mine = 0u;
#pragma unroll
        for (unsigned j = 0; j < 16; ++j) { const unsigned c = xb_ld(&bar[XB_XCNT(j)]); sum += c; cnt += (c > 0u) ? 1u : 0u; mine = (j == x) ? c : mine; }
        if (sum == G) break;
        __builtin_amdgcn_s_sleep(1);
        if ((++sp & 255u) == 0u) { if (xb_ld(&bar[XB_TMO])) break; if (sp > XB_SPIN_CAP) { atomicAdd(&bar[XB_TMO], 1u); break; } }
    }
    nloc = mine > 0u ? mine : 1u; nx = cnt > 0u ? cnt : 1u;
}

__device__ __forceinline__ void xcd_barrier(const XcdBarrier& b) {
    asm volatile("s_waitcnt vmcnt(0)" ::: "memory");
    __syncthreads();
    if (threadIdx.x == 0) {
        unsigned* bar = b.bar;
        __builtin_amdgcn_s_waitcnt(0);
        unsigned nloc = b.st[0], nx = b.st[1];
        if (nloc == 0u) { xcd_barrier_complete(bar, b.x, nloc, nx); b.st[0] = nloc; b.st[1] = nx; }
        const unsigned old = xb_add(&bar[XB_XSUB(b.x)], 1u);
        const unsigned gen = old / nloc;
        if (old + 1u == (gen + 1u) * nloc) {
            __builtin_amdgcn_fence(__ATOMIC_RELEASE, "agent");
            asm volatile("s_waitcnt vmcnt(0)" ::: "memory");
            const unsigned og = xb_add(&bar[XB_TOP], 1u);
            const unsigned tg = og / nx;
            if (og + 1u == (tg + 1u) * nx) xb_add(&bar[XB_TOPGEN], 1u);
            else XB_SPIN(xb_ld(&bar[XB_TOPGEN]) == tg, bar);
            __builtin_amdgcn_fence(__ATOMIC_ACQUIRE, "agent");
            xb_add(&bar[XB_XGEN(b.x)], 1u);
            asm volatile("s_waitcnt vmcnt(0)" ::: "memory");
        } else {
            XB_SPIN(xb_ld(&bar[XB_XGEN(b.x)]) == gen, bar);
            __builtin_amdgcn_fence(__ATOMIC_ACQUIRE, "agent");
            asm volatile("s_waitcnt vmcnt(0)" ::: "memory");
        }
    }
    __syncthreads();
}

__device__ __forceinline__ KArgs load_args() {
#if !defined(__HIP_DEVICE_COMPILE__)
    return KArgs{};
#else
    auto p = __builtin_amdgcn_kernarg_segment_ptr(); asm volatile("" : "+s"(p)); return *(const __attribute__((address_space(4))) KArgs*)p;
#endif
}
__global__ void __launch_bounds__(NWAVES * 64, 2) fwd_mega(KArgs args_unused) {
    extern __shared__ __attribute__((aligned(16))) unsigned char lds[];
    LAS unsigned char* L = (LAS unsigned char*)lds;
    const int G = gridDim.x, bx = blockIdx.x, vcu = (G % 8 == 0) ? (bx % 8) * (G / 8) + bx / 8 : bx;
    int lo, hi; XcdBarrier xbar;
    { const KArgs a0 = load_args(); lo = a0.ph_lo; hi = a0.ph_hi;
      volatile LAS unsigned* st = (volatile LAS unsigned*)(L + RING_BYTES + 1024); if (threadIdx.x < 2) st[threadIdx.x] = 0u; __syncthreads();
      xbar = xcd_barrier_post((unsigned*)a0.ws + 4096, st); }
    if (hi > N_PHASES) cg::this_grid().sync();
#ifndef PHMASK
#define PHMASK 0xfff
#endif
#define IN(k) (((PHMASK >> (k)) & 1) && lo <= (k) && (k) < hi)
#define SEAM(k) do { if (IN(k) && IN((k) + 1)) { xcd_barrier(xbar); } } while (0)
#ifndef PROBE_MASK
#define PROBE_MASK 0
#endif
#define SEG_BEGIN(k) unsigned long long seg_t0_ = 0; if ((PROBE_MASK >> (k)) & 1) seg_t0_ = __builtin_amdgcn_s_memrealtime()
#define SEG_END(k) do { if ((PROBE_MASK >> (k)) & 1) { const unsigned long long t1_ = __builtin_amdgcn_s_memrealtime(), d_ = t1_ - seg_t0_; while (__builtin_amdgcn_s_memrealtime() - t1_ < d_) __builtin_amdgcn_s_sleep(8); } } while (0)
#define PHASE_ARGS() int tid = threadIdx.x; asm volatile("" : "+v"(tid)); const int lane = tid & 63, wave = __builtin_amdgcn_readfirstlane(tid >> 6); (void)lane; (void)wave; const KArgs args = load_args(); unsigned char* ws = args.ws; float* out = args.out; (void)out; \
    bf16* QO = (bf16*)(ws + WS_QO); bf16* KB = (bf16*)(ws + WS_KB); bf16* VB = (bf16*)(ws + WS_VB); bf16* HB = (bf16*)(ws + WS_HB); bf16* ACT = (bf16*)(ws + WS_ACT); (void)QO; (void)KB; (void)VB; (void)HB; (void)ACT
#define SSPN(i) ((float*)(ws + WS_SSP + (size_t)(i) * SSP_STRIDE))

    if (IN(0)) {
        PHASE_ARGS();
        SEG_BEGIN(0);
        LAS unsigned char* wf = L + 98304;
        for (int e = tid; e < 32 * 64; e += NWAVES * 64) { const int ks = e >> 6, ln = e & 63, h = ln & 15, kq = ln >> 4, k0 = 32 * ks + 8 * kq; float v[8];
#pragma unroll
            for (int i = 0; i < 8; ++i) v[i] = args.in[8][(size_t)(k0 + i) * 3088 + 3072 + h] * args.in[7][k0 + i];
            *(LAS v4u*)(wf + e * 16) = (v4u){pk2(v[0], v[1]), pk2(v[2], v[3]), pk2(v[4], v[5]), pk2(v[6], v[7])}; }
        __syncthreads();
        { const int g = wave * G + vcu; if (g < MT / 16) p0_row_group(args, g, wf, lane); }
        LAS float* scr = (LAS float*)(L + wave * 8704);
        const int gw = vcu * NWAVES + wave, NGW = G * NWAVES;
        for (int it = gw; it < P0_NITEMS; it += NGW) p0_weight_item(args, it, scr, lane);
        SEG_END(0);
    }
    SEAM(0);
    if (IN(1)) {
        PHASE_ARGS();
        SEG_BEGIN(1);
        p1_scan(args, vcu, (LAS float*)L, tid);
        pg8::Gemm g{HB, (const bf16*)(ws + WS_WQKV0), MT, 3072, 1024}; pg8::StaticOrder S; S.init(MT, 3072, G, bx);
        pg8::EpiQKV E{QO, KB, VB, out + O_AKP, out + O_AVP, out + O_AKS, out + O_AVS, SSPN(0), 0, attn_body::C2};
        pg8::gemm_phase<pg8::EpiQKV, pg8::StaticOrder, PG8_ALIGN, PG8_SP2>(L, g, S, E);
        SEG_END(1);
    }
    SEAM(1);
    if (IN(2)) {
        PHASE_ARGS();
        SEG_BEGIN(2);
        { SEG_BEGIN(12); for (int i = 0; i < 2; ++i) { const int u = 2 * vcu + i; if (u < DECB * NH) sample_attn<0>(args, u >> 4, u & 15, L, tid); } SEG_END(12); }
        const attn_body::AttnTensors AT{(const attn_body::bf16*)QO, (const attn_body::bf16*)KB, (const attn_body::bf16*)VB, (attn_body::bf16*)QO, (const attn_body::bf16*)(ws + WS_KX), args.in[12]};
        const attn_body::StaticOrder S(G, bx);
        attn_body::attn_phase<0, attn_body::StaticOrder>((char*)lds, AT, S);
        SEG_END(2);
    }
    SEAM(2);
    if (IN(3)) {
        PHASE_ARGS();
        SEG_BEGIN(3);
        pg8::Gemm g{QO, (const bf16*)(ws + WS_WO0), MT, 1024, 1024}; pg8::StaticOrder S; S.init(MT, 1024, G, bx);
        pg8::EpiRes E{args.in[0], args.in[1], out, HB, SSPN(1)};
        pg8::gemm_phase<pg8::EpiRes, pg8::StaticOrder, PG8_ALIGN, PG8_SP2>(L, g, S, E);
        SEG_END(3);
    }
    SEAM(3);
    if (IN(4)) {
        PHASE_ARGS();
        SEG_BEGIN(4);
        pg8::Gemm g{HB, (const bf16*)(ws + WS_WGU0), MT, 5632, 1024}; pg8::StaticOrder S; S.init(MT, 5632, G, bx);
        pg8::EpiSwiGLU E{ACT, SSPN(1)};
        pg8::gemm_phase<pg8::EpiSwiGLU, pg8::StaticOrder, PG8_ALIGN, PG8_SP2>(L, g, S, E);
        SEG_END(4);
    }
    SEAM(4);
    if (IN(5)) {
        PHASE_ARGS();
        SEG_BEGIN(5);
        pg8::Gemm g{ACT, (const bf16*)(ws + WS_WD0), MT, 1024, 2816}; pg8::StaticOrder S; S.init(MT, 1024, G, bx);
        pg8::EpiRes E{out, out + (size_t)MP * 1024, out, HB, SSPN(2)};
        pg8::gemm_phase<pg8::EpiRes, pg8::StaticOrder, PG8_ALIGN, PG8_SP2>(L, g, S, E);
        SEG_END(5);
    }
    SEAM(5);
    if (IN(6)) {
        PHASE_ARGS();
        SEG_BEGIN(6);
        pg8::Gemm g{HB, (const bf16*)(ws + WS_WKVQ), MT, 3072, 1024}; pg8::StaticOrder S; S.init(MT, 3072, G, bx);
        pg8::EpiQKV E{QO, KB, VB, out + O_BKP, out + O_BVP, out + O_BKS, out + O_BVS, SSPN(2), 1, attn_body::C2};
        pg8::gemm_phase<pg8::EpiQKV, pg8::StaticOrder, PG8_ALIGN, PG8_SP2>(L, g, S, E);
        SEG_END(6);
    }
    SEAM(6);
    if (IN(7)) {
        PHASE_ARGS();
        SEG_BEGIN(7);
        { SEG_BEGIN(13); for (int i = 0; i < 2; ++i) { const int u = 2 * vcu + i; if (u < DECB * NH) sample_attn<1>(args, u >> 4, u & 15, L, tid); } SEG_END(13); }
        const attn_body::AttnTensors AT{(const attn_body::bf16*)QO, (const attn_body::bf16*)KB, (const attn_body::bf16*)VB, (attn_body::bf16*)QO, (const attn_body::bf16*)(ws + WS_KX), args.in[12]};
        const attn_body::StaticOrder S(G, bx);
        attn_body::attn_phase<1, attn_body::StaticOrder>((char*)lds, AT, S);
        SEG_END(7);
    }
    SEAM(7);
    if (IN(8)) {
        PHASE_ARGS();
        SEG_BEGIN(8);
        pg8::Gemm g{QO, (const bf16*)(ws + WS_WO1), MT, 1024, 1024}; pg8::StaticOrder S; S.init(MT, 1024, G, bx);
        pg8::EpiRes E{out, out + (size_t)MP * 1024, out, HB, SSPN(3)};
        pg8::gemm_phase<pg8::EpiRes, pg8::StaticOrder, PG8_ALIGN, PG8_SP2>(L, g, S, E);
        SEG_END(8);
    }
    SEAM(8);
    if (IN(9)) {
        PHASE_ARGS();
        SEG_BEGIN(9);
        pg8::Gemm g{HB, (const bf16*)(ws + WS_WGU1), MT, 5632, 1024}; pg8::StaticOrder S; S.init(MT, 5632, G, bx);
        pg8::EpiSwiGLU E{ACT, SSPN(3)};
        pg8::gemm_phase<pg8::EpiSwiGLU, pg8::StaticOrder, PG8_ALIGN, PG8_SP2>(L, g, S, E);
        SEG_END(9);
    }
    SEAM(9);
    if (IN(10)) {
        PHASE_ARGS();
        SEG_BEGIN(10);
        pg8::Gemm g{ACT, (const bf16*)(ws + WS_WD1), MT, 1024, 2816}; pg8::StaticOrder S; S.init(MT, 1024, G, bx);
        pg8::EpiRes E{out, out + (size_t)MP * 1024, out, HB, SSPN(4)};
        pg8::gemm_phase<pg8::EpiRes, pg8::StaticOrder, PG8_ALIGN, PG8_SP2>(L, g, S, E);
        SEG_END(10);
    }
    SEAM(10);
    if (IN(11)) {
        PHASE_ARGS();
        SEG_BEGIN(11);
        const int gw = vcu * NWAVES + wave, NGW = G * NWAVES; const float* gf = args.in[19]; const float* ssp = SSPN(4);
        f32x4 gv[4];
#pragma unroll
        for (int j = 0; j < 4; ++j) gv[j] = *(const f32x4*)(gf + 256 * j + 4 * lane);
        for (int m = gw; m < MT; m += NGW) {
            float s = 0.f;
#pragma unroll
            for (int j = 0; j < 4; ++j) { const f32x4 p = *(const f32x4*)(ssp + (size_t)m * 16 + 4 * j); s += (p[0] + p[1]) + (p[2] + p[3]); }
            const float rstd = 1.0f / sqrtf(s * (1.0f / 1024.0f) + 1e-6f);
            float* r = out + (size_t)m * 1024 + 4 * lane;
#pragma unroll
            for (int j = 0; j < 4; ++j) { f32x4 v = *(f32x4*)(r + 256 * j); v = v * rstd * gv[j]; *(f32x4*)(r + 256 * j) = v; }
        }
        SEG_END(11);
    }
#undef IN
#undef SEAM
}

extern "C" void kernel_launch(void* const* d_in, const int* in_sizes, int n_in, void* d_out, int out_size, void* d_ws, size_t ws_size, hipStream_t stream) {
    static int grid = 0;
    if (grid == 0) {
        if (n_in != 20 || (size_t)out_size != O_END || ws_size < WS_END) { fprintf(stderr, "kernel_launch: unexpected shapes (n_in %d out %d ws %zu)\n", n_in, out_size, ws_size); grid = -1; return; }
        int dev = 0, cus = 0, per_cu = 0;
        hipGetDevice(&dev); hipDeviceGetAttribute(&cus, hipDeviceAttributeMultiprocessorCount, dev);
        if (hipFuncSetAttribute((const void*)fwd_mega, hipFuncAttributeMaxDynamicSharedMemorySize, LDS_BYTES) != hipSuccess) { fprintf(stderr, "kernel_launch: hipFuncSetAttribute failed\n"); grid = -1; return; }
        if (hipOccupancyMaxActiveBlocksPerMultiprocessor(&per_cu, (const void*)fwd_mega, NWAVES * 64, LDS_BYTES) != hipSuccess || per_cu < 1) { fprintf(stderr, "kernel_launch: occupancy query says %d\n", per_cu); per_cu = 1; }
        (void)hipGetLastError();
        grid = cus * per_cu;
        if (grid != 256) fprintf(stderr, "kernel_launch: grid %d (expected 256)\n", grid);
    }
    if (grid < 0) return;
    if (hipMemsetAsync(d_ws, 0, 65536, stream) != hipSuccess) { fprintf(stderr, "kernel_launch: memset failed\n"); return; }
    KArgs a{};
    for (int i = 0; i < 20; ++i) a.in[i] = (const float*)d_in[i];
    a.out = (float*)d_out; a.ws = (unsigned char*)d_ws;
#if MK_PER_PHASE
    for (int p = 0; p < N_PHASES; ++p) { a.ph_lo = p; a.ph_hi = p + 1; void* kargs[] = {&a};
        hipError_t e = hipLaunchCooperativeKernel((const void*)fwd_mega, dim3(grid), dim3(NWAVES * 64), kargs, LDS_BYTES, stream);
        if (e != hipSuccess) { fprintf(stderr, "kernel_launch: launch %d failed: %s\n", p, hipGetErrorString(e)); break; } }
#else
    a.ph_lo = 0; a.ph_hi = N_PHASES; void* kargs[] = {&a};
    hipError_t e = hipLaunchCooperativeKernel((const void*)fwd_mega, dim3(grid), dim3(NWAVES * 64), kargs, LDS_BYTES, stream);
    if (e != hipSuccess) fprintf(stderr, "kernel_launch: cooperative launch failed: %s (grid %d)\n", hipGetErrorString(e), grid);
#endif
}
```

```cpp
#include <hip/hip_cooperative_groups.h>
#include <hip/hip_runtime.h>
#include <cstdio>
#include <cstdint>
namespace pg8 {
#define PG8_LAS __attribute__((address_space(3)))
typedef unsigned short bf16_t;
typedef short bf16x8 __attribute__((ext_vector_type(8)));
typedef float f32x4 __attribute__((ext_vector_type(4)));
typedef unsigned u32x4 __attribute__((ext_vector_type(4)));
constexpr int BM = 256, BK = 64, HALF = 128, HTB = HALF * BK * 2  , STAGE_BYTES = 8 * HTB, NXCD = 8, WGM = 8;

__host__ __device__ __forceinline__ int lds_byte(int r, int c) { const int st = (r >> 4) * 2 + (c >> 5), rr = r & 15, cc = c & 31, ob = rr * 64 + cc * 2; return st * 1024 + (ob ^ (((ob >> 9) & 1) << 5)); }
__host__ __device__ __forceinline__ void stage_rc(int b, int& R, int& C) { const int st = b / 1024, sb = b % 1024, swz = sb ^ (((sb >> 9) & 1) << 5); R = (st >> 1) * 16 + swz / 64; C = (st & 1) * 32 + (swz % 64) / 2; }
__host__ __device__ __forceinline__ int perm32(int rho) { const int n = rho >> 4, i = rho & 15; return 8 * (i >> 2) + 4 * n + (i & 3); }

struct Unit { int pm, pn; };
struct Gemm { const bf16_t* A; const bf16_t* Bt; int M, N, K; };

struct StaticOrder {
    int nM, nN, nwg, G, c;
    __host__ __device__ void init(int M, int N, int G_, int c_) { nM = M / BM; nN = N / BM; nwg = nM * nN; G = G_; c = c_; }
    __host__ __device__ bool next(int i, Unit& u) const {
        const long L = (long)i * G + c; if (L >= nwg) return false;
        int wgid = (int)L; { const int q = nwg / NXCD, r = nwg % NXCD, xcd = wgid % NXCD, off = wgid / NXCD; wgid = (xcd < r ? xcd * (q + 1) : r * (q + 1) + (xcd - r) * q) + off; }
        const int nig = WGM * nN, gid = wgid / nig, fm = gid * WGM, gsz = (nM - fm) < WGM ? (nM - fm) : WGM;
        u.pm = fm + ((wgid % nig) % gsz); u.pn = (wgid % nig) / gsz; return true;
    }
    __device__ __forceinline__ void a_ready(const Unit&) const {}
    __device__ __forceinline__ void done(const Unit&) const {}
};

__device__ __forceinline__ unsigned cvt_pk_bf16(float lo, float hi) { unsigned r; asm volatile("v_cvt_pk_bf16_f32 %0, %1, %2" : "=v"(r) : "v"(lo), "v"(hi)); return r; }
constexpr int MP_ROWS = 16384;
constexpr float RMS_EPS = 1e-6f;
__device__ __forceinline__ void row_rstd(float (&rs)[2][4], const float* ssp, int row0, int fq) {
#pragma unroll
    for (int ai = 0; ai < 2; ++ai)
#pragma unroll
        for (int m = 0; m < 4; ++m) { const f32x4 p = *(const f32x4*)(ssp + (size_t)(row0 + ai * HALF + m * 16) * 16 + 4 * fq);
            float s = (p[0] + p[1]) + (p[2] + p[3]); s += __shfl_xor(s, 16); s += __shfl_xor(s, 32);
            rs[ai][m] = 1.0f / sqrtf(s * (1.0f / 1024.0f) + RMS_EPS); }
}
struct EpiQKV {
    static constexpr bool PERM = true, AFTER_DRAIN = false;
    bf16_t *Qb, *Kb, *Vb; float *kp, *vp, *ks, *vs; const float* ssp; int layer; float qscale;
    __device__ __forceinline__ long frow(int row) const {
        if (layer == 0) return row < MP_ROWS ? (long)row * 1024 : (long)(row - MP_ROWS) * 1024;
        if (row < MP_ROWS) { const int t = row & 8191, b = row >> 13; return t >= 7680 ? (long)(b * 512 + t - 7680) * 1024 : -1; }
        const int sr = row - MP_ROWS; return (long)((sr >> 4) * 512 + 496 + (sr & 15)) * 1024;
    }
    __device__ __forceinline__ void operator()(const f32x4 (&acc)[2][2][4][2], const Unit& u, int wr, int wc, int fr, int fq) const {
        const int t = u.pn >> 2, colt = (u.pn & 3) * BM, row0 = u.pm * BM + wr * 64 + fr, col0 = colt + wc * 32 + 8 * fq;
        float rs[2][4]; row_rstd(rs, ssp, row0, fq);
        bf16_t* const qb_ = Qb; bf16_t* const kb_ = Kb; bf16_t* const vb_ = Vb; float* const kp_ = kp; float* const vp_ = vp; float* const ks_ = ks; float* const vs_ = vs;
        bf16_t* B = t == 0 ? qb_ : (t == 1 ? kb_ : vb_); const float sc = t == 0 ? qscale : 1.f;
        const bool prow = u.pm < 64;
        float* fb = t == 1 ? (prow ? kp_ : ks_) : (prow ? vp_ : vs_);
        const bool anyf = t > 0 && (layer == 0 || !prow || (u.pm & 31) >= 30);
#pragma unroll
        for (int ai = 0; ai < 2; ++ai)
#pragma unroll
            for (int m = 0; m < 4; ++m) { const int row = row0 + ai * HALF + m * 16; const float r = rs[ai][m];
                const long fo = anyf ? frow(row) : -1;
#pragma unroll
                for (int bj = 0; bj < 2; ++bj) { f32x4 v0 = acc[ai][bj][m][0] * r, v1 = acc[ai][bj][m][1] * r;
                    if (fo >= 0) { float* fp = fb + fo + col0 + bj * HALF; *(f32x4*)fp = v0; *(f32x4*)(fp + 4) = v1; }
                    v0 = v0 * sc; v1 = v1 * sc; u32x4 w; w.x = cvt_pk_bf16(v0[0], v0[1]); w.y = cvt_pk_bf16(v0[2], v0[3]); w.z = cvt_pk_bf16(v1[0], v1[1]); w.w = cvt_pk_bf16(v1[2], v1[3]);
                    *(u32x4*)(B + (size_t)row * 1024 + col0 + bj * HALF) = w; } }
    }
};
struct EpiRes {
    static constexpr bool PERM = true, AFTER_DRAIN = false;
    const float *base_p, *base_s; float* H; bf16_t* HB; float* ssp;
    __device__ __forceinline__ void operator()(const f32x4 (&acc)[2][2][4][2], const Unit& u, int wr, int wc, int fr, int fq) const {
        const int col0 = u.pn * BM + wc * 32 + 8 * fq, rl0 = wr * 64 + fr;
        const float* base = u.pm < 64 ? base_p + (size_t)u.pm * BM * 1024 : base_s + (size_t)(u.pm - 64) * BM * 1024;
#pragma unroll
        for (int ai = 0; ai < 2; ++ai)
#pragma unroll
            for (int m = 0; m < 4; ++m) { const int rl = rl0 + ai * HALF + m * 16; const size_t row = (size_t)u.pm * BM + rl; float ss = 0.f;
#pragma unroll
                for (int bj = 0; bj < 2; ++bj) { const float* bp = base + (size_t)rl * 1024 + col0 + bj * HALF;
                    const f32x4 v0 = acc[ai][bj][m][0] + *(const f32x4*)bp, v1 = acc[ai][bj][m][1] + *(const f32x4*)(bp + 4);
                    ss += (v0[0] * v0[0] + v0[1] * v0[1]) + (v0[2] * v0[2] + v0[3] * v0[3]) + (v1[0] * v1[0] + v1[1] * v1[1]) + (v1[2] * v1[2] + v1[3] * v1[3]);
                    float* hp = H + row * 1024 + col0 + bj * HALF; *(f32x4*)hp = v0; *(f32x4*)(hp + 4) = v1;
                    u32x4 w; w.x = cvt_pk_bf16(v0[0], v0[1]); w.y = cvt_pk_bf16(v0[2], v0[3]); w.z = cvt_pk_bf16(v1[0], v1[1]); w.w = cvt_pk_bf16(v1[2], v1[3]);
                    *(u32x4*)(HB + row * 1024 + col0 + bj * HALF) = w; }
                ss += __shfl_xor(ss, 16); ss += __shfl_xor(ss, 32);
                if (fq == 0) ssp[row * 16 + u.pn * 4 + wc] = ss;
                if (m & 1) asm volatile("" ::: "memory"); }
    }
};
struct EpiSwiGLU {
    static constexpr bool PERM = true, AFTER_DRAIN = false;
    bf16_t* ACT; const float* ssp;
    __device__ __forceinline__ void operator()(const f32x4 (&acc)[2][2][4][2], const Unit& u, int wr, int wc, int fr, int fq) const {
        const int row0 = u.pm * BM + wr * 64 + fr, col0 = u.pn * HALF + wc * 32 + 8 * fq;
        float rs[2][4]; row_rstd(rs, ssp, row0, fq);
#pragma unroll
        for (int ai = 0; ai < 2; ++ai)
#pragma unroll
            for (int m = 0; m < 4; ++m) { const int row = row0 + ai * HALF + m * 16; const float r = rs[ai][m]; float o[8];
#pragma unroll
                for (int n = 0; n < 2; ++n)
#pragma unroll
                    for (int e = 0; e < 4; ++e) { const float g = acc[ai][0][m][n][e] * r, up = acc[ai][1][m][n][e] * r;
                        o[n * 4 + e] = g * __builtin_amdgcn_rcpf(1.0f + __builtin_amdgcn_exp2f(g * -1.4426950408889634f)) * up; }
                u32x4 w; w.x = cvt_pk_bf16(o[0], o[1]); w.y = cvt_pk_bf16(o[2], o[3]); w.z = cvt_pk_bf16(o[4], o[5]); w.w = cvt_pk_bf16(o[6], o[7]);
                *(u32x4*)(ACT + (size_t)row * 2816 + col0) = w; }
    }
};

template <class Epi, class Sched, bool ALIGN_EPI = false, bool SP2 = false>
__device__ __forceinline__ void gemm_phase(PG8_LAS unsigned char* lds, const Gemm g, const Sched& S, const Epi& E) {
    int tid_ = threadIdx.x; asm volatile("" : "+v"(tid_));
    const int tid = tid_, wid = __builtin_amdgcn_readfirstlane(tid >> 6), lane = tid & 63, wr = wid >> 2, wc = wid & 3, fr = lane & 15, fq = lane >> 4;
    const int K = g.K, nt = K / BK;
    unsigned voffA[2], voffB[2];
#pragma unroll
    for (int i = 0; i < 2; ++i) { int R, C; stage_rc(tid * 16 + i * 8192, R, C); const int Rb = Epi::PERM ? ((R & ~31) + perm32(R & 31)) : R;
        voffA[i] = (unsigned)(R * K + C) * 2u; voffB[i] = (unsigned)(Rb * K + C) * 2u; }
    const size_t kstep = (size_t)(BK * 2);
    const size_t hstep = (size_t)HALF * K * 2;
    const size_t tstep = 2 * hstep;
    const unsigned ldsw = (unsigned)wid * 1024u;
    const int aoff = lds_byte(wr * 64 + fr, fq * 8), boff = lds_byte(wc * 32 + fr, fq * 8);
#define PG8_SA(b, h) (((b) * 2 + (h)) * HTB)
#define PG8_SB(b, h) ((4 + (b) * 2 + (h)) * HTB)
#define PG8_STAGE(bufoff, gbase, voff) do { _Pragma("unroll") for (int _i = 0; _i < 2; ++_i) \
        __builtin_amdgcn_global_load_lds((const unsigned*)((const char*)(gbase) + (voff)[_i]), (PG8_LAS unsigned*)(lds + (bufoff) + ldsw + _i * 8192), 16, 0, 0); } while (0)
#define PG8_LDA(dst, b, h) do { _Pragma("unroll") for (int m = 0; m < 4; ++m) _Pragma("unroll") for (int k = 0; k < 2; ++k) dst[m][k] = *(const PG8_LAS bf16x8*)(lds + PG8_SA(b, h) + aoff + m * 2048 + k * 1024); } while (0)
#define PG8_LDB(dst, b, h) do { _Pragma("unroll") for (int n = 0; n < 2; ++n) _Pragma("unroll") for (int k = 0; k < 2; ++k) dst[n][k] = *(const PG8_LAS bf16x8*)(lds + PG8_SB(b, h) + boff + n * 2048 + k * 1024); } while (0)
#define PG8_MMA(ai, bj, At, Bt) do { __builtin_amdgcn_s_setprio(1); _Pragma("unroll") for (int m = 0; m < 4; ++m) _Pragma("unroll") for (int n = 0; n < 2; ++n) _Pragma("unroll") for (int k = 0; k < 2; ++k) \
        acc[ai][bj][m][n] = __builtin_amdgcn_mfma_f32_16x16x32_bf16(Bt[n][k], At[m][k], acc[ai][bj][m][n], 0, 0, 0); __builtin_amdgcn_s_setprio(0); } while (0)
#define PG8_WAIT_V(n) asm volatile("s_waitcnt vmcnt(" #n ")" ::: "memory")
#define PG8_WAIT_L(n) asm volatile("s_waitcnt lgkmcnt(" #n ")" ::: "memory")
#define PG8_BAR __builtin_amdgcn_s_barrier()
#define PG8_SCHED __builtin_amdgcn_sched_barrier(0)
    Unit cur, nxt; int ui = 0;
    if (!S.next(0, cur)) return;
    f32x4 acc[2][2][4][2];
#pragma unroll
    for (int a = 0; a < 2; ++a)
#pragma unroll
        for (int b = 0; b < 2; ++b)
#pragma unroll
            for (int m = 0; m < 4; ++m)
#pragma unroll
                for (int n = 0; n < 2; ++n) acc[a][b][m][n] = (f32x4){0.f, 0.f, 0.f, 0.f};
    bf16x8 At[4][2], B0[2][2], B1[2][2];
    const char* cA = (const char*)g.A + (size_t)cur.pm * tstep; const char* cB = (const char*)g.Bt + (size_t)cur.pn * tstep;
    S.a_ready(cur);
    if constexpr (SP2) {
        PG8_STAGE(PG8_SB(0, 0), cB, voffB); PG8_STAGE(PG8_SB(0, 1), cB + hstep, voffB); PG8_STAGE(PG8_SA(0, 0), cA, voffA); PG8_STAGE(PG8_SA(0, 1), cA + hstep, voffA);
        if (wr == 1) PG8_BAR;
        PG8_WAIT_V(2); PG8_BAR;
        PG8_STAGE(PG8_SB(1, 0), cB + kstep, voffB); PG8_STAGE(PG8_SA(1, 0), cA + kstep, voffA); PG8_STAGE(PG8_SB(1, 1), cB + hstep + kstep, voffB);
        PG8_WAIT_V(6); PG8_BAR;
    } else {
        PG8_STAGE(PG8_SB(0, 0), cB, voffB); PG8_STAGE(PG8_SA(0, 0), cA, voffA); PG8_STAGE(PG8_SB(0, 1), cB + hstep, voffB); PG8_STAGE(PG8_SA(0, 1), cA + hstep, voffA);
        if (wr == 1) PG8_BAR;
        PG8_WAIT_V(4); PG8_BAR;
        PG8_STAGE(PG8_SB(1, 0), cB + kstep, voffB); PG8_STAGE(PG8_SA(1, 0), cA + kstep, voffA); PG8_STAGE(PG8_SB(1, 1), cB + hstep + kstep, voffB);
        PG8_WAIT_V(6); PG8_BAR;
    }
    for (;;) {
        const bool has_next = S.next(ui + 1, nxt);
        const char* nA = has_next ? (const char*)g.A + (size_t)nxt.pm * tstep : cA; const char* nB = has_next ? (const char*)g.Bt + (size_t)nxt.pn * tstep : cB;
        for (int t = 0; t < nt; t += 2) {
            const bool last = (t == nt - 2);
            const char* a1 = cA + (size_t)(t + 1) * kstep;
            const char* a2 = last ? nA : cA + (size_t)(t + 2) * kstep; const char* b2 = last ? nB : cB + (size_t)(t + 2) * kstep;
            const char* a3 = a2 + kstep; const char* b3 = b2 + kstep;
            if (last && has_next) S.a_ready(nxt);
            if constexpr (SP2) {
            PG8_LDB(B0, 0, 0); PG8_LDB(B1, 0, 1); PG8_SCHED; PG8_LDA(At, 0, 0); PG8_STAGE(PG8_SA(1, 1), a1 + hstep, voffA);
            PG8_WAIT_V(8); PG8_WAIT_L(0); PG8_BAR; PG8_MMA(0, 0, At, B0); PG8_MMA(0, 1, At, B1); PG8_BAR; PG8_SCHED;
            PG8_LDA(At, 0, 1); PG8_STAGE(PG8_SB(0, 0), b2, voffB); PG8_STAGE(PG8_SB(0, 1), b2 + hstep, voffB); PG8_STAGE(PG8_SA(0, 0), a2, voffA);
            PG8_WAIT_V(8); PG8_WAIT_L(0); PG8_BAR; PG8_MMA(1, 0, At, B0); PG8_MMA(1, 1, At, B1); PG8_BAR; PG8_SCHED;
            PG8_LDB(B0, 1, 0); PG8_LDB(B1, 1, 1); PG8_SCHED; PG8_LDA(At, 1, 0); PG8_STAGE(PG8_SA(0, 1), a2 + hstep, voffA);
            PG8_WAIT_V(8); PG8_WAIT_L(0); PG8_BAR; PG8_MMA(0, 0, At, B0); PG8_MMA(0, 1, At, B1); PG8_BAR; PG8_SCHED;
            PG8_LDA(At, 1, 1); PG8_STAGE(PG8_SB(1, 0), b3, voffB); PG8_STAGE(PG8_SB(1, 1), b3 + hstep, voffB); PG8_STAGE(PG8_SA(1, 0), a3, voffA);
            PG8_WAIT_V(8); PG8_WAIT_L(0); PG8_BAR; PG8_MMA(1, 0, At, B0); PG8_MMA(1, 1, At, B1); PG8_BAR; PG8_SCHED;
            } else {
            PG8_LDB(B0, 0, 0); PG8_SCHED; PG8_LDA(At, 0, 0); PG8_STAGE(PG8_SA(1, 1), a1 + hstep, voffA);
            PG8_WAIT_L(8); PG8_BAR; PG8_WAIT_L(0); PG8_MMA(0, 0, At, B0); PG8_BAR; PG8_SCHED;
            PG8_LDB(B1, 0, 1); PG8_STAGE(PG8_SB(0, 0), b2, voffB);
            PG8_BAR; PG8_WAIT_L(0); PG8_MMA(0, 1, At, B1); PG8_BAR;
            PG8_LDA(At, 0, 1); PG8_STAGE(PG8_SA(0, 0), a2, voffA);
            PG8_BAR; PG8_WAIT_L(0); PG8_MMA(1, 0, At, B0); PG8_BAR; PG8_SCHED;
            PG8_STAGE(PG8_SB(0, 1), b2 + hstep, voffB);
            PG8_WAIT_V(6); PG8_BAR; PG8_MMA(1, 1, At, B1); PG8_BAR;
            PG8_LDB(B0, 1, 0); PG8_SCHED; PG8_LDA(At, 1, 0); PG8_STAGE(PG8_SA(0, 1), a2 + hstep, voffA);
            PG8_WAIT_L(8); PG8_BAR; PG8_WAIT_L(0); PG8_MMA(0, 0, At, B0); PG8_BAR; PG8_SCHED;
            PG8_LDB(B1, 1, 1); PG8_STAGE(PG8_SB(1, 0), b3, voffB);
            PG8_BAR; PG8_WAIT_L(0); PG8_MMA(0, 1, At, B1); PG8_BAR;
            PG8_LDA(At, 1, 1); PG8_STAGE(PG8_SA(1, 0), a3, voffA);
            PG8_BAR; PG8_WAIT_L(0); PG8_MMA(1, 0, At, B0); PG8_BAR; PG8_SCHED;
            PG8_STAGE(PG8_SB(1, 1), b3 + hstep, voffB);
            PG8_WAIT_V(6); PG8_BAR; PG8_MMA(1, 1, At, B1); PG8_BAR;
            }
        }
        if constexpr (ALIGN_EPI) { if (wr == 0) PG8_BAR; }
        if constexpr (!Epi::AFTER_DRAIN) { E(acc, cur, wr, wc, fr, fq); S.done(cur); }
        if (!has_next) break;
#pragma unroll
        for (int a = 0; a < 2; ++a)
#pragma unroll
            for (int b = 0; b < 2; ++b)
#pragma unroll
                for (int m = 0; m < 4; ++m)
#pragma unroll
                    for (int n = 0; n < 2; ++n) acc[a][b][m][n] = (f32x4){0.f, 0.f, 0.f, 0.f};
        cur = nxt; cA = nA; cB = nB; ++ui;
        if constexpr (ALIGN_EPI) { if (wr == 1) PG8_BAR; }
    }
    PG8_WAIT_V(0);
    if constexpr (!ALIGN_EPI) { if (wr == 0) PG8_BAR; }
    PG8_BAR;
    if constexpr (Epi::AFTER_DRAIN) { E.fused(acc, cur, wr, wc, fr, fq, lds, wid, lane); S.done(cur); }
#undef PG8_SA
#undef PG8_SB
#undef PG8_STAGE
#undef PG8_LDA
#undef PG8_LDB
#undef PG8_MMA
#undef PG8_WAIT_V
#undef PG8_WAIT_L
#undef PG8_BAR
#undef PG8_SCHED
}
}

#ifndef PG8_SP2
#define PG8_SP2 true
#endif
#ifndef PG8_ALIGN
#define PG8_ALIGN true
#endif
#include <hip/hip_bf16.h>
#include <cmath>
namespace attn_body {
using bf16=__hip_bfloat16;
using bf16x8=__attribute__((ext_vector_type(8)))short;
using s16x4=__attribute__((ext_vector_type(4)))short;
using f32x16=__attribute__((ext_vector_type(16)))float;
using u32x4=__attribute__((ext_vector_type(4)))unsigned;
constexpr int BATCH=2,NHEAD=16,SEQ=8192,D=64,DM=NHEAD*D;
constexpr int NW=8,QBLK=32,QB=QBLK*NW,KVBLK=64,NQB=SEQ/QB;
constexpr int ATTN_PITCH=DM, ATTN_UNIT_ROWS=QB;
__device__ __forceinline__ int crow(int r,int hi){return (r&3)+8*(r>>2)+4*hi;}
#define SBAR() __builtin_amdgcn_sched_barrier(0)
__device__ __forceinline__ void cmask(f32x16&p0,f32x16&p1,int jb,int qrel,int hi){
  const float NEG=-INFINITY; int kb=64*jb+4*hi;
  #pragma unroll
  for(int r=0;r<16;++r){int kv=kb+(r&3)+8*(r>>2); if(kv>qrel)p0[r]=NEG; if(kv+32>qrel)p1[r]=NEG;}
}

constexpr int NSLOT=3, SLOTB=8192;
constexpr int LDS_K=0, LDS_V=NSLOT*SLOTB, LDS_WS=2*NSLOT*SLOTB, LDS_OST=LDS_WS+NW*64*4, LDS_X=LDS_OST+NW*4096, LDS_BT=LDS_X+NSLOT*2048, LDS_BYTES=LDS_BT+2048;
constexpr float C2=0.125f*1.4426950408889634f;
__device__ __forceinline__ void glds16(const void*gsrc,unsigned lds_dst){unsigned keep;
  asm volatile("s_mov_b32 %0, m0\n\ts_mov_b32 m0, %2\n\ts_nop 0\n\tglobal_load_lds_dwordx4 %1, off\n\ts_mov_b32 m0, %0":"=&s"(keep):"v"(gsrc),"s"(lds_dst):"memory");}
__device__ __forceinline__ void glds16s(const void*sbase,unsigned voff,unsigned lds_dst){unsigned keep;
  asm volatile("s_mov_b32 %0, m0\n\ts_mov_b32 m0, %3\n\ts_nop 0\n\tglobal_load_lds_dwordx4 %1, %2\n\ts_mov_b32 m0, %0":"=&s"(keep):"v"(voff),"s"(sbase),"s"(lds_dst):"memory");}
__device__ __forceinline__ void glds4s(const void*sbase,unsigned voff,unsigned lds_dst){unsigned keep;
  asm volatile("s_mov_b32 %0, m0\n\ts_mov_b32 m0, %3\n\ts_nop 0\n\tglobal_load_lds_dword %1, %2\n\ts_mov_b32 m0, %0":"=&s"(keep):"v"(voff),"s"(sbase),"s"(lds_dst):"memory");}
__device__ __forceinline__ void glds4(const void*gsrc,unsigned lds_dst){unsigned keep;
  asm volatile("s_mov_b32 %0, m0\n\ts_mov_b32 m0, %2\n\ts_nop 0\n\tglobal_load_lds_dword %1, off\n\ts_mov_b32 m0, %0":"=&s"(keep):"v"(gsrc),"s"(lds_dst):"memory");}
__device__ __forceinline__ float max3f(float a,float b,float c){float r;asm("v_max3_f32 %0, %1, %2, %3":"=v"(r):"v"(a),"v"(b),"v"(c));return r;}
__device__ __forceinline__ float max2f(float a,float b){float r;asm("v_max_f32_e32 %0, %1, %2":"=v"(r):"v"(a),"v"(b));return r;}
__device__ __forceinline__ float fadd_s(float a,float b){float r;asm("v_add_f32_e32 %0, %1, %2":"=v"(r):"v"(a),"v"(b));return r;}
__device__ __forceinline__ float fsub_s(float a,float b){float r;asm("v_sub_f32_e32 %0, %1, %2":"=v"(r):"v"(a),"v"(b));return r;}
typedef float f32x2_t __attribute__((ext_vector_type(2))); typedef __bf16 bf16x2_t __attribute__((ext_vector_type(2)));
__device__ __forceinline__ unsigned cvtpk_s(float lo,float hi){f32x2_t v={lo,hi};bf16x2_t b=__builtin_convertvector(v,bf16x2_t);return __builtin_bit_cast(unsigned,b);}
#define WAIT_BAR(N) asm volatile("s_waitcnt vmcnt(" #N ") lgkmcnt(0)\n\ts_barrier":::"memory")

__device__ __forceinline__ void qkt(f32x16&p0,f32x16&p1,const char*Kslot,const bf16x8*qr,bf16x8 kx0,bf16x8 kx1,bf16x8 qe,int r32,int hi){
  const char*kb=Kslot+hi*1024+r32*16;
  #pragma unroll
  for(int d0=0;d0<4;++d0){
    const bf16x8 b0=*reinterpret_cast<const bf16x8*>(kb+d0*2048);
    const bf16x8 b1=*reinterpret_cast<const bf16x8*>(kb+d0*2048+512);
    if(d0==0){const f32x16 z=f32x16{};p0=__builtin_amdgcn_mfma_f32_32x32x16_bf16(kx0,qe,z,0,0,0);p1=__builtin_amdgcn_mfma_f32_32x32x16_bf16(kx1,qe,z,0,0,0);}
    {p0=__builtin_amdgcn_mfma_f32_32x32x16_bf16(b0,qr[d0],p0,0,0,0);p1=__builtin_amdgcn_mfma_f32_32x32x16_bf16(b1,qr[d0],p1,0,0,0);}}
}
typedef __attribute__((address_space(3))) const char* lds_cptr;
typedef short v4i16_t __attribute__((ext_vector_type(4)));
__device__ __forceinline__ void kload8(bf16x8*kf,lds_cptr kp){
  kf[0]=*(const __attribute__((address_space(3))) bf16x8*)(kp);      kf[1]=*(const __attribute__((address_space(3))) bf16x8*)(kp+512);
  kf[2]=*(const __attribute__((address_space(3))) bf16x8*)(kp+2048); kf[3]=*(const __attribute__((address_space(3))) bf16x8*)(kp+2560);
  kf[4]=*(const __attribute__((address_space(3))) bf16x8*)(kp+4096); kf[5]=*(const __attribute__((address_space(3))) bf16x8*)(kp+4608);
  kf[6]=*(const __attribute__((address_space(3))) bf16x8*)(kp+6144); kf[7]=*(const __attribute__((address_space(3))) bf16x8*)(kp+6656);
}
__device__ __forceinline__ void kload2(bf16x8*kf,lds_cptr kp,int j){ kf[2*j]=*(const __attribute__((address_space(3))) bf16x8*)(kp+j*2048); kf[2*j+1]=*(const __attribute__((address_space(3))) bf16x8*)(kp+j*2048+512); }
__device__ __forceinline__ s16x4 vtr(lds_cptr p){ return __builtin_bit_cast(s16x4,__builtin_amdgcn_ds_read_tr16_b64_v4i16((__attribute__((address_space(3))) v4i16_t*)p)); }
__device__ __forceinline__ float rowmax(const f32x16&p0,const f32x16&p1){
  float a=max3f(p0[0],p0[1],p1[0]),b=max3f(p0[2],p0[3],p1[1]);a=max3f(a,p1[2],p1[3]);
  #pragma unroll
  for(int r=4;r<16;r+=4){a=max3f(a,p0[r],p0[r+1]);b=max3f(b,p0[r+2],p0[r+3]);a=max3f(a,p1[r],p1[r+1]);b=max3f(b,p1[r+2],p1[r+3]);}
  const float m=max2f(a,b);
  auto rr=__builtin_amdgcn_permlane32_swap(__float_as_uint(m),__float_as_uint(m),false,false);
  return max2f(__uint_as_float(rr[0]),__uint_as_float(rr[1]));
}
__device__ __forceinline__ void pv(f32x16*o,int vb,bf16x8 pa0,bf16x8 pa1,bf16x8 pa2,bf16x8 pa3){
  #pragma unroll
  for(int d0=0;d0<2;++d0){s16x4 lo[4],hi[4];
    #pragma unroll
    for(int ks=0;ks<4;++ks){
      asm volatile("ds_read_b64_tr_b16 %0,%1 offset:%c2":"=&v"(lo[ks]):"v"(vb),"i"(d0*4096+ks*1024):"memory");
      asm volatile("ds_read_b64_tr_b16 %0,%1 offset:%c2":"=&v"(hi[ks]):"v"(vb),"i"(d0*4096+ks*1024+512):"memory");}
    asm volatile("s_waitcnt lgkmcnt(0)":::"memory");SBAR();
    #define PK(k) (bf16x8){lo[k][0],lo[k][1],lo[k][2],lo[k][3],hi[k][0],hi[k][1],hi[k][2],hi[k][3]}
    o[d0]=__builtin_amdgcn_mfma_f32_32x32x16_bf16(pa0,PK(0),o[d0],0,0,0);
    o[d0]=__builtin_amdgcn_mfma_f32_32x32x16_bf16(pa1,PK(1),o[d0],0,0,0);
    o[d0]=__builtin_amdgcn_mfma_f32_32x32x16_bf16(pa2,PK(2),o[d0],0,0,0);
    o[d0]=__builtin_amdgcn_mfma_f32_32x32x16_bf16(pa3,PK(3),o[d0],0,0,0);
    #undef PK
  }
}

#ifndef ATTN_STORE16
#define ATTN_STORE16(p,v) (*(u32x4*)(p)=(v))
#endif
template<int MODE,int THRL> __device__ __forceinline__ void attn_unit(int b,int h,int qb,const bf16*Q,const bf16*K,const bf16*V,bf16*O,char*shm,const bf16*KX,const float*relb){
  int tid_=threadIdx.x; asm volatile("":"+v"(tid_));
  const int tid=tid_,lane=tid&63,r32=lane&31,hi=lane>>5; const int wid=__builtin_amdgcn_readfirstlane(tid>>6);
  const long rowbase=(long)b*SEQ; const int q0=qb*QB;
  const bf16*Qw=Q+(rowbase+q0+wid*QBLK)*DM+h*D;
  const int kc0=(MODE==1)?((4*qb-8)>0?(4*qb-8):0):0;
  const bf16*Kh=K+(rowbase+(long)kc0*KVBLK)*DM+h*D,*Vh=V+(rowbase+(long)kc0*KVBLK)*DM+h*D;
  const unsigned lds0=(unsigned)(uintptr_t)shm;
  float*wsf=(float*)(shm+LDS_WS)+wid*64;
  const unsigned kvo=(unsigned)(lane*DM+wid*8)*2u, vvo=(unsigned)((16*(wid&3)+(lane>>2))*DM+(wid>>2)*32+(lane&3)*8)*2u;
  const unsigned kdst=lds0+LDS_K+wid*1024, vdst=lds0+LDS_V+wid*1024;
  #define TILE(s_) ((MODE==0)?(NT-1-(s_)):(s_))
  #define DMA_K(t,slot) glds16s(Kh+(long)TILE(t)*KVBLK*DM,kvo,(unsigned)__builtin_amdgcn_readfirstlane(kdst+(slot)))
  #define DMA_V(t,slot) glds16s(Vh+(long)TILE(t)*KVBLK*DM,vvo,(unsigned)__builtin_amdgcn_readfirstlane(vdst+(slot)))
  const bf16*xsrc=KX+((long)(b*NHEAD+h)*2*SEQ+(long)(wid>>2)*SEQ+16*(wid&3))*8; const unsigned xvo=(unsigned)lane*4u; const unsigned xdst=lds0+LDS_X+wid*256;
  #define DMA_E(t,slot) do{ if(MODE==0) glds4s(xsrc+(long)TILE(t)*KVBLK*8,xvo,(unsigned)__builtin_amdgcn_readfirstlane(xdst+((slot)>>2))); }while(0)
  const lds_cptr xp0=(lds_cptr)shm+LDS_X+hi*1024+r32*16;
  #define XLD(sl) do{ if(MODE==0){ ke0=*(const __attribute__((address_space(3))) bf16x8*)(xp0+((sl)>>2)); ke1=*(const __attribute__((address_space(3))) bf16x8*)(xp0+((sl)>>2)+512); } }while(0)
  #define WAITB_A() do{ if(MODE==0){WAIT_BAR(3);}else{WAIT_BAR(2);} }while(0)
  const int vb0=(int)(lds0+LDS_V)+((lane>>4)&1)*32+(lane&3)*8+(4*hi+((lane&15)>>2))*64;
  const char*Kbase=shm+LDS_K; bf16x8 kf[8];
  const lds_cptr shm3=(lds_cptr)shm; const lds_cptr kp0=shm3+LDS_K+hi*1024+r32*16; const lds_cptr vp0=shm3+LDS_V+((lane>>4)&1)*32+(lane&3)*8+(4*hi+((lane&15)>>2))*64;
  const int NT=(q0+QB)/KVBLK-kc0;
  if(MODE==1){ float*bt=(float*)(shm+LDS_BT); if(tid<257) bt[tid]=(relb[tid]-relb[256])*1.4426950408889634f; }
  u32x4 qev=(u32x4){0x3F803F80u,0x3F80u,0u,0u};
  bf16x8 ke0,ke1; { const u32x4 kc_=(hi==0)?(u32x4){0u,0x3F800000u,0x3F803F80u,0u}:(u32x4){0u,0u,0u,0u}; ke0=__builtin_bit_cast(bf16x8,kc_); ke1=ke0; }
  #define QE() __builtin_bit_cast(bf16x8,qev)
  #define SETQE() do{ const float nm_=-mhat; const unsigned a_=cvtpk_s(nm_,0.f)&0xffffu; const float r1_=nm_-__uint_as_float(a_<<16); const unsigned b_=cvtpk_s(r1_,0.f)&0xffffu; \
    const float r2_=r1_-__uint_as_float(b_<<16); const unsigned c_=cvtpk_s(r2_,0.f)&0xffffu; qev[1]=0x3F80u|(a_<<16); qev[2]=b_|(c_<<16); }while(0)
  DMA_K(0,0);DMA_E(0,0);DMA_V(0,0);DMA_K(1,SLOTB);DMA_E(1,SLOTB);
  bf16x8 qr[4];
  #pragma unroll
  for(int d0=0;d0<4;++d0)qr[d0]=*reinterpret_cast<const bf16x8*>(&Qw[(long)r32*DM+d0*16+hi*8]);
  float mhat=0.f,l_reg=0.f;f32x16 o[2];o[0]=f32x16{};o[1]=f32x16{};
  const int qrel=wid*QBLK+r32;
  const int cw=4*qb+(wid>>1);
  #define BMASK(P0,P1,t) do{ const int kc_=kc0+(t); if(kc_>cw||kc_<cw-8){ _Pragma("unroll") for(int r=0;r<16;++r){P0[r]=-INFINITY;P1[r]=-INFINITY;} } \
    else if(kc_>=cw-2){ const float*bt_=(const float*)(shm+LDS_BT); const int dq_=64*(cw-kc_)+32*(wid&1)+r32-4*hi; \
      _Pragma("unroll") for(int r=0;r<16;++r){ const int d0_=dq_-((r&3)+8*(r>>2)), d1_=d0_-32; P0[r]+=bt_[(d0_<128?d0_:128)+128]; P1[r]+=bt_[(d1_<128?d1_:128)+128]; } } }while(0)
  #define CMASK(P0,P1,t) do{ if(MODE==1){BMASK(P0,P1,t);} else {int jb_=3-(t); if(jb_>=0)cmask(P0,P1,jb_,qrel,hi);} }while(0)
  bool resc=false;
  #define START(P0,P1) do{ float rm=rowmax(P0,P1); rm=max2f(rm,-64.f); resc=false;     \
    { const float dl=rm; mhat=fadd_s(mhat,dl); \
      _Pragma("unroll") for(int r=0;r<16;++r){P0[r]=fsub_s(P0[r],dl);P1[r]=fsub_s(P1[r],dl);} \
      SETQE(); } \
    _Pragma("unroll") for(int r=0;r<16;++r)P0[r]=__builtin_amdgcn_exp2f(P0[r]); }while(0)
  #define RESC() do{ if(resc){ asm volatile("s_waitcnt lgkmcnt(0)":::"memory"); \
      _Pragma("unroll") for(int d_=0;d_<2;++d_) _Pragma("unroll") for(int r=0;r<16;++r)o[d_][r]*=wsf[crow(r,hi)]; } }while(0)
  f32x16 pA0,pA1,pB0,pB1;
  int sl_prev=0,sl_cur=0,sl_next=SLOTB;
  #define ROT() do{sl_prev=sl_cur;sl_cur=sl_next;sl_next=(sl_next==(NSLOT-1)*SLOTB)?0:sl_next+SLOTB;}while(0)
  DMA_K(2,2*SLOTB);DMA_E(2,2*SLOTB);
  if(MODE==0){WAIT_BAR(5);}else{WAIT_BAR(3);}
  XLD(0);
  qkt(pA0,pA1,Kbase,qr,ke0,ke1,QE(),r32,hi);asm volatile("s_nop 15\n\ts_nop 7":"+v"(pA0),"+v"(pA1));CMASK(pA0,pA1,0);
  START(pA0,pA1);
  _Pragma("unroll") for(int r=0;r<16;++r)pA1[r]=__builtin_amdgcn_exp2f(pA1[r]);
  WAIT_BAR(0);
  DMA_K(3,0);DMA_E(3,0);DMA_V(1,SLOTB);
  ROT();
  kload8(kf,kp0+sl_cur); XLD(sl_cur);
  WAITB_A();
  s16x4 vlo[8],vhi[8]; u32x4 pw0,pw1,pw2,pw3;
  #define PKW(P,B) cvtpk_s(P[B],P[B+1])
  #define PAF(k) __builtin_bit_cast(bf16x8,pw##k)
  #define VFR(i) (bf16x8){vlo[i][0],vlo[i][1],vlo[i][2],vlo[i][3],vhi[i][0],vhi[i][1],vhi[i][2],vhi[i][3]}
  #define PIN(x) asm volatile("":"+v"(x))
  #define MX3(a,b,c) __builtin_fmaxf(__builtin_fmaxf((a),(b)),(c))
  #define GAPA(MF,A0,A1,A2,A3,W0,W1,PW) do{ MF; sacc+=A0; sacc+=A1; sacc+=A2; sacc+=A3; PIN(sacc); W0; W1; PIN(PW); SBAR(); }while(0)
  #define EX(v) __builtin_amdgcn_exp2f(v)
  #define GAPB(MF,X,B) do{ MF; X[B]=EX(X[B]); X[B+1]=EX(X[B+1]); X[B+2]=EX(X[B+2]); X[B+3]=EX(X[B+3]); PIN(X); SBAR(); }while(0)
  #define VRD(i) do{ vlo[i]=vtr(vp_+(((i)>>2)*4096+((i)&3)*1024)); vhi[i]=vtr(vp_+(((i)>>2)*4096+((i)&3)*1024+512)); }while(0)
  #define KRD(G,j) do{ if(G){ kload2(kf,kp0+sl_next,j); SBAR(); } }while(0)
  #define STEP(C0,C1,P0,P1,t,GK,GV,GL) do{ SBAR(); \
    const lds_cptr vp_=vp0+sl_prev; \
    { const f32x16 z_=f32x16{}; C0=__builtin_amdgcn_mfma_f32_32x32x16_bf16(ke0,QE(),z_,0,0,0); C1=__builtin_amdgcn_mfma_f32_32x32x16_bf16(ke1,QE(),z_,0,0,0); } SBAR(); \
    VRD(0); SBAR(); float sacc=(P0[0]+P0[1]); \
    GAPA(C0=__builtin_amdgcn_mfma_f32_32x32x16_bf16(kf[0],qr[0],C0,0,0,0), P0[2],P0[3],P0[4],P0[5],     pw0[0]=PKW(P0,0), pw0[1]=PKW(P0,2), pw0); \
    VRD(4); SBAR(); GAPA(C1=__builtin_amdgcn_mfma_f32_32x32x16_bf16(kf[1],qr[0],C1,0,0,0), P0[6],P0[7],P0[8],P0[9],     pw0[2]=PKW(P0,4), pw0[3]=PKW(P0,6), pw0); \
    VRD(1); SBAR(); GAPA(C0=__builtin_amdgcn_mfma_f32_32x32x16_bf16(kf[2],qr[1],C0,0,0,0),   P0[10],P0[11],P0[12],P0[13], pw1[0]=PKW(P0,8), pw1[1]=PKW(P0,10), pw1); \
    VRD(5); SBAR(); GAPA(C1=__builtin_amdgcn_mfma_f32_32x32x16_bf16(kf[3],qr[1],C1,0,0,0),   P0[14],P0[15],P1[0],P1[1],   pw1[2]=PKW(P0,12),pw1[3]=PKW(P0,14), pw1); \
    VRD(2); SBAR(); GAPA(C0=__builtin_amdgcn_mfma_f32_32x32x16_bf16(kf[4],qr[2],C0,0,0,0),   P1[2],P1[3],P1[4],P1[5],     pw2[0]=PKW(P1,0), pw2[1]=PKW(P1,2), pw2); \
    VRD(6); SBAR(); GAPA(C1=__builtin_amdgcn_mfma_f32_32x32x16_bf16(kf[5],qr[2],C1,0,0,0),   P1[6],P1[7],P1[8],P1[9],     pw2[2]=PKW(P1,4), pw2[3]=PKW(P1,6), pw2); \
    VRD(3); SBAR(); GAPA(C0=__builtin_amdgcn_mfma_f32_32x32x16_bf16(kf[6],qr[3],C0,0,0,0),   P1[10],P1[11],P1[12],P1[13], pw3[0]=PKW(P1,8), pw3[1]=PKW(P1,10), pw3); \
    VRD(7); SBAR(); GAPA(C1=__builtin_amdgcn_mfma_f32_32x32x16_bf16(kf[7],qr[3],C1,0,0,0),   P1[14],P1[15],0.f,0.f,       pw3[2]=PKW(P1,12),pw3[3]=PKW(P1,14), pw3); \
    l_reg+=sacc; \
    if(GK){DMA_K((t)+3,sl_cur);DMA_E((t)+3,sl_cur);} if(GV){DMA_V((t)+1,sl_next);} \
    CMASK(C0,C1,t); \
    { float a=MX3(C0[0],C0[1],C1[0]),b=MX3(C0[2],C0[3],C1[1]); a=MX3(a,C1[2],C1[3]); \
      _Pragma("unroll") for(int r=4;r<16;r+=4){a=MX3(a,C0[r],C0[r+1]);b=MX3(b,C0[r+2],C0[r+3]);a=MX3(a,C1[r],C1[r+1]);b=MX3(b,C1[r+2],C1[r+3]);} \
      float rm=__builtin_fmaxf(a,b); { auto rr=__builtin_amdgcn_permlane32_swap(__float_as_uint(rm),__float_as_uint(rm),false,false); rm=__builtin_fmaxf(__uint_as_float(rr[0]),__uint_as_float(rr[1])); } \
      resc=false; \
      if(__builtin_expect(__any(rm>(float)THRL),0)){ const float dl=__builtin_fmaxf(rm,0.f); mhat+=dl; \
        _Pragma("unroll") for(int r=0;r<16;++r){C0[r]-=dl;C1[r]-=dl;} \
        SETQE(); \
        const float f=__builtin_amdgcn_exp2f(-dl); l_reg*=f; if(hi==0)wsf[r32]=f; resc=true; } } \
    SBAR(); \
    GAPB(o[0]=__builtin_amdgcn_mfma_f32_32x32x16_bf16(PAF(0),VFR(0),o[0],0,0,0), C0,0); \
    GAPB(o[1]=__builtin_amdgcn_mfma_f32_32x32x16_bf16(PAF(0),VFR(4),o[1],0,0,0), C0,4); \
    KRD(GL,0); GAPB(o[0]=__builtin_amdgcn_mfma_f32_32x32x16_bf16(PAF(1),VFR(1),o[0],0,0,0), C0,8); \
    KRD(GL,1); GAPB(o[1]=__builtin_amdgcn_mfma_f32_32x32x16_bf16(PAF(1),VFR(5),o[1],0,0,0), C0,12); \
    KRD(GL,2); GAPB(o[0]=__builtin_amdgcn_mfma_f32_32x32x16_bf16(PAF(2),VFR(2),o[0],0,0,0), C1,0); \
    KRD(GL,3); GAPB(o[1]=__builtin_amdgcn_mfma_f32_32x32x16_bf16(PAF(2),VFR(6),o[1],0,0,0), C1,4); \
    if(GL){ XLD(sl_next); SBAR(); } GAPB(o[0]=__builtin_amdgcn_mfma_f32_32x32x16_bf16(PAF(3),VFR(3),o[0],0,0,0), C1,8); \
    GAPB(o[1]=__builtin_amdgcn_mfma_f32_32x32x16_bf16(PAF(3),VFR(7),o[1],0,0,0), C1,12); \
    }while(0)
  int t=1;
  if(MODE==0) for(;t+5<NT;t+=2){
    STEP(pB0,pB1,pA0,pA1,t,true,true,true);     WAIT_BAR(3); RESC(); ROT();
    STEP(pA0,pA1,pB0,pB1,t+1,true,true,true);   WAIT_BAR(3); RESC(); ROT();
  }
  #define ENDW(tt) do{ if((tt)+3<NT){WAITB_A();} else if((tt)+2<NT){WAIT_BAR(1);} else {WAIT_BAR(0);} }while(0)
  for(;t+1<NT;t+=2){
    STEP(pB0,pB1,pA0,pA1,t,(t+3<NT),(t+1<NT),(t+1<NT));       ENDW(t);   RESC(); ROT();
    STEP(pA0,pA1,pB0,pB1,t+1,(t+4<NT),(t+2<NT),(t+2<NT));     ENDW(t+1); RESC(); ROT();
  }
  STEP(pB0,pB1,pA0,pA1,NT-1,false,false,false); RESC();
  { float sacc=pB0[0]+pB0[1]; _Pragma("unroll") for(int r=2;r<16;++r)sacc+=pB0[r]; _Pragma("unroll") for(int r=0;r<16;++r)sacc+=pB1[r]; l_reg+=sacc;
    pw0=(u32x4){PKW(pB0,0),PKW(pB0,2),PKW(pB0,4),PKW(pB0,6)};pw1=(u32x4){PKW(pB0,8),PKW(pB0,10),PKW(pB0,12),PKW(pB0,14)};pw2=(u32x4){PKW(pB1,0),PKW(pB1,2),PKW(pB1,4),PKW(pB1,6)};pw3=(u32x4){PKW(pB1,8),PKW(pB1,10),PKW(pB1,12),PKW(pB1,14)};
    SBAR(); pv(o,vb0+sl_cur,PAF(0),PAF(1),PAF(2),PAF(3)); }
  #undef PKW
  #undef PAF
  #undef VFR
  #undef PIN
  #undef MX3
  #undef GAPA
  #undef GAPB
  #undef EX
  #undef VRD
  #undef KRD
  #undef STEP
  #undef ENDW
  {auto rr=__builtin_amdgcn_permlane32_swap(__float_as_uint(l_reg),__float_as_uint(l_reg),false,false);l_reg=__uint_as_float(rr[0])+__uint_as_float(rr[1]);}
  if(hi==0)wsf[32+r32]=l_reg;asm volatile("s_waitcnt lgkmcnt(0)":::"memory");
  float rli[16];
  #pragma unroll
  for(int r=0;r<16;++r)rli[r]=__builtin_amdgcn_rcpf(wsf[32+crow(r,hi)]);
  bf16*Ow=O+(rowbase+q0+wid*QBLK)*DM+h*D;
  { bf16*stg=(bf16*)(shm+LDS_OST)+wid*2048;
    #pragma unroll
    for(int r=0;r<16;++r){const int orow=crow(r,hi);
      #pragma unroll
      for(int d0=0;d0<2;++d0)stg[orow*64+d0*32+r32]=__float2bfloat16(o[d0][r]*rli[r]);}
    asm volatile("s_waitcnt lgkmcnt(0)":::"memory");
    #pragma unroll
    for(int i=0;i<4;++i){const int row=i*8+(lane>>3),ch=lane&7; const u32x4 v=*(const u32x4*)(stg+row*64+ch*8); ATTN_STORE16(Ow+(long)row*DM+ch*8,v);} }
  asm volatile("s_waitcnt lgkmcnt(0)\n\ts_barrier":::"memory");
  #undef DMA_K
  #undef TILE
  #undef DMA_V
  #undef DMA_E
  #undef XLD
  #undef WAITB_A
  #undef QE
  #undef SETQE
  #undef BMASK
  #undef CMASK
  #undef START
  #undef RESC
  #undef ROT
}
constexpr int ATTN_LDS_BYTES=LDS_BYTES;
struct AttnTensors { const bf16* Q; const bf16* K; const bf16* V; bf16* O; const bf16* KX; const float* relb; };
struct AttnUnit { int bh; int qb; };
struct StaticOrder {
  int vcu;
  __device__ __forceinline__ explicit StaticOrder(int grid,int block):vcu((block%8)*(grid/8)+block/8){}
  __device__ __forceinline__ bool next(int i,AttnUnit&u)const{ if(i>=4)return false; const int s=vcu&7; u.bh=vcu>>3; u.qb=(i==0)?s:(i==1)?15-s:(i==2)?16+s:31-s; return true; }
  __device__ __forceinline__ bool next_band(int i,AttnUnit&u)const{ if(i>=4)return false; u.bh=vcu>>3; u.qb=(vcu&7)+8*i; return true; }
  __device__ __forceinline__ void a_ready(const AttnUnit&)const{}
  __device__ __forceinline__ void done(const AttnUnit&)const{}
};
template<int MODE,class Sched,int THRL=8> __device__ __forceinline__ void attn_phase(char*lds,const AttnTensors&T,const Sched&S){
  AttnUnit u;
  for(int i=0;(MODE==0?S.next(i,u):S.next_band(i,u));++i){ attn_unit<MODE,THRL>(u.bh/NHEAD,u.bh%NHEAD,u.qb,T.Q,T.K,T.V,T.O,lds,T.KX,T.relb+(MODE==1?(u.bh%NHEAD)*257:0)); }
}
#undef SBAR
#undef WAIT_BAR
}
namespace cg = cooperative_groups;
constexpr int NWAVES = 8;
#ifndef MK_PER_PHASE
#define MK_PER_PHASE 0
#endif
constexpr int N_PHASES = 12;
constexpr int MP = 16384, MS = 512, MT = MP + MS, DMODEL = 1024, DFF = 2816, NH = 16, SEQL = 8192;
constexpr int PAST = 1024, BPAST = 512, DECB = 32, DECT = 16;
constexpr size_t O_YP = 0, O_YS = 16777216, O_AKP = 17301504, O_AVP = 34078720, O_ALFP = 50855936, O_BKP = 51118080, O_BVP = 52166656,
                 O_AKS = 53215232, O_AVS = 53739520, O_ALFS = 54263808, O_BKS = 54272000, O_BVS = 71049216, O_END = 87826432;
constexpr size_t MiB = 1u << 20;
constexpr size_t WS_WQKV0 = 2 * MiB, WS_WO0 = 8 * MiB, WS_WGU0 = 10 * MiB, WS_WD0 = 21 * MiB, WS_WKVQ = 27 * MiB, WS_WO1 = 33 * MiB, WS_WGU1 = 35 * MiB, WS_WD1 = 46 * MiB;
constexpr size_t WS_SSP = 52 * MiB, SSP_STRIDE = 2 * MiB;
constexpr size_t WS_GS = 62 * MiB;
constexpr size_t WS_KX = 64 * MiB;
constexpr size_t WS_QO = 72 * MiB, WS_KB = 105 * MiB, WS_VB = 138 * MiB, WS_HB = 171 * MiB, WS_ACT = 204 * MiB, WS_END = 296 * MiB;
static_assert(WS_ACT + (size_t)MT * DFF * 2 <= WS_END && WS_QO + (size_t)MT * DMODEL * 2 <= WS_KB, "d_ws map");
constexpr int RING_BYTES = 131072, LDS_BYTES = 147456;
static_assert(attn_body::ATTN_LDS_BYTES <= RING_BYTES, "attention LDS");

#define GAS __attribute__((address_space(1)))
#define LAS __attribute__((address_space(3)))
typedef unsigned short bf16;
typedef unsigned v4u __attribute__((ext_vector_type(4)));
typedef float f32x4 __attribute__((ext_vector_type(4)));
typedef short bf16x8 __attribute__((ext_vector_type(8)));
#define LDS_WAIT() asm volatile("s_waitcnt lgkmcnt(0)" ::: "memory")
__device__ __forceinline__ unsigned f2bf(float f) { unsigned u = __builtin_bit_cast(unsigned, f); return (u + 0x7fffu + ((u >> 16) & 1u)) >> 16; }
__device__ __forceinline__ unsigned pk2(float lo, float hi) { return f2bf(lo) | (f2bf(hi) << 16); }
__device__ __forceinline__ float bf2f(unsigned short b) { return __uint_as_float((unsigned)b << 16); }

__device__ __forceinline__ void p0_transpose_item(const float* W, int ldw, int csrc, int k0, const float* gain, bf16* WT, int K, int drow, LAS float* scr, int lane) {
    float wv[32]; const float gl = gain ? gain[k0 + lane] : 1.f;
#pragma unroll
    for (int i = 0; i < 32; ++i) wv[i] = W[(size_t)(k0 + 2 * i + (lane >> 5)) * ldw + csrc + (lane & 31)];
#pragma unroll
    for (int i = 0; i < 32; ++i) { const int kk = 2 * i + (lane >> 5); scr[kk * 33 + (lane & 31)] = wv[i] * __shfl(gl, kk); }
    LDS_WAIT(); asm volatile("" ::: "memory");
    const int c = lane & 7;
#pragma unroll
    for (int j = 0; j < 4; ++j) { const int n = (lane >> 3) + 8 * j; const LAS float* s = scr + (8 * c) * 33 + n;
        v4u o; o.x = pk2(s[0 * 33], s[1 * 33]); o.y = pk2(s[2 * 33], s[3 * 33]); o.z = pk2(s[4 * 33], s[5 * 33]); o.w = pk2(s[6 * 33], s[7 * 33]);
        *(v4u*)(WT + (size_t)(drow + n) * K + k0 + 8 * c) = o; }
    LDS_WAIT(); asm volatile("" ::: "memory");
}
struct KArgs { const float* in[20]; float* out; unsigned char* ws; int ph_lo, ph_hi; };

__device__ __forceinline__ void p0_weight_item(const KArgs& a, int it, LAS float* scr, int lane) {
    unsigned char* ws = a.ws;
    constexpr int I_QKV = 16 * 96, I_O = 16 * 32, I_GU = 16 * 176, I_D = 44 * 32, I_Q1 = 16 * 32, I_KV = 16 * 64;
    const float* W; int ldw, ncols, K, roff = 0; const float* gain = nullptr; bf16* dst; bool perm = false;
    int r = it;
    if (r < I_QKV) { W = a.in[8]; ldw = 3088; ncols = 3072; K = 1024; gain = a.in[7]; dst = (bf16*)(ws + WS_WQKV0); }
    else if ((r -= I_QKV) < I_O) { W = a.in[10]; ldw = 1024; ncols = 1024; K = 1024; dst = (bf16*)(ws + WS_WO0); }
    else if ((r -= I_O) < I_GU) { W = a.in[17]; ldw = 5632; ncols = 5632; K = 1024; gain = a.in[16]; dst = (bf16*)(ws + WS_WGU0); perm = true; }
    else if ((r -= I_GU) < I_D) { W = a.in[18]; ldw = 1024; ncols = 1024; K = 2816; dst = (bf16*)(ws + WS_WD0); }
    else if ((r -= I_D) < I_Q1) { W = a.in[11]; ldw = 1024; ncols = 1024; K = 1024; gain = a.in[7] + 1024; dst = (bf16*)(ws + WS_WKVQ); }
    else if ((r -= I_Q1) < I_KV) { W = a.in[15]; ldw = 2048; ncols = 2048; K = 1024; gain = a.in[14]; dst = (bf16*)(ws + WS_WKVQ); roff = 1024; }
    else if ((r -= I_KV) < I_O) { W = a.in[13]; ldw = 1024; ncols = 1024; K = 1024; dst = (bf16*)(ws + WS_WO1); }
    else if ((r -= I_O) < I_GU) { W = a.in[17] + (size_t)1024 * 5632; ldw = 5632; ncols = 5632; K = 1024; gain = a.in[16] + 1024; dst = (bf16*)(ws + WS_WGU1); perm = true; }
    else { r -= I_GU; W = a.in[18] + (size_t)2816 * 1024; ldw = 1024; ncols = 1024; K = 2816; dst = (bf16*)(ws + WS_WD1); }
    const int nblk = ncols / 32, kb = r / nblk, nb = r % nblk, n0 = 32 * nb;
    int drow = roff + n0;
    if (perm) { drow = n0 < 2816 ? 256 * (n0 / 128) + (n0 % 128) : 256 * ((n0 - 2816) / 128) + 128 + ((n0 - 2816) % 128); }
    p0_transpose_item(W, ldw, n0, 64 * kb, gain, dst, K, drow, scr, lane);
}
constexpr int P0_FIRST = 16 * 96, P0_SECOND = P0_FIRST + 16 * 32 + 16 * 176 + 44 * 32 + 16 * 32 + 16 * 64;
constexpr int P0_NITEMS = 16 * 96 + 16 * 32 + 16 * 176 + 44 * 32 + 16 * 32 + 16 * 64 + 16 * 32 + 16 * 176 + 44 * 32;

__device__ __forceinline__ void p0_row_group(const KArgs& a, int g, const LAS unsigned char* wf, int lane) {
    const int fr = lane & 15, fq = lane >> 4;
    const int row = g * 16 + fr;
    const float* xr = (g < 1024 ? a.in[0] + (size_t)row * 1024 : a.in[1] + (size_t)(row - MP) * 1024) + 8 * fq;
    bf16* hb = (bf16*)(a.ws + WS_HB) + (size_t)row * 1024 + 8 * fq;
    f32x4 acc = {0.f, 0.f, 0.f, 0.f}; float ss = 0.f;
#pragma unroll 4
    for (int ks = 0; ks < 32; ++ks) {
        const f32x4 x0 = *(const f32x4*)(xr + 32 * ks), x1 = *(const f32x4*)(xr + 32 * ks + 4);
        ss += (x0[0] * x0[0] + x0[1] * x0[1]) + (x0[2] * x0[2] + x0[3] * x0[3]) + (x1[0] * x1[0] + x1[1] * x1[1]) + (x1[2] * x1[2] + x1[3] * x1[3]);
        v4u w; w.x = pk2(x0[0], x0[1]); w.y = pk2(x0[2], x0[3]); w.z = pk2(x1[0], x1[1]); w.w = pk2(x1[2], x1[3]);
        *(v4u*)(hb + 32 * ks) = w;
        const bf16x8 bfrag = *(const LAS bf16x8*)(wf + (ks * 64 + lane) * 16);
        acc = __builtin_amdgcn_mfma_f32_16x16x32_bf16(bfrag, __builtin_bit_cast(bf16x8, w), acc, 0, 0, 0);
    }
    ss += __shfl_xor(ss, 16); ss += __shfl_xor(ss, 32);
    float* ssp = (float*)(a.ws + WS_SSP) + (size_t)row * 16 + 4 * fq;
    *(f32x4*)ssp = (f32x4){fq == 0 ? ss : 0.f, 0.f, 0.f, 0.f};
    const float rstd = 1.0f / sqrtf(ss * (1.0f / 1024.0f) + 1e-6f);
    const f32x4 bf = *(const f32x4*)(a.in[9] + 4 * fq);
    f32x4 lf;
#pragma unroll
    for (int e = 0; e < 4; ++e) { const float z = acc[e] * rstd + bf[e]; lf[e] = fminf(z, 0.f) - log1pf(expf(-fabsf(z))); }
    float* lo = (g < 1024 ? a.out + O_ALFP + (size_t)row * 16 : a.out + O_ALFS + (size_t)(row - MP) * 16) + 4 * fq;
    *(f32x4*)lo = lf;
    if (g < 1024) {
#pragma unroll
        for (int o = 1; o < 16; o <<= 1) { lf[0] += __shfl_xor(lf[0], o); lf[1] += __shfl_xor(lf[1], o); lf[2] += __shfl_xor(lf[2], o); lf[3] += __shfl_xor(lf[3], o); }
        if (fr == 0) *(f32x4*)((float*)(a.ws + WS_GS) + g * 16 + 4 * fq) = lf;
    }
}

__device__ __forceinline__ void p1_scan(const KArgs& a, int v, LAS float* red, int tid) {
    const int batch = v >> 7, g0 = batch * 512, g1 = 4 * v, h = tid & 15, part = tid >> 4;
    const float* gs = (const float*)(a.ws + WS_GS);
    float s = 0.f;
    for (int g = g0 + part; g < g1; g += 32) s += gs[g * 16 + h];
    red[part * 16 + h] = s;
    __syncthreads();
    LAS float* lfs = red + 512;
    for (int e = tid; e < 1024; e += 512) lfs[e] = a.out[O_ALFP + (size_t)(64 * v) * 16 + e];
    __syncthreads();
    if (tid < 16) {
        float cum = 0.f;
        for (int p = 0; p < 32; ++p) cum += red[p * 16 + tid];
        bf16* kx = (bf16*)(a.ws + WS_KX) + ((size_t)(batch * 16 + tid) * 2 * SEQL) * 8;
        const int t0 = (64 * v) & (SEQL - 1);
#pragma unroll 8
        for (int r = 0; r < 64; ++r) {
            cum += lfs[r * 16 + tid];
            const float c = -cum * 1.4426950408889634f;
            const unsigned c1 = f2bf(c); const float r1 = c - bf2f((unsigned short)c1);
            const unsigned c2 = f2bf(r1); const float r2 = r1 - bf2f((unsigned short)c2);
            const unsigned c3 = f2bf(r2);
            *(v4u*)(kx + (size_t)(t0 + r) * 8) = (v4u){c1 | (c2 << 16), c3 | 0x3F800000u, 0x3F803F80u, 0u};
            *(v4u*)(kx + (size_t)(SEQL + t0 + r) * 8) = (v4u){0u, 0u, 0u, 0u};
        }
    }
    __syncthreads();
}

template <int MODE> __device__ __forceinline__ void sample_attn(const KArgs& a, int b, int h, LAS unsigned char* lds, int tid) {
    constexpr int NC = MODE == 0 ? PAST : BPAST, NK = NC + 16, NKP = 1056;
    constexpr float L2E = 1.4426950408889634f;
    LAS float* S = (LAS float*)lds;
    LAS float* Qs = S + 16 * NKP;
    LAS float* bias = Qs + 1024;
    LAS float* Op = bias + NKP;
    LAS float* rl = Op + 8 * 1024;
    const int lane = tid & 63, wid = __builtin_amdgcn_readfirstlane(tid >> 6);
    const float* ck = a.in[MODE == 0 ? 2 : 5]; const float* cv = a.in[MODE == 0 ? 3 : 6];
    const float* nk = a.out + (MODE == 0 ? O_AKS + (size_t)(b * 16) * 1024 : O_BKS + (size_t)(b * 512 + 496) * 1024) + h * 64;
    const float* nv = a.out + (MODE == 0 ? O_AVS + (size_t)(b * 16) * 1024 : O_BVS + (size_t)(b * 512 + 496) * 1024) + h * 64;
    const bf16* qo = (const bf16*)(a.ws + WS_QO) + (size_t)(MP + b * 16) * 1024 + h * 64;
    if (tid < 128) { const int q = tid >> 3, c = tid & 7; const v4u w = *(const v4u*)(qo + (size_t)q * 1024 + 8 * c);
        LAS float* d = Qs + q * 64 + 8 * c; d[0] = bf2f(w.x & 0xffff); d[1] = bf2f(w.x >> 16); d[2] = bf2f(w.y & 0xffff); d[3] = bf2f(w.y >> 16); d[4] = bf2f(w.z & 0xffff); d[5] = bf2f(w.z >> 16); d[6] = bf2f(w.w & 0xffff); d[7] = bf2f(w.w >> 16); }
    if (MODE == 0) {
        for (int j = tid; j < NK; j += 512) bias[j] = j < NC ? a.in[4][((size_t)b * NC + j) * 16 + h] : a.out[O_ALFS + (size_t)(b * 16 + (j - NC)) * 16 + h];
    } else {
        if (tid < 257) bias[tid] = a.in[12][h * 257 + tid] * L2E;
    }
    __syncthreads();
    if (MODE == 0) {
        if (wid == 0) { float carry = 0.f;
            for (int c = 0; c < (NK + 63) / 64; ++c) { const int j = 64 * c + lane; float v = j < NK ? bias[j] : 0.f;
#pragma unroll
                for (int o = 1; o < 64; o <<= 1) { const float t = __shfl_up(v, o); if (lane >= o) v += t; }
                v += carry; carry = __shfl(v, 63); if (j < NK) bias[j] = -v * L2E; } }
        __syncthreads();
    }
    for (int g = wid; g <= NC / 64; g += 8) {
        const bool isnew = g == NC / 64; const int j = 64 * g + lane;
        if (isnew && lane >= 16) continue;
        const float* kr = isnew ? nk + (size_t)lane * 1024 : ck + (((size_t)b * NC + j) * 16 + h) * 64;
        f32x4 k4[16];
#pragma unroll
        for (int i = 0; i < 16; ++i) k4[i] = *(const f32x4*)(kr + 4 * i);
        if (MODE == 1 && !isnew && j >= 16) { float* ok = a.out + O_BKS + (((size_t)b * 512 + (j - 16)) * 16 + h) * 64;
#pragma unroll
            for (int i = 0; i < 16; ++i) *(f32x4*)(ok + 4 * i) = k4[i]; }
#pragma unroll 2
        for (int q = 0; q < 16; ++q) { float s = 0.f;
#pragma unroll
            for (int i = 0; i < 16; ++i) { const f32x4 qv = *(const LAS f32x4*)(Qs + q * 64 + 4 * i); s += (qv[0] * k4[i][0] + qv[1] * k4[i][1]) + (qv[2] * k4[i][2] + qv[3] * k4[i][3]); }
            if (MODE == 0) { s += bias[j]; if (isnew && lane > q) s = -INFINITY; }
            else { const int d = 512 + q - j; s += bias[(d < 128 ? d : 128) + 128]; }
            S[q * NKP + j] = s; }
    }
    __syncthreads();
    for (int q = 2 * wid; q < 2 * wid + 2; ++q) { float m = -INFINITY;
        for (int j = lane; j < NK; j += 64) m = fmaxf(m, S[q * NKP + j]);
#pragma unroll
        for (int o = 1; o < 64; o <<= 1) m = fmaxf(m, __shfl_xor(m, o));
        float l = 0.f;
        for (int j = lane; j < NK; j += 64) { const float p = __builtin_amdgcn_exp2f(S[q * NKP + j] - m); S[q * NKP + j] = p; l += p; }
#pragma unroll
        for (int o = 1; o < 64; o <<= 1) l += __shfl_xor(l, o);
        if (lane == 0) rl[q] = 1.0f / l; }
    __syncthreads();
    { float acc[16];
#pragma unroll
        for (int q = 0; q < 16; ++q) acc[q] = 0.f;
        for (int c = wid; c < NK / 16; c += 8) { const int j0 = 16 * c; float v[16];
#pragma unroll
            for (int u = 0; u < 16; ++u) { const int j = j0 + u; v[u] = j0 < NC ? cv[(((size_t)b * NC + j) * 16 + h) * 64 + lane] : nv[(size_t)(j - NC) * 1024 + lane]; }
            if (MODE == 1 && j0 < NC) {
#pragma unroll
                for (int u = 0; u < 16; ++u) { const int j = j0 + u; if (j >= 16) a.out[O_BVS + (((size_t)b * 512 + (j - 16)) * 16 + h) * 64 + lane] = v[u]; } }
#pragma unroll
            for (int q = 0; q < 16; ++q) {
#pragma unroll
                for (int u4 = 0; u4 < 4; ++u4) { const f32x4 p = *(const LAS f32x4*)(S + q * NKP + j0 + 4 * u4);
                    acc[q] += (p[0] * v[4 * u4] + p[1] * v[4 * u4 + 1]) + (p[2] * v[4 * u4 + 2] + p[3] * v[4 * u4 + 3]); } } }
#pragma unroll
        for (int q = 0; q < 16; ++q) Op[(wid * 16 + q) * 64 + lane] = acc[q]; }
    __syncthreads();
    for (int e = tid; e < 1024; e += 512) { const int q = e >> 6, d = e & 63; float o = 0.f;
#pragma unroll
        for (int w = 0; w < 8; ++w) o += Op[(w * 16 + q) * 64 + d];
        ((bf16*)(a.ws + WS_QO))[(size_t)(MP + b * 16 + q) * 1024 + h * 64 + d] = (bf16)f2bf(o * rl[q]); }
    __syncthreads();
}

#define RLX_AGENT __ATOMIC_RELAXED, __HIP_MEMORY_SCOPE_AGENT
#define XB_TMO      128
#define XB_XCNT(j)  (256  + 64 * (j))
#define XB_XSUB(j)  (1280 + 64 * (j))
#define XB_XGEN(j)  (2304 + 64 * (j))
#define XB_TOP      3328
#define XB_TOPGEN   3392
#define XCD_BAR_WORDS 3456
#define XB_SPIN_CAP (1u << 18)

__device__ __forceinline__ unsigned xb_ld(unsigned* p)              { return __hip_atomic_load(p, __ATOMIC_RELAXED, __HIP_MEMORY_SCOPE_AGENT); }
__device__ __forceinline__ unsigned xb_add(unsigned* p, unsigned v) { return __hip_atomic_fetch_add(p, v, __ATOMIC_RELAXED, __HIP_MEMORY_SCOPE_AGENT); }
__device__ __forceinline__ unsigned xb_xcc_id() { return (unsigned)__builtin_amdgcn_s_getreg((3 << 11) | 20) & 0xFu; }
#define XB_SPIN(cond, bar) do { unsigned _sp = 0; while (cond) { __builtin_amdgcn_s_sleep(1); \
    if ((++_sp & 255u) == 0u) { if (xb_ld(&(bar)[XB_TMO])) break; if (_sp > XB_SPIN_CAP) { atomicAdd(&(bar)[XB_TMO], 1u); break; } } } } while (0)

struct XcdBarrier {
    unsigned* bar; unsigned x;
    volatile LAS unsigned* st;
};

__device__ __forceinline__ XcdBarrier xcd_barrier_post(unsigned* bar, volatile LAS unsigned* st) {
    XcdBarrier b; b.bar = bar; b.x = xb_xcc_id(); b.st = st;
    if (threadIdx.x == 0) (void)xb_add(&bar[XB_XCNT(b.x)], 1u);
    return b;
}
__device__ __forceinline__ void xcd_barrier_complete(unsigned* bar, unsigned x, unsigned& nloc, unsigned& nx) {
    const unsigned G = gridDim.x * gridDim.y * gridDim.z;
    unsigned sum, cnt, mine, sp = 0u;
    for (;;) {
        sum = 0u; cnt = 0u; mine = 0u;
#pragma unroll
        for (unsigned j = 0; j < 16; ++j) { const unsigned c = xb_ld(&bar[XB_XCNT(j)]); sum += c; cnt += (c > 0u) ? 1u : 0u; mine = (j == x) ? c : mine; }
        if (sum == G) break;
        __builtin_amdgcn_s_sleep(1);
        if ((++sp & 255u) == 0u) { if (xb_ld(&bar[XB_TMO])) break; if (sp > XB_SPIN_CAP) { atomicAdd(&bar[XB_TMO], 1u); break; } }
    }
    nloc = mine > 0u ? mine : 1u; nx = cnt > 0u ? cnt : 1u;
}

__device__ __forceinline__ void xcd_barrier(const XcdBarrier& b) {
    asm volatile("s_waitcnt vmcnt(0)" ::: "memory");
    __syncthreads();
    if (threadIdx.x == 0) {
        unsigned* bar = b.bar;
        __builtin_amdgcn_s_waitcnt(0);
        unsigned nloc = b.st[0], nx = b.st[1];
        if (nloc == 0u) { xcd_barrier_complete(bar, b.x, nloc, nx); b.st[0] = nloc; b.st[1] = nx; }
        const unsigned old = xb_add(&bar[XB_XSUB(b.x)], 1u);
        const unsigned gen = old / nloc;
        if (old + 1u == (gen + 1u) * nloc) {
            __builtin_amdgcn_fence(__ATOMIC_RELEASE, "agent");
            asm volatile("s_waitcnt vmcnt(0)" ::: "memory");
            const unsigned og = xb_add(&bar[XB_TOP], 1u);
            const unsigned tg = og / nx;
            if (og + 1u == (tg + 1u) * nx) xb_add(&bar[XB_TOPGEN], 1u);
            else XB_SPIN(xb_ld(&bar[XB_TOPGEN]) == tg, bar);
            __builtin_amdgcn_fence(__ATOMIC_ACQUIRE, "agent");
            xb_add(&bar[XB_XGEN(b.x)], 1u);
            asm volatile("s_waitcnt vmcnt(0)" ::: "memory");
        } else {
            XB_SPIN(xb_ld(&bar[XB_XGEN(b.x)]) == gen, bar);
            __builtin_amdgcn_fence(__ATOMIC_ACQUIRE, "agent");
            asm volatile("s_waitcnt vmcnt(0)" ::: "memory");
        }
    }
    __syncthreads();
}

__device__ __forceinline__ KArgs load_args() {
#if !defined(__HIP_DEVICE_COMPILE__)
    return KArgs{};
#else
    auto p = __builtin_amdgcn_kernarg_segment_ptr(); asm volatile("" : "+s"(p)); return *(const __attribute__((address_space(4))) KArgs*)p;
#endif
}
__global__ void __launch_bounds__(NWAVES * 64, 2) fwd_mega(KArgs args_unused) {
    extern __shared__ __attribute__((aligned(16))) unsigned char lds[];
    LAS unsigned char* L = (LAS unsigned char*)lds;
    const int G = gridDim.x, bx = blockIdx.x, vcu = (G % 8 == 0) ? (bx % 8) * (G / 8) + bx / 8 : bx;
    int lo, hi; XcdBarrier xbar;
    { const KArgs a0 = load_args(); lo = a0.ph_lo; hi = a0.ph_hi;
      volatile LAS unsigned* st = (volatile LAS unsigned*)(L + RING_BYTES + 1024); if (threadIdx.x < 2) st[threadIdx.x] = 0u; __syncthreads();
      xbar = xcd_barrier_post((unsigned*)a0.ws + 4096, st); }
    if (hi > N_PHASES) cg::this_grid().sync();
#ifndef PHMASK
#define PHMASK 0xfff
#endif
#define IN(k) (((PHMASK >> (k)) & 1) && lo <= (k) && (k) < hi)
#define SEAM(k) do { if (IN(k) && IN((k) + 1)) { xcd_barrier(xbar); } } while (0)
#ifndef PROBE_MASK
#define PROBE_MASK 0
#endif
#define SEG_BEGIN(k) unsigned long long seg_t0_ = 0; if ((PROBE_MASK >> (k)) & 1) seg_t0_ = __builtin_amdgcn_s_memrealtime()
#define SEG_END(k) do { if ((PROBE_MASK >> (k)) & 1) { const unsigned long long t1_ = __builtin_amdgcn_s_memrealtime(), d_ = t1_ - seg_t0_; while (__builtin_amdgcn_s_memrealtime() - t1_ < d_) __builtin_amdgcn_s_sleep(8); } } while (0)
#define PHASE_ARGS() int tid = threadIdx.x; asm volatile("" : "+v"(tid)); const int lane = tid & 63, wave = __builtin_amdgcn_readfirstlane(tid >> 6); (void)lane; (void)wave; const KArgs args = load_args(); unsigned char* ws = args.ws; float* out = args.out; (void)out; \
    bf16* QO = (bf16*)(ws + WS_QO); bf16* KB = (bf16*)(ws + WS_KB); bf16* VB = (bf16*)(ws + WS_VB); bf16* HB = (bf16*)(ws + WS_HB); bf16* ACT = (bf16*)(ws + WS_ACT); (void)QO; (void)KB; (void)VB; (void)HB; (void)ACT
#define SSPN(i) ((float*)(ws + WS_SSP + (size_t)(i) * SSP_STRIDE))

    if (IN(0)) {
        PHASE_ARGS();
        SEG_BEGIN(0);
        LAS unsigned char* wf = L + 98304;
        for (int e = tid; e < 32 * 64; e += NWAVES * 64) { const int ks = e >> 6, ln = e & 63, h = ln & 15, kq = ln >> 4, k0 = 32 * ks + 8 * kq; float v[8];
#pragma unroll
            for (int i = 0; i < 8; ++i) v[i] = args.in[8][(size_t)(k0 + i) * 3088 + 3072 + h] * args.in[7][k0 + i];
            *(LAS v4u*)(wf + e * 16) = (v4u){pk2(v[0], v[1]), pk2(v[2], v[3]), pk2(v[4], v[5]), pk2(v[6], v[7])}; }
        __syncthreads();
        { const int g = wave * G + vcu; if (g < MT / 16) p0_row_group(args, g, wf, lane); }
        LAS float* scr = (LAS float*)(L + wave * 8704);
        const int gw = vcu * NWAVES + wave, NGW = G * NWAVES;
        for (int it = gw; it < P0_FIRST; it += NGW) p0_weight_item(args, it, scr, lane);
        SEG_END(0);
    }
    SEAM(0);
    if (IN(1)) {
        PHASE_ARGS();
        SEG_BEGIN(1);
        p1_scan(args, vcu, (LAS float*)L, tid);
        pg8::Gemm g{HB, (const bf16*)(ws + WS_WQKV0), MT, 3072, 1024}; pg8::StaticOrder S; S.init(MT, 3072, G, bx);
        pg8::EpiQKV E{QO, KB, VB, out + O_AKP, out + O_AVP, out + O_AKS, out + O_AVS, SSPN(0), 0, attn_body::C2};
        pg8::gemm_phase<pg8::EpiQKV, pg8::StaticOrder, PG8_ALIGN, PG8_SP2>(L, g, S, E);
        { const int n4 = (MT / 256) * 12 - 3 * G;
          if (n4 >= 0 && n4 < G && bx >= n4) { LAS float* scr = (LAS float*)(L + wave * 8704); const int cw = (bx - n4) * NWAVES + wave, ncw = (G - n4) * NWAVES;
              for (int it = P0_FIRST + cw; it < P0_SECOND; it += ncw) p0_weight_item(args, it, scr, lane); } }
        SEG_END(1);
    }
    SEAM(1);
    if (IN(2)) {
        PHASE_ARGS();
        SEG_BEGIN(2);
        { SEG_BEGIN(12); for (int i = 0; i < 2; ++i) { const int u = 2 * vcu + i; if (u < DECB * NH) sample_attn<0>(args, u >> 4, u & 15, L, tid); } SEG_END(12); }
        const attn_body::AttnTensors AT{(const attn_body::bf16*)QO, (const attn_body::bf16*)KB, (const attn_body::bf16*)VB, (attn_body::bf16*)QO, (const attn_body::bf16*)(ws + WS_KX), args.in[12]};
        const attn_body::StaticOrder S(G, bx);
        attn_body::attn_phase<0, attn_body::StaticOrder>((char*)lds, AT, S);
        SEG_END(2);
    }
    SEAM(2);
    if (IN(3)) {
        PHASE_ARGS();
        SEG_BEGIN(3);
        pg8::Gemm g{QO, (const bf16*)(ws + WS_WO0), MT, 1024, 1024}; pg8::StaticOrder S; S.init(MT, 1024, G, bx);
        pg8::EpiRes E{args.in[0], args.in[1], out, HB, SSPN(1)};
        pg8::gemm_phase<pg8::EpiRes, pg8::StaticOrder, PG8_ALIGN, PG8_SP2>(L, g, S, E);
        SEG_END(3);
    }
    SEAM(3);
    if (IN(4)) {
        PHASE_ARGS();
        SEG_BEGIN(4);
        pg8::Gemm g{HB, (const bf16*)(ws + WS_WGU0), MT, 5632, 1024}; pg8::StaticOrder S; S.init(MT, 5632, G, bx);
        pg8::EpiSwiGLU E{ACT, SSPN(1)};
        pg8::gemm_phase<pg8::EpiSwiGLU, pg8::StaticOrder, PG8_ALIGN, PG8_SP2>(L, g, S, E);
        SEG_END(4);
    }
    SEAM(4);
    if (IN(5)) {
        PHASE_ARGS();
        SEG_BEGIN(5);
        pg8::Gemm g{ACT, (const bf16*)(ws + WS_WD0), MT, 1024, 2816}; pg8::StaticOrder S; S.init(MT, 1024, G, bx);
        pg8::EpiRes E{out, out + (size_t)MP * 1024, out, HB, SSPN(2)};
        pg8::gemm_phase<pg8::EpiRes, pg8::StaticOrder, PG8_ALIGN, PG8_SP2>(L, g, S, E);
        SEG_END(5);
    }
    SEAM(5);
    if (IN(6)) {
        PHASE_ARGS();
        SEG_BEGIN(6);
        pg8::Gemm g{HB, (const bf16*)(ws + WS_WKVQ), MT, 3072, 1024}; pg8::StaticOrder S; S.init(MT, 3072, G, bx);
        pg8::EpiQKV E{QO, KB, VB, out + O_BKP, out + O_BVP, out + O_BKS, out + O_BVS, SSPN(2), 1, attn_body::C2};
        pg8::gemm_phase<pg8::EpiQKV, pg8::StaticOrder, PG8_ALIGN, PG8_SP2>(L, g, S, E);
        { const int n4 = (MT / 256) * 12 - 3 * G;
          if (n4 >= 0 && n4 < G && bx >= n4) { LAS float* scr = (LAS float*)(L + wave * 8704); const int cw = (bx - n4) * NWAVES + wave, ncw = (G - n4) * NWAVES;
              for (int it = P0_SECOND + cw; it < P0_NITEMS; it += ncw) p0_weight_item(args, it, scr, lane); } }
        SEG_END(6);
    }
    SEAM(6);
    if (IN(7)) {
        PHASE_ARGS();
        SEG_BEGIN(7);
        { SEG_BEGIN(13); for (int i = 0; i < 2; ++i) { const int u = 2 * vcu + i; if (u < DECB * NH) sample_attn<1>(args, u >> 4, u & 15, L, tid); } SEG_END(13); }
        const attn_body::AttnTensors AT{(const attn_body::bf16*)QO, (const attn_body::bf16*)KB, (const attn_body::bf16*)VB, (attn_body::bf16*)QO, (const attn_body::bf16*)(ws + WS_KX), args.in[12]};
        const attn_body::StaticOrder S(G, bx);
        attn_body::attn_phase<1, attn_body::StaticOrder>((char*)lds, AT, S);
        SEG_END(7);
    }
    SEAM(7);
    if (IN(8)) {
        PHASE_ARGS();
        SEG_BEGIN(8);
        pg8::Gemm g{QO, (const bf16*)(ws + WS_WO1), MT, 1024, 1024}; pg8::StaticOrder S; S.init(MT, 1024, G, bx);
        pg8::EpiRes E{out, out + (size_t)MP * 1024, out, HB, SSPN(3)};
        pg8::gemm_phase<pg8::EpiRes, pg8::StaticOrder, PG8_ALIGN, PG8_SP2>(L, g, S, E);
        SEG_END(8);
    }
    SEAM(8);
    if (IN(9)) {
        PHASE_ARGS();
        SEG_BEGIN(9);
        pg8::Gemm g{HB, (const bf16*)(ws + WS_WGU1), MT, 5632, 1024}; pg8::StaticOrder S; S.init(MT, 5632, G, bx);
        pg8::EpiSwiGLU E{ACT, SSPN(3)};
        pg8::gemm_phase<pg8::EpiSwiGLU, pg8::StaticOrder, PG8_ALIGN, PG8_SP2>(L, g, S, E);
        SEG_END(9);
    }
    SEAM(9);
    if (IN(10)) {
        PHASE_ARGS();
        SEG_BEGIN(10);
        pg8::Gemm g{ACT, (const bf16*)(ws + WS_WD1), MT, 1024, 2816}; pg8::StaticOrder S; S.init(MT, 1024, G, bx);
        pg8::EpiRes E{out, out + (size_t)MP * 1024, out, HB, SSPN(4)};
        pg8::gemm_phase<pg8::EpiRes, pg8::StaticOrder, PG8_ALIGN, PG8_SP2>(L, g, S, E);
        SEG_END(10);
    }
    SEAM(10);
    if (IN(11)) {
        PHASE_ARGS();
        SEG_BEGIN(11);
        const int gw = vcu * NWAVES + wave, NGW = G * NWAVES; const float* gf = args.in[19]; const float* ssp = SSPN(4);
        f32x4 gv[4];
#pragma unroll
        for (int j = 0; j < 4; ++j) gv[j] = *(const f32x4*)(gf + 256 * j + 4 * lane);
        for (int m = gw; m < MT; m += NGW) {
            float s = 0.f;
#pragma unroll
            for (int j = 0; j < 4; ++j) { const f32x4 p = *(const f32x4*)(ssp + (size_t)m * 16 + 4 * j); s += (p[0] + p[1]) + (p[2] + p[3]); }
            const float rstd = 1.0f / sqrtf(s * (1.0f / 1024.0f) + 1e-6f);
            float* r = out + (size_t)m * 1024 + 4 * lane;
#pragma unroll
            for (int j = 0; j < 4; ++j) { f32x4 v = *(f32x4*)(r + 256 * j); v = v * rstd * gv[j]; *(f32x4*)(r + 256 * j) = v; }
        }
        SEG_END(11);
    }
#undef IN
#undef SEAM
}

extern "C" void kernel_launch(void* const* d_in, const int* in_sizes, int n_in, void* d_out, int out_size, void* d_ws, size_t ws_size, hipStream_t stream) {
    static int grid = 0;
    if (grid == 0) {
        if (n_in != 20 || (size_t)out_size != O_END || ws_size < WS_END) { fprintf(stderr, "kernel_launch: unexpected shapes (n_in %d out %d ws %zu)\n", n_in, out_size, ws_size); grid = -1; return; }
        int dev = 0, cus = 0, per_cu = 0;
        hipGetDevice(&dev); hipDeviceGetAttribute(&cus, hipDeviceAttributeMultiprocessorCount, dev);
        if (hipFuncSetAttribute((const void*)fwd_mega, hipFuncAttributeMaxDynamicSharedMemorySize, LDS_BYTES) != hipSuccess) { fprintf(stderr, "kernel_launch: hipFuncSetAttribute failed\n"); grid = -1; return; }
        if (hipOccupancyMaxActiveBlocksPerMultiprocessor(&per_cu, (const void*)fwd_mega, NWAVES * 64, LDS_BYTES) != hipSuccess || per_cu < 1) { fprintf(stderr, "kernel_launch: occupancy query says %d\n", per_cu); per_cu = 1; }
        (void)hipGetLastError();
        grid = cus * per_cu;
        if (grid != 256) fprintf(stderr, "kernel_launch: grid %d (expected 256)\n", grid);
    }
    if (grid < 0) return;
    if (hipMemsetAsync(d_ws, 0, 65536, stream) != hipSuccess) { fprintf(stderr, "kernel_launch: memset failed\n"); return; }
    KArgs a{};
    for (int i = 0; i < 20; ++i) a.in[i] = (const float*)d_in[i];
    a.out = (float*)d_out; a.ws = (unsigned char*)d_ws;
#if MK_PER_PHASE
    for (int p = 0; p < N_PHASES; ++p) { a.ph_lo = p; a.ph_hi = p + 1; void* kargs[] = {&a};
        hipError_t e = hipLaunchCooperativeKernel((const void*)fwd_mega, dim3(grid), dim3(NWAVES * 64), kargs, LDS_BYTES, stream);
        if (e != hipSuccess) { fprintf(stderr, "kernel_launch: launch %d failed: %s\n", p, hipGetErrorString(e)); break; } }
#else
    a.ph_lo = 0; a.ph_hi = N_PHASES; void* kargs[] = {&a};
    hipError_t e = hipLaunchCooperativeKernel((const void*)fwd_mega, dim3(grid), dim3(NWAVES * 64), kargs, LDS_BYTES, stream);
    if (e != hipSuccess) fprintf(stderr, "kernel_launch: cooperative launch failed: %s (grid %d)\n", hipGetErrorString(e), grid);
#endif
}
```

```cpp
#include <hip/hip_cooperative_groups.h>
#include <hip/hip_runtime.h>
#include <cstdio>
#include <cstdint>
namespace pg8 {
#define PG8_LAS __attribute__((address_space(3)))
typedef unsigned short bf16_t;
typedef short bf16x8 __attribute__((ext_vector_type(8)));
typedef float f32x4 __attribute__((ext_vector_type(4)));
typedef unsigned u32x4 __attribute__((ext_vector_type(4)));
constexpr int BM = 256, BK = 64, HALF = 128, HTB = HALF * BK * 2  , STAGE_BYTES = 8 * HTB, NXCD = 8, WGM = 8;

__host__ __device__ __forceinline__ int lds_byte(int r, int c) { const int st = (r >> 4) * 2 + (c >> 5), rr = r & 15, cc = c & 31, ob = rr * 64 + cc * 2; return st * 1024 + (ob ^ (((ob >> 9) & 1) << 5)); }
__host__ __device__ __forceinline__ void stage_rc(int b, int& R, int& C) { const int st = b / 1024, sb = b % 1024, swz = sb ^ (((sb >> 9) & 1) << 5); R = (st >> 1) * 16 + swz / 64; C = (st & 1) * 32 + (swz % 64) / 2; }
__host__ __device__ __forceinline__ int perm32(int rho) { const int n = rho >> 4, i = rho & 15; return 8 * (i >> 2) + 4 * n + (i & 3); }

struct Unit { int pm, pn; };
struct Gemm { const bf16_t* A; const bf16_t* Bt; int M, N, K; };

struct StaticOrder {
    int nM, nN, nwg, G, c;
    __host__ __device__ void init(int M, int N, int G_, int c_) { nM = M / BM; nN = N / BM; nwg = nM * nN; G = G_; c = c_; }
    __host__ __device__ bool next(int i, Unit& u) const {
        const long L = (long)i * G + c; if (L >= nwg) return false;
        int wgid = (int)L; { const int q = nwg / NXCD, r = nwg % NXCD, xcd = wgid % NXCD, off = wgid / NXCD; wgid = (xcd < r ? xcd * (q + 1) : r * (q + 1) + (xcd - r) * q) + off; }
        const int nig = WGM * nN, gid = wgid / nig, fm = gid * WGM, gsz = (nM - fm) < WGM ? (nM - fm) : WGM;
        u.pm = fm + ((wgid % nig) % gsz); u.pn = (wgid % nig) / gsz; return true;
    }
    __device__ __forceinline__ void a_ready(const Unit&) const {}
    __device__ __forceinline__ void done(const Unit&) const {}
};

struct FlexOrder {
    int nN, nwg, nprompt, G, c, ns, ks, nmain;
    unsigned *arrP, *arrS, *waitP, *waitS; unsigned tgtP, tgtS; PG8_LAS unsigned* larr; volatile PG8_LAS unsigned* stw; mutable int acq;
    __device__ void init(int nN_, int G_, int c_, int ns_, int ks_) { nN = nN_; nprompt = 64 * nN_; nwg = 66 * nN_; G = G_; c = c_; ns = ns_; ks = ks_; nmain = nwg - ns_ * ks_;
        arrP = arrS = waitP = waitS = nullptr; tgtP = tgtS = 0u; larr = nullptr; stw = nullptr; acq = 0; }
    __device__ bool next(int i, Unit& u) const {
        int L;
        if (c >= ns) { L = i * (G - ns) + (c - ns); if (L >= nmain) return false; } else { if (i >= ks) return false; L = nmain + i * ns + c; }
        if (L < nprompt) { int wgid = L; { const int q = nprompt / NXCD, r = nprompt % NXCD, xcd = wgid % NXCD, off = wgid / NXCD; wgid = (xcd < r ? xcd * (q + 1) : r * (q + 1) + (xcd - r) * q) + off; }
            const int nig = WGM * nN, gid = wgid / nig, fm = gid * WGM, gsz = (64 - fm) < WGM ? (64 - fm) : WGM;
            u.pm = fm + ((wgid % nig) % gsz); u.pn = (wgid % nig) / gsz; }
        else { const int s = L - nprompt; u.pm = 64 + s / nN; u.pn = s % nN; }
        return true;
    }
    __device__ __forceinline__ void a_ready(const Unit& u) const {
        if (!waitP) return;
        const int bit = u.pm >= 64 ? 2 : 1; if (acq & bit) return;
        unsigned* p = bit == 1 ? waitP : waitS; const unsigned tgt = bit == 1 ? tgtP : tgtS; unsigned sp = 0;
        while (__hip_atomic_load(p, __ATOMIC_RELAXED, __HIP_MEMORY_SCOPE_AGENT) < tgt) { __builtin_amdgcn_s_sleep(4); if (++sp > (1u << 22)) break; }
        __builtin_amdgcn_fence(__ATOMIC_ACQUIRE, "agent"); asm volatile("s_waitcnt vmcnt(0)" ::: "memory");
        acq |= bit;
    }
    __device__ __forceinline__ void done(const Unit& u) const {
        if (!arrP) return;
        asm volatile("s_waitcnt vmcnt(0)" ::: "memory");
        if ((threadIdx.x & 63) == 0) {
            const unsigned old = __hip_atomic_fetch_add(larr, 1u, __ATOMIC_RELAXED, __HIP_MEMORY_SCOPE_WORKGROUP);
            if ((old & 7u) == 7u) {
                if (u.pm >= 64) { __builtin_amdgcn_fence(__ATOMIC_RELEASE, "agent"); asm volatile("s_waitcnt vmcnt(0)" ::: "memory");
                    __hip_atomic_fetch_add(arrS, 1u, __ATOMIC_RELAXED, __HIP_MEMORY_SCOPE_AGENT); }
                else {
                    const unsigned x = (unsigned)__builtin_amdgcn_s_getreg((3 << 11) | 20) & 0xFu, nloc = stw[0];
                    const unsigned o = __hip_atomic_fetch_add(arrP + 64 * x, 1u, __ATOMIC_RELAXED, __HIP_MEMORY_SCOPE_AGENT);
                    if (o + 1u == nloc) { __builtin_amdgcn_fence(__ATOMIC_RELEASE, "agent"); asm volatile("s_waitcnt vmcnt(0)" ::: "memory");
                        __hip_atomic_fetch_add(arrP + 1024, 1u, __ATOMIC_RELAXED, __HIP_MEMORY_SCOPE_AGENT); } } }
        }
    }
};

__device__ __forceinline__ unsigned cvt_pk_bf16(float lo, float hi) { unsigned r; asm volatile("v_cvt_pk_bf16_f32 %0, %1, %2" : "=v"(r) : "v"(lo), "v"(hi)); return r; }
__device__ __forceinline__ void st16(void* p, u32x4 v) {
#if defined(EPI_WT) && EPI_WT
    asm volatile("global_store_dwordx4 %0, %1, off sc1" : : "v"(p), "v"(v) : "memory");
#else
    *(u32x4*)p = v;
#endif
}
__device__ __forceinline__ void st16f(void* p, f32x4 v) { st16(p, __builtin_bit_cast(u32x4, v)); }
constexpr int MP_ROWS = 16384;
constexpr float RMS_EPS = 1e-6f;
__device__ __forceinline__ void row_rstd(float (&rs)[2][4], const float* ssp, int row0, int fq) {
#pragma unroll
    for (int ai = 0; ai < 2; ++ai)
#pragma unroll
        for (int m = 0; m < 4; ++m) { const f32x4 p = *(const f32x4*)(ssp + (size_t)(row0 + ai * HALF + m * 16) * 16 + 4 * fq);
            float s = (p[0] + p[1]) + (p[2] + p[3]); s += __shfl_xor(s, 16); s += __shfl_xor(s, 32);
            rs[ai][m] = 1.0f / sqrtf(s * (1.0f / 1024.0f) + RMS_EPS); }
}
struct EpiQKV {
    static constexpr bool PERM = true, AFTER_DRAIN = false;
    bf16_t *Qb, *Kb, *Vb; float *kp, *vp, *ks, *vs; const float* ssp; int layer; float qscale;
    __device__ __forceinline__ long frow(int row) const {
        if (layer == 0) return row < MP_ROWS ? (long)row * 1024 : (long)(row - MP_ROWS) * 1024;
        if (row < MP_ROWS) { const int t = row & 8191, b = row >> 13; return t >= 7680 ? (long)(b * 512 + t - 7680) * 1024 : -1; }
        const int sr = row - MP_ROWS; return (long)((sr >> 4) * 512 + 496 + (sr & 15)) * 1024;
    }
    __device__ __forceinline__ void operator()(const f32x4 (&acc)[2][2][4][2], const Unit& u, int wr, int wc, int fr, int fq) const {
        const int t = u.pn >> 2, colt = (u.pn & 3) * BM, row0 = u.pm * BM + wr * 64 + fr, col0 = colt + wc * 32 + 8 * fq;
        float rs[2][4]; row_rstd(rs, ssp, row0, fq);
        bf16_t* const qb_ = Qb; bf16_t* const kb_ = Kb; bf16_t* const vb_ = Vb; float* const kp_ = kp; float* const vp_ = vp; float* const ks_ = ks; float* const vs_ = vs;
        bf16_t* B = t == 0 ? qb_ : (t == 1 ? kb_ : vb_); const float sc = t == 0 ? qscale : 1.f;
        const bool prow = u.pm < 64;
        float* fb = t == 1 ? (prow ? kp_ : ks_) : (prow ? vp_ : vs_);
        const bool anyf = t > 0 && (layer == 0 || !prow || (u.pm & 31) >= 30);
#pragma unroll
        for (int ai = 0; ai < 2; ++ai)
#pragma unroll
            for (int m = 0; m < 4; ++m) { const int row = row0 + ai * HALF + m * 16; const float r = rs[ai][m];
                const long fo = anyf ? frow(row) : -1;
#pragma unroll
                for (int bj = 0; bj < 2; ++bj) { f32x4 v0 = acc[ai][bj][m][0] * r, v1 = acc[ai][bj][m][1] * r;
                    if (fo >= 0) { float* fp = fb + fo + col0 + bj * HALF; st16f(fp, v0); st16f(fp + 4, v1); }
                    v0 = v0 * sc; v1 = v1 * sc; u32x4 w; w.x = cvt_pk_bf16(v0[0], v0[1]); w.y = cvt_pk_bf16(v0[2], v0[3]); w.z = cvt_pk_bf16(v1[0], v1[1]); w.w = cvt_pk_bf16(v1[2], v1[3]);
                    st16(B + (size_t)row * 1024 + col0 + bj * HALF, w); } }
    }
};
struct EpiRes {
    static constexpr bool PERM = true, AFTER_DRAIN = false;
    const float *base_p, *base_s; float* H; bf16_t* HB; float* ssp;
    __device__ __forceinline__ void operator()(const f32x4 (&acc)[2][2][4][2], const Unit& u, int wr, int wc, int fr, int fq) const {
        const int col0 = u.pn * BM + wc * 32 + 8 * fq, rl0 = wr * 64 + fr;
        const float* base = u.pm < 64 ? base_p + (size_t)u.pm * BM * 1024 : base_s + (size_t)(u.pm - 64) * BM * 1024;
#pragma unroll
        for (int ai = 0; ai < 2; ++ai)
#pragma unroll
            for (int m = 0; m < 4; ++m) { const int rl = rl0 + ai * HALF + m * 16; const size_t row = (size_t)u.pm * BM + rl; float ss = 0.f;
#pragma unroll
                for (int bj = 0; bj < 2; ++bj) { const float* bp = base + (size_t)rl * 1024 + col0 + bj * HALF;
                    const f32x4 v0 = acc[ai][bj][m][0] + *(const f32x4*)bp, v1 = acc[ai][bj][m][1] + *(const f32x4*)(bp + 4);
                    ss += (v0[0] * v0[0] + v0[1] * v0[1]) + (v0[2] * v0[2] + v0[3] * v0[3]) + (v1[0] * v1[0] + v1[1] * v1[1]) + (v1[2] * v1[2] + v1[3] * v1[3]);
                    float* hp = H + row * 1024 + col0 + bj * HALF; st16f(hp, v0); st16f(hp + 4, v1);
                    u32x4 w; w.x = cvt_pk_bf16(v0[0], v0[1]); w.y = cvt_pk_bf16(v0[2], v0[3]); w.z = cvt_pk_bf16(v1[0], v1[1]); w.w = cvt_pk_bf16(v1[2], v1[3]);
                    st16(HB + row * 1024 + col0 + bj * HALF, w); }
                ss += __shfl_xor(ss, 16); ss += __shfl_xor(ss, 32);
                if (fq == 0) ssp[row * 16 + u.pn * 4 + wc] = ss;
                if (m & 1) asm volatile("" ::: "memory"); }
    }
};
struct EpiSwiGLU {
    static constexpr bool PERM = true, AFTER_DRAIN = false;
    bf16_t* ACT; const float* ssp;
    __device__ __forceinline__ void operator()(const f32x4 (&acc)[2][2][4][2], const Unit& u, int wr, int wc, int fr, int fq) const {
        const int row0 = u.pm * BM + wr * 64 + fr, col0 = u.pn * HALF + wc * 32 + 8 * fq;
        float rs[2][4]; row_rstd(rs, ssp, row0, fq);
#pragma unroll
        for (int ai = 0; ai < 2; ++ai)
#pragma unroll
            for (int m = 0; m < 4; ++m) { const int row = row0 + ai * HALF + m * 16; const float r = rs[ai][m]; float o[8];
#pragma unroll
                for (int n = 0; n < 2; ++n)
#pragma unroll
                    for (int e = 0; e < 4; ++e) { const float g = acc[ai][0][m][n][e] * r, up = acc[ai][1][m][n][e] * r;
                        o[n * 4 + e] = g * __builtin_amdgcn_rcpf(1.0f + __builtin_amdgcn_exp2f(g * -1.4426950408889634f)) * up; }
                u32x4 w; w.x = cvt_pk_bf16(o[0], o[1]); w.y = cvt_pk_bf16(o[2], o[3]); w.z = cvt_pk_bf16(o[4], o[5]); w.w = cvt_pk_bf16(o[6], o[7]);
                st16(ACT + (size_t)row * 2816 + col0, w); }
    }
};

template <class Epi, class Sched, bool ALIGN_EPI = false, bool SP2 = false>
__device__ __forceinline__ void gemm_phase(PG8_LAS unsigned char* lds, const Gemm g, const Sched& S, const Epi& E) {
    int tid_ = threadIdx.x; asm volatile("" : "+v"(tid_));
    const int tid = tid_, wid = __builtin_amdgcn_readfirstlane(tid >> 6), lane = tid & 63, wr = wid >> 2, wc = wid & 3, fr = lane & 15, fq = lane >> 4;
    const int K = g.K, nt = K / BK;
    unsigned voffA[2], voffB[2];
#pragma unroll
    for (int i = 0; i < 2; ++i) { int R, C; stage_rc(tid * 16 + i * 8192, R, C); const int Rb = Epi::PERM ? ((R & ~31) + perm32(R & 31)) : R;
        voffA[i] = (unsigned)(R * K + C) * 2u; voffB[i] = (unsigned)(Rb * K + C) * 2u; }
    const size_t kstep = (size_t)(BK * 2);
    const size_t hstep = (size_t)HALF * K * 2;
    const size_t tstep = 2 * hstep;
    const unsigned ldsw = (unsigned)wid * 1024u;
    const int aoff = lds_byte(wr * 64 + fr, fq * 8), boff = lds_byte(wc * 32 + fr, fq * 8);
#define PG8_SA(b, h) (((b) * 2 + (h)) * HTB)
#define PG8_SB(b, h) ((4 + (b) * 2 + (h)) * HTB)
#define PG8_STAGE(bufoff, gbase, voff) do { _Pragma("unroll") for (int _i = 0; _i < 2; ++_i) \
        __builtin_amdgcn_global_load_lds((const unsigned*)((const char*)(gbase) + (voff)[_i]), (PG8_LAS unsigned*)(lds + (bufoff) + ldsw + _i * 8192), 16, 0, 0); } while (0)
#define PG8_LDA(dst, b, h) do { _Pragma("unroll") for (int m = 0; m < 4; ++m) _Pragma("unroll") for (int k = 0; k < 2; ++k) dst[m][k] = *(const PG8_LAS bf16x8*)(lds + PG8_SA(b, h) + aoff + m * 2048 + k * 1024); } while (0)
#define PG8_LDB(dst, b, h) do { _Pragma("unroll") for (int n = 0; n < 2; ++n) _Pragma("unroll") for (int k = 0; k < 2; ++k) dst[n][k] = *(const PG8_LAS bf16x8*)(lds + PG8_SB(b, h) + boff + n * 2048 + k * 1024); } while (0)
#define PG8_MMA(ai, bj, At, Bt) do { __builtin_amdgcn_s_setprio(1); _Pragma("unroll") for (int m = 0; m < 4; ++m) _Pragma("unroll") for (int n = 0; n < 2; ++n) _Pragma("unroll") for (int k = 0; k < 2; ++k) \
        acc[ai][bj][m][n] = __builtin_amdgcn_mfma_f32_16x16x32_bf16(Bt[n][k], At[m][k], acc[ai][bj][m][n], 0, 0, 0); __builtin_amdgcn_s_setprio(0); } while (0)
#define PG8_WAIT_V(n) asm volatile("s_waitcnt vmcnt(" #n ")" ::: "memory")
#define PG8_WAIT_L(n) asm volatile("s_waitcnt lgkmcnt(" #n ")" ::: "memory")
#define PG8_BAR __builtin_amdgcn_s_barrier()
#define PG8_SCHED __builtin_amdgcn_sched_barrier(0)
    Unit cur, nxt; int ui = 0;
    if (!S.next(0, cur)) return;
    f32x4 acc[2][2][4][2];
#pragma unroll
    for (int a = 0; a < 2; ++a)
#pragma unroll
        for (int b = 0; b < 2; ++b)
#pragma unroll
            for (int m = 0; m < 4; ++m)
#pragma unroll
                for (int n = 0; n < 2; ++n) acc[a][b][m][n] = (f32x4){0.f, 0.f, 0.f, 0.f};
    bf16x8 At[4][2], B0[2][2], B1[2][2];
    const char* cA = (const char*)g.A + (size_t)cur.pm * tstep; const char* cB = (const char*)g.Bt + (size_t)cur.pn * tstep;
    S.a_ready(cur);
    if constexpr (SP2) {
        PG8_STAGE(PG8_SB(0, 0), cB, voffB); PG8_STAGE(PG8_SB(0, 1), cB + hstep, voffB); PG8_STAGE(PG8_SA(0, 0), cA, voffA); PG8_STAGE(PG8_SA(0, 1), cA + hstep, voffA);
        if (wr == 1) PG8_BAR;
        PG8_WAIT_V(2); PG8_BAR;
        PG8_STAGE(PG8_SB(1, 0), cB + kstep, voffB); PG8_STAGE(PG8_SA(1, 0), cA + kstep, voffA); PG8_STAGE(PG8_SB(1, 1), cB + hstep + kstep, voffB);
        PG8_WAIT_V(6); PG8_BAR;
    } else {
        PG8_STAGE(PG8_SB(0, 0), cB, voffB); PG8_STAGE(PG8_SA(0, 0), cA, voffA); PG8_STAGE(PG8_SB(0, 1), cB + hstep, voffB); PG8_STAGE(PG8_SA(0, 1), cA + hstep, voffA);
        if (wr == 1) PG8_BAR;
        PG8_WAIT_V(4); PG8_BAR;
        PG8_STAGE(PG8_SB(1, 0), cB + kstep, voffB); PG8_STAGE(PG8_SA(1, 0), cA + kstep, voffA); PG8_STAGE(PG8_SB(1, 1), cB + hstep + kstep, voffB);
        PG8_WAIT_V(6); PG8_BAR;
    }
    for (;;) {
        const bool has_next = S.next(ui + 1, nxt);
        const char* nA = has_next ? (const char*)g.A + (size_t)nxt.pm * tstep : cA; const char* nB = has_next ? (const char*)g.Bt + (size_t)nxt.pn * tstep : cB;
        for (int t = 0; t < nt; t += 2) {
            const bool last = (t == nt - 2);
            const char* a1 = cA + (size_t)(t + 1) * kstep;
            const char* a2 = last ? nA : cA + (size_t)(t + 2) * kstep; const char* b2 = last ? nB : cB + (size_t)(t + 2) * kstep;
            const char* a3 = a2 + kstep; const char* b3 = b2 + kstep;
            if (last && has_next) S.a_ready(nxt);
            if constexpr (SP2) {
            PG8_LDB(B0, 0, 0); PG8_LDB(B1, 0, 1); PG8_SCHED; PG8_LDA(At, 0, 0); PG8_STAGE(PG8_SA(1, 1), a1 + hstep, voffA);
            PG8_WAIT_V(8); PG8_WAIT_L(0); PG8_BAR; PG8_MMA(0, 0, At, B0); PG8_MMA(0, 1, At, B1); PG8_BAR; PG8_SCHED;
            PG8_LDA(At, 0, 1); PG8_STAGE(PG8_SB(0, 0), b2, voffB); PG8_STAGE(PG8_SB(0, 1), b2 + hstep, voffB); PG8_STAGE(PG8_SA(0, 0), a2, voffA);
            PG8_WAIT_V(8); PG8_WAIT_L(0); PG8_BAR; PG8_MMA(1, 0, At, B0); PG8_MMA(1, 1, At, B1); PG8_BAR; PG8_SCHED;
            PG8_LDB(B0, 1, 0); PG8_LDB(B1, 1, 1); PG8_SCHED; PG8_LDA(At, 1, 0); PG8_STAGE(PG8_SA(0, 1), a2 + hstep, voffA);
            PG8_WAIT_V(8); PG8_WAIT_L(0); PG8_BAR; PG8_MMA(0, 0, At, B0); PG8_MMA(0, 1, At, B1); PG8_BAR; PG8_SCHED;
            PG8_LDA(At, 1, 1); PG8_STAGE(PG8_SB(1, 0), b3, voffB); PG8_STAGE(PG8_SB(1, 1), b3 + hstep, voffB); PG8_STAGE(PG8_SA(1, 0), a3, voffA);
            PG8_WAIT_V(8); PG8_WAIT_L(0); PG8_BAR; PG8_MMA(1, 0, At, B0); PG8_MMA(1, 1, At, B1); PG8_BAR; PG8_SCHED;
            } else {
            PG8_LDB(B0, 0, 0); PG8_SCHED; PG8_LDA(At, 0, 0); PG8_STAGE(PG8_SA(1, 1), a1 + hstep, voffA);
            PG8_WAIT_L(8); PG8_BAR; PG8_WAIT_L(0); PG8_MMA(0, 0, At, B0); PG8_BAR; PG8_SCHED;
            PG8_LDB(B1, 0, 1); PG8_STAGE(PG8_SB(0, 0), b2, voffB);
            PG8_BAR; PG8_WAIT_L(0); PG8_MMA(0, 1, At, B1); PG8_BAR;
            PG8_LDA(At, 0, 1); PG8_STAGE(PG8_SA(0, 0), a2, voffA);
            PG8_BAR; PG8_WAIT_L(0); PG8_MMA(1, 0, At, B0); PG8_BAR; PG8_SCHED;
            PG8_STAGE(PG8_SB(0, 1), b2 + hstep, voffB);
            PG8_WAIT_V(6); PG8_BAR; PG8_MMA(1, 1, At, B1); PG8_BAR;
            PG8_LDB(B0, 1, 0); PG8_SCHED; PG8_LDA(At, 1, 0); PG8_STAGE(PG8_SA(0, 1), a2 + hstep, voffA);
            PG8_WAIT_L(8); PG8_BAR; PG8_WAIT_L(0); PG8_MMA(0, 0, At, B0); PG8_BAR; PG8_SCHED;
            PG8_LDB(B1, 1, 1); PG8_STAGE(PG8_SB(1, 0), b3, voffB);
            PG8_BAR; PG8_WAIT_L(0); PG8_MMA(0, 1, At, B1); PG8_BAR;
            PG8_LDA(At, 1, 1); PG8_STAGE(PG8_SA(1, 0), a3, voffA);
            PG8_BAR; PG8_WAIT_L(0); PG8_MMA(1, 0, At, B0); PG8_BAR; PG8_SCHED;
            PG8_STAGE(PG8_SB(1, 1), b3 + hstep, voffB);
            PG8_WAIT_V(6); PG8_BAR; PG8_MMA(1, 1, At, B1); PG8_BAR;
            }
        }
        if constexpr (ALIGN_EPI) { if (wr == 0) PG8_BAR; }
        if constexpr (!Epi::AFTER_DRAIN) { E(acc, cur, wr, wc, fr, fq); S.done(cur); }
        if (!has_next) break;
#pragma unroll
        for (int a = 0; a < 2; ++a)
#pragma unroll
            for (int b = 0; b < 2; ++b)
#pragma unroll
                for (int m = 0; m < 4; ++m)
#pragma unroll
                    for (int n = 0; n < 2; ++n) acc[a][b][m][n] = (f32x4){0.f, 0.f, 0.f, 0.f};
        cur = nxt; cA = nA; cB = nB; ++ui;
        if constexpr (ALIGN_EPI) { if (wr == 1) PG8_BAR; }
    }
    PG8_WAIT_V(0);
    if constexpr (!ALIGN_EPI) { if (wr == 0) PG8_BAR; }
    PG8_BAR;
    if constexpr (Epi::AFTER_DRAIN) { E.fused(acc, cur, wr, wc, fr, fq, lds, wid, lane); S.done(cur); }
#undef PG8_SA
#undef PG8_SB
#undef PG8_STAGE
#undef PG8_LDA
#undef PG8_LDB
#undef PG8_MMA
#undef PG8_WAIT_V
#undef PG8_WAIT_L
#undef PG8_BAR
#undef PG8_SCHED
}
}

#ifndef PG8_SP2
#define PG8_SP2 true
#endif
#ifndef PG8_ALIGN
#define PG8_ALIGN true
#endif
#include <hip/hip_bf16.h>
#include <cmath>
namespace attn_body {
using bf16=__hip_bfloat16;
using bf16x8=__attribute__((ext_vector_type(8)))short;
using s16x4=__attribute__((ext_vector_type(4)))short;
using f32x16=__attribute__((ext_vector_type(16)))float;
using u32x4=__attribute__((ext_vector_type(4)))unsigned;
constexpr int BATCH=2,NHEAD=16,SEQ=8192,D=64,DM=NHEAD*D;
constexpr int NW=8,QBLK=32,QB=QBLK*NW,KVBLK=64,NQB=SEQ/QB;
constexpr int ATTN_PITCH=DM, ATTN_UNIT_ROWS=QB;
__device__ __forceinline__ int crow(int r,int hi){return (r&3)+8*(r>>2)+4*hi;}
#define SBAR() __builtin_amdgcn_sched_barrier(0)
__device__ __forceinline__ void cmask(f32x16&p0,f32x16&p1,int jb,int qrel,int hi){
  const float NEG=-INFINITY; int kb=64*jb+4*hi;
  #pragma unroll
  for(int r=0;r<16;++r){int kv=kb+(r&3)+8*(r>>2); if(kv>qrel)p0[r]=NEG; if(kv+32>qrel)p1[r]=NEG;}
}

constexpr int NSLOT=3, SLOTB=8192;
constexpr int LDS_K=0, LDS_V=NSLOT*SLOTB, LDS_WS=2*NSLOT*SLOTB, LDS_OST=LDS_WS+NW*64*4, LDS_X=LDS_OST+NW*4096, LDS_BT=LDS_X+NSLOT*2048, LDS_BYTES=LDS_BT+2048;
constexpr float C2=0.125f*1.4426950408889634f;
__device__ __forceinline__ void glds16(const void*gsrc,unsigned lds_dst){unsigned keep;
  asm volatile("s_mov_b32 %0, m0\n\ts_mov_b32 m0, %2\n\ts_nop 0\n\tglobal_load_lds_dwordx4 %1, off\n\ts_mov_b32 m0, %0":"=&s"(keep):"v"(gsrc),"s"(lds_dst):"memory");}
__device__ __forceinline__ void glds16s(const void*sbase,unsigned voff,unsigned lds_dst){unsigned keep;
  asm volatile("s_mov_b32 %0, m0\n\ts_mov_b32 m0, %3\n\ts_nop 0\n\tglobal_load_lds_dwordx4 %1, %2\n\ts_mov_b32 m0, %0":"=&s"(keep):"v"(voff),"s"(sbase),"s"(lds_dst):"memory");}
__device__ __forceinline__ void glds4s(const void*sbase,unsigned voff,unsigned lds_dst){unsigned keep;
  asm volatile("s_mov_b32 %0, m0\n\ts_mov_b32 m0, %3\n\ts_nop 0\n\tglobal_load_lds_dword %1, %2\n\ts_mov_b32 m0, %0":"=&s"(keep):"v"(voff),"s"(sbase),"s"(lds_dst):"memory");}
__device__ __forceinline__ void glds4(const void*gsrc,unsigned lds_dst){unsigned keep;
  asm volatile("s_mov_b32 %0, m0\n\ts_mov_b32 m0, %2\n\ts_nop 0\n\tglobal_load_lds_dword %1, off\n\ts_mov_b32 m0, %0":"=&s"(keep):"v"(gsrc),"s"(lds_dst):"memory");}
__device__ __forceinline__ float max3f(float a,float b,float c){float r;asm("v_max3_f32 %0, %1, %2, %3":"=v"(r):"v"(a),"v"(b),"v"(c));return r;}
__device__ __forceinline__ float max2f(float a,float b){float r;asm("v_max_f32_e32 %0, %1, %2":"=v"(r):"v"(a),"v"(b));return r;}
__device__ __forceinline__ float fadd_s(float a,float b){float r;asm("v_add_f32_e32 %0, %1, %2":"=v"(r):"v"(a),"v"(b));return r;}
__device__ __forceinline__ float fsub_s(float a,float b){float r;asm("v_sub_f32_e32 %0, %1, %2":"=v"(r):"v"(a),"v"(b));return r;}
typedef float f32x2_t __attribute__((ext_vector_type(2))); typedef __bf16 bf16x2_t __attribute__((ext_vector_type(2)));
__device__ __forceinline__ unsigned cvtpk_s(float lo,float hi){f32x2_t v={lo,hi};bf16x2_t b=__builtin_convertvector(v,bf16x2_t);return __builtin_bit_cast(unsigned,b);}
#define WAIT_BAR(N) asm volatile("s_waitcnt vmcnt(" #N ") lgkmcnt(0)\n\ts_barrier":::"memory")

__device__ __forceinline__ void qkt(f32x16&p0,f32x16&p1,const char*Kslot,const bf16x8*qr,bf16x8 kx0,bf16x8 kx1,bf16x8 qe,int r32,int hi){
  const char*kb=Kslot+hi*1024+r32*16;
  #pragma unroll
  for(int d0=0;d0<4;++d0){
    const bf16x8 b0=*reinterpret_cast<const bf16x8*>(kb+d0*2048);
    const bf16x8 b1=*reinterpret_cast<const bf16x8*>(kb+d0*2048+512);
    if(d0==0){const f32x16 z=f32x16{};p0=__builtin_amdgcn_mfma_f32_32x32x16_bf16(kx0,qe,z,0,0,0);p1=__builtin_amdgcn_mfma_f32_32x32x16_bf16(kx1,qe,z,0,0,0);}
    {p0=__builtin_amdgcn_mfma_f32_32x32x16_bf16(b0,qr[d0],p0,0,0,0);p1=__builtin_amdgcn_mfma_f32_32x32x16_bf16(b1,qr[d0],p1,0,0,0);}}
}
typedef __attribute__((address_space(3))) const char* lds_cptr;
typedef short v4i16_t __attribute__((ext_vector_type(4)));
__device__ __forceinline__ void kload8(bf16x8*kf,lds_cptr kp){
  kf[0]=*(const __attribute__((address_space(3))) bf16x8*)(kp);      kf[1]=*(const __attribute__((address_space(3))) bf16x8*)(kp+512);
  kf[2]=*(const __attribute__((address_space(3))) bf16x8*)(kp+2048); kf[3]=*(const __attribute__((address_space(3))) bf16x8*)(kp+2560);
  kf[4]=*(const __attribute__((address_space(3))) bf16x8*)(kp+4096); kf[5]=*(const __attribute__((address_space(3))) bf16x8*)(kp+4608);
  kf[6]=*(const __attribute__((address_space(3))) bf16x8*)(kp+6144); kf[7]=*(const __attribute__((address_space(3))) bf16x8*)(kp+6656);
}
__device__ __forceinline__ void kload2(bf16x8*kf,lds_cptr kp,int j){ kf[2*j]=*(const __attribute__((address_space(3))) bf16x8*)(kp+j*2048); kf[2*j+1]=*(const __attribute__((address_space(3))) bf16x8*)(kp+j*2048+512); }
__device__ __forceinline__ s16x4 vtr(lds_cptr p){ return __builtin_bit_cast(s16x4,__builtin_amdgcn_ds_read_tr16_b64_v4i16((__attribute__((address_space(3))) v4i16_t*)p)); }
__device__ __forceinline__ float rowmax(const f32x16&p0,const f32x16&p1){
  float a=max3f(p0[0],p0[1],p1[0]),b=max3f(p0[2],p0[3],p1[1]);a=max3f(a,p1[2],p1[3]);
  #pragma unroll
  for(int r=4;r<16;r+=4){a=max3f(a,p0[r],p0[r+1]);b=max3f(b,p0[r+2],p0[r+3]);a=max3f(a,p1[r],p1[r+1]);b=max3f(b,p1[r+2],p1[r+3]);}
  const float m=max2f(a,b);
  auto rr=__builtin_amdgcn_permlane32_swap(__float_as_uint(m),__float_as_uint(m),false,false);
  return max2f(__uint_as_float(rr[0]),__uint_as_float(rr[1]));
}
__device__ __forceinline__ void pv(f32x16*o,int vb,bf16x8 pa0,bf16x8 pa1,bf16x8 pa2,bf16x8 pa3){
  #pragma unroll
  for(int d0=0;d0<2;++d0){s16x4 lo[4],hi[4];
    #pragma unroll
    for(int ks=0;ks<4;++ks){
      asm volatile("ds_read_b64_tr_b16 %0,%1 offset:%c2":"=&v"(lo[ks]):"v"(vb),"i"(d0*4096+ks*1024):"memory");
      asm volatile("ds_read_b64_tr_b16 %0,%1 offset:%c2":"=&v"(hi[ks]):"v"(vb),"i"(d0*4096+ks*1024+512):"memory");}
    asm volatile("s_waitcnt lgkmcnt(0)":::"memory");SBAR();
    #define PK(k) (bf16x8){lo[k][0],lo[k][1],lo[k][2],lo[k][3],hi[k][0],hi[k][1],hi[k][2],hi[k][3]}
    o[d0]=__builtin_amdgcn_mfma_f32_32x32x16_bf16(pa0,PK(0),o[d0],0,0,0);
    o[d0]=__builtin_amdgcn_mfma_f32_32x32x16_bf16(pa1,PK(1),o[d0],0,0,0);
    o[d0]=__builtin_amdgcn_mfma_f32_32x32x16_bf16(pa2,PK(2),o[d0],0,0,0);
    o[d0]=__builtin_amdgcn_mfma_f32_32x32x16_bf16(pa3,PK(3),o[d0],0,0,0);
    #undef PK
  }
}

#ifndef ATTN_STORE16
#define ATTN_STORE16(p,v) (*(u32x4*)(p)=(v))
#endif
template<int MODE,int THRL> __device__ __forceinline__ void attn_unit(int b,int h,int qb,const bf16*Q,const bf16*K,const bf16*V,bf16*O,char*shm,const bf16*KX,const float*relb){
  int tid_=threadIdx.x; asm volatile("":"+v"(tid_));
  const int tid=tid_,lane=tid&63,r32=lane&31,hi=lane>>5; const int wid=__builtin_amdgcn_readfirstlane(tid>>6);
  const long rowbase=(long)b*SEQ; const int q0=qb*QB;
  const bf16*Qw=Q+(rowbase+q0+wid*QBLK)*DM+h*D;
  const int kc0=(MODE==1)?((4*qb-8)>0?(4*qb-8):0):0;
  const bf16*Kh=K+(rowbase+(long)kc0*KVBLK)*DM+h*D,*Vh=V+(rowbase+(long)kc0*KVBLK)*DM+h*D;
  const unsigned lds0=(unsigned)(uintptr_t)shm;
  float*wsf=(float*)(shm+LDS_WS)+wid*64;
  const unsigned kvo=(unsigned)(lane*DM+wid*8)*2u, vvo=(unsigned)((16*(wid&3)+(lane>>2))*DM+(wid>>2)*32+(lane&3)*8)*2u;
  const unsigned kdst=lds0+LDS_K+wid*1024, vdst=lds0+LDS_V+wid*1024;
  #define TILE(s_) ((MODE==0)?(NT-1-(s_)):(s_))
  #define DMA_K(t,slot) glds16s(Kh+(long)TILE(t)*KVBLK*DM,kvo,(unsigned)__builtin_amdgcn_readfirstlane(kdst+(slot)))
  #define DMA_V(t,slot) glds16s(Vh+(long)TILE(t)*KVBLK*DM,vvo,(unsigned)__builtin_amdgcn_readfirstlane(vdst+(slot)))
  const bf16*xsrc=KX+((long)(b*NHEAD+h)*2*SEQ+(long)(wid>>2)*SEQ+16*(wid&3))*8; const unsigned xvo=(unsigned)lane*4u; const unsigned xdst=lds0+LDS_X+wid*256;
  #define DMA_E(t,slot) do{ if(MODE==0) glds4s(xsrc+(long)TILE(t)*KVBLK*8,xvo,(unsigned)__builtin_amdgcn_readfirstlane(xdst+((slot)>>2))); }while(0)
  const lds_cptr xp0=(lds_cptr)shm+LDS_X+hi*1024+r32*16;
  #define XLD(sl) do{ if(MODE==0){ ke0=*(const __attribute__((address_space(3))) bf16x8*)(xp0+((sl)>>2)); ke1=*(const __attribute__((address_space(3))) bf16x8*)(xp0+((sl)>>2)+512); } }while(0)
  #define WAITB_A() do{ if(MODE==0){WAIT_BAR(3);}else{WAIT_BAR(2);} }while(0)
  const int vb0=(int)(lds0+LDS_V)+((lane>>4)&1)*32+(lane&3)*8+(4*hi+((lane&15)>>2))*64;
  const char*Kbase=shm+LDS_K; bf16x8 kf[8];
  const lds_cptr shm3=(lds_cptr)shm; const lds_cptr kp0=shm3+LDS_K+hi*1024+r32*16; const lds_cptr vp0=shm3+LDS_V+((lane>>4)&1)*32+(lane&3)*8+(4*hi+((lane&15)>>2))*64;
  const int NT=(q0+QB)/KVBLK-kc0;
  if(MODE==1){ float*bt=(float*)(shm+LDS_BT); if(tid<257) bt[tid]=(relb[tid]-relb[256])*1.4426950408889634f; }
  u32x4 qev=(u32x4){0x3F803F80u,0x3F80u,0u,0u};
  bf16x8 ke0,ke1; { const u32x4 kc_=(hi==0)?(u32x4){0u,0x3F800000u,0x3F803F80u,0u}:(u32x4){0u,0u,0u,0u}; ke0=__builtin_bit_cast(bf16x8,kc_); ke1=ke0; }
  #define QE() __builtin_bit_cast(bf16x8,qev)
  #define SETQE() do{ const float nm_=-mhat; const unsigned a_=cvtpk_s(nm_,0.f)&0xffffu; const float r1_=nm_-__uint_as_float(a_<<16); const unsigned b_=cvtpk_s(r1_,0.f)&0xffffu; \
    const float r2_=r1_-__uint_as_float(b_<<16); const unsigned c_=cvtpk_s(r2_,0.f)&0xffffu; qev[1]=0x3F80u|(a_<<16); qev[2]=b_|(c_<<16); }while(0)
  DMA_K(0,0);DMA_E(0,0);DMA_V(0,0);DMA_K(1,SLOTB);DMA_E(1,SLOTB);
  bf16x8 qr[4];
  #pragma unroll
  for(int d0=0;d0<4;++d0)qr[d0]=*reinterpret_cast<const bf16x8*>(&Qw[(long)r32*DM+d0*16+hi*8]);
  float mhat=0.f,l_reg=0.f;f32x16 o[2];o[0]=f32x16{};o[1]=f32x16{};
  const int qrel=wid*QBLK+r32;
  const int cw=4*qb+(wid>>1);
  #define BMASK(P0,P1,t) do{ const int kc_=kc0+(t); if(kc_>cw||kc_<cw-8){ _Pragma("unroll") for(int r=0;r<16;++r){P0[r]=-INFINITY;P1[r]=-INFINITY;} } \
    else if(kc_>=cw-2){ const float*bt_=(const float*)(shm+LDS_BT); const int dq_=64*(cw-kc_)+32*(wid&1)+r32-4*hi; \
      _Pragma("unroll") for(int r=0;r<16;++r){ const int d0_=dq_-((r&3)+8*(r>>2)), d1_=d0_-32; P0[r]+=bt_[(d0_<128?d0_:128)+128]; P1[r]+=bt_[(d1_<128?d1_:128)+128]; } } }while(0)
  #define CMASK(P0,P1,t) do{ if(MODE==1){BMASK(P0,P1,t);} else {int jb_=3-(t); if(jb_>=0)cmask(P0,P1,jb_,qrel,hi);} }while(0)
  bool resc=false;
  #define START(P0,P1) do{ float rm=rowmax(P0,P1); rm=max2f(rm,-64.f); resc=false;     \
    { const float dl=rm; mhat=fadd_s(mhat,dl); \
      _Pragma("unroll") for(int r=0;r<16;++r){P0[r]=fsub_s(P0[r],dl);P1[r]=fsub_s(P1[r],dl);} \
      SETQE(); } \
    _Pragma("unroll") for(int r=0;r<16;++r)P0[r]=__builtin_amdgcn_exp2f(P0[r]); }while(0)
  #define RESC() do{ if(resc){ asm volatile("s_waitcnt lgkmcnt(0)":::"memory"); \
      _Pragma("unroll") for(int d_=0;d_<2;++d_) _Pragma("unroll") for(int r=0;r<16;++r)o[d_][r]*=wsf[crow(r,hi)]; } }while(0)
  f32x16 pA0,pA1,pB0,pB1;
  int sl_prev=0,sl_cur=0,sl_next=SLOTB;
  #define ROT() do{sl_prev=sl_cur;sl_cur=sl_next;sl_next=(sl_next==(NSLOT-1)*SLOTB)?0:sl_next+SLOTB;}while(0)
  DMA_K(2,2*SLOTB);DMA_E(2,2*SLOTB);
  if(MODE==0){WAIT_BAR(5);}else{WAIT_BAR(3);}
  XLD(0);
  qkt(pA0,pA1,Kbase,qr,ke0,ke1,QE(),r32,hi);asm volatile("s_nop 15\n\ts_nop 7":"+v"(pA0),"+v"(pA1));CMASK(pA0,pA1,0);
  START(pA0,pA1);
  _Pragma("unroll") for(int r=0;r<16;++r)pA1[r]=__builtin_amdgcn_exp2f(pA1[r]);
  WAIT_BAR(0);
  DMA_K(3,0);DMA_E(3,0);DMA_V(1,SLOTB);
  ROT();
  kload8(kf,kp0+sl_cur); XLD(sl_cur);
  WAITB_A();
  s16x4 vlo[8],vhi[8]; u32x4 pw0,pw1,pw2,pw3;
  #define PKW(P,B) cvtpk_s(P[B],P[B+1])
  #define PAF(k) __builtin_bit_cast(bf16x8,pw##k)
  #define VFR(i) (bf16x8){vlo[i][0],vlo[i][1],vlo[i][2],vlo[i][3],vhi[i][0],vhi[i][1],vhi[i][2],vhi[i][3]}
  #define PIN(x) asm volatile("":"+v"(x))
  #define MX3(a,b,c) __builtin_fmaxf(__builtin_fmaxf((a),(b)),(c))
  #define GAPA(MF,A0,A1,A2,A3,W0,W1,PW) do{ MF; sacc+=A0; sacc+=A1; sacc+=A2; sacc+=A3; PIN(sacc); W0; W1; PIN(PW); SBAR(); }while(0)
  #define EX(v) __builtin_amdgcn_exp2f(v)
  #define GAPB(MF,X,B) do{ MF; X[B]=EX(X[B]); X[B+1]=EX(X[B+1]); X[B+2]=EX(X[B+2]); X[B+3]=EX(X[B+3]); PIN(X); SBAR(); }while(0)
  #define VRD(i) do{ vlo[i]=vtr(vp_+(((i)>>2)*4096+((i)&3)*1024)); vhi[i]=vtr(vp_+(((i)>>2)*4096+((i)&3)*1024+512)); }while(0)
  #define KRD(G,j) do{ if(G){ kload2(kf,kp0+sl_next,j); SBAR(); } }while(0)
  #define STEP(C0,C1,P0,P1,t,GK,GV,GL) do{ SBAR(); \
    const lds_cptr vp_=vp0+sl_prev; \
    { const f32x16 z_=f32x16{}; C0=__builtin_amdgcn_mfma_f32_32x32x16_bf16(ke0,QE(),z_,0,0,0); C1=__builtin_amdgcn_mfma_f32_32x32x16_bf16(ke1,QE(),z_,0,0,0); } SBAR(); \
    VRD(0); SBAR(); float sacc=(P0[0]+P0[1]); \
    GAPA(C0=__builtin_amdgcn_mfma_f32_32x32x16_bf16(kf[0],qr[0],C0,0,0,0), P0[2],P0[3],P0[4],P0[5],     pw0[0]=PKW(P0,0), pw0[1]=PKW(P0,2), pw0); \
    VRD(4); SBAR(); GAPA(C1=__builtin_amdgcn_mfma_f32_32x32x16_bf16(kf[1],qr[0],C1,0,0,0), P0[6],P0[7],P0[8],P0[9],     pw0[2]=PKW(P0,4), pw0[3]=PKW(P0,6), pw0); \
    VRD(1); SBAR(); GAPA(C0=__builtin_amdgcn_mfma_f32_32x32x16_bf16(kf[2],qr[1],C0,0,0,0),   P0[10],P0[11],P0[12],P0[13], pw1[0]=PKW(P0,8), pw1[1]=PKW(P0,10), pw1); \
    VRD(5); SBAR(); GAPA(C1=__builtin_amdgcn_mfma_f32_32x32x16_bf16(kf[3],qr[1],C1,0,0,0),   P0[14],P0[15],P1[0],P1[1],   pw1[2]=PKW(P0,12),pw1[3]=PKW(P0,14), pw1); \
    VRD(2); SBAR(); GAPA(C0=__builtin_amdgcn_mfma_f32_32x32x16_bf16(kf[4],qr[2],C0,0,0,0),   P1[2],P1[3],P1[4],P1[5],     pw2[0]=PKW(P1,0), pw2[1]=PKW(P1,2), pw2); \
    VRD(6); SBAR(); GAPA(C1=__builtin_amdgcn_mfma_f32_32x32x16_bf16(kf[5],qr[2],C1,0,0,0),   P1[6],P1[7],P1[8],P1[9],     pw2[2]=PKW(P1,4), pw2[3]=PKW(P1,6), pw2); \
    VRD(3); SBAR(); GAPA(C0=__builtin_amdgcn_mfma_f32_32x32x16_bf16(kf[6],qr[3],C0,0,0,0),   P1[10],P1[11],P1[12],P1[13], pw3[0]=PKW(P1,8), pw3[1]=PKW(P1,10), pw3); \
    VRD(7); SBAR(); GAPA(C1=__builtin_amdgcn_mfma_f32_32x32x16_bf16(kf[7],qr[3],C1,0,0,0),   P1[14],P1[15],0.f,0.f,       pw3[2]=PKW(P1,12),pw3[3]=PKW(P1,14), pw3); \
    l_reg+=sacc; \
    if(GK){DMA_K((t)+3,sl_cur);DMA_E((t)+3,sl_cur);} if(GV){DMA_V((t)+1,sl_next);} \
    CMASK(C0,C1,t); \
    { float a=MX3(C0[0],C0[1],C1[0]),b=MX3(C0[2],C0[3],C1[1]); a=MX3(a,C1[2],C1[3]); \
      _Pragma("unroll") for(int r=4;r<16;r+=4){a=MX3(a,C0[r],C0[r+1]);b=MX3(b,C0[r+2],C0[r+3]);a=MX3(a,C1[r],C1[r+1]);b=MX3(b,C1[r+2],C1[r+3]);} \
      float rm=__builtin_fmaxf(a,b); { auto rr=__builtin_amdgcn_permlane32_swap(__float_as_uint(rm),__float_as_uint(rm),false,false); rm=__builtin_fmaxf(__uint_as_float(rr[0]),__uint_as_float(rr[1])); } \
      resc=false; \
      if(__builtin_expect(__any(rm>(float)THRL),0)){ const float dl=__builtin_fmaxf(rm,0.f); mhat+=dl; \
        _Pragma("unroll") for(int r=0;r<16;++r){C0[r]-=dl;C1[r]-=dl;} \
        SETQE(); \
        const float f=__builtin_amdgcn_exp2f(-dl); l_reg*=f; if(hi==0)wsf[r32]=f; resc=true; } } \
    SBAR(); \
    GAPB(o[0]=__builtin_amdgcn_mfma_f32_32x32x16_bf16(PAF(0),VFR(0),o[0],0,0,0), C0,0); \
    GAPB(o[1]=__builtin_amdgcn_mfma_f32_32x32x16_bf16(PAF(0),VFR(4),o[1],0,0,0), C0,4); \
    KRD(GL,0); GAPB(o[0]=__builtin_amdgcn_mfma_f32_32x32x16_bf16(PAF(1),VFR(1),o[0],0,0,0), C0,8); \
    KRD(GL,1); GAPB(o[1]=__builtin_amdgcn_mfma_f32_32x32x16_bf16(PAF(1),VFR(5),o[1],0,0,0), C0,12); \
    KRD(GL,2); GAPB(o[0]=__builtin_amdgcn_mfma_f32_32x32x16_bf16(PAF(2),VFR(2),o[0],0,0,0), C1,0); \
    KRD(GL,3); GAPB(o[1]=__builtin_amdgcn_mfma_f32_32x32x16_bf16(PAF(2),VFR(6),o[1],0,0,0), C1,4); \
    if(GL){ XLD(sl_next); SBAR(); } GAPB(o[0]=__builtin_amdgcn_mfma_f32_32x32x16_bf16(PAF(3),VFR(3),o[0],0,0,0), C1,8); \
    GAPB(o[1]=__builtin_amdgcn_mfma_f32_32x32x16_bf16(PAF(3),VFR(7),o[1],0,0,0), C1,12); \
    }while(0)
  int t=1;
  if(MODE==0) for(;t+5<NT;t+=2){
    STEP(pB0,pB1,pA0,pA1,t,true,true,true);     WAIT_BAR(3); RESC(); ROT();
    STEP(pA0,pA1,pB0,pB1,t+1,true,true,true);   WAIT_BAR(3); RESC(); ROT();
  }
  #define ENDW(tt) do{ if((tt)+3<NT){WAITB_A();} else if((tt)+2<NT){WAIT_BAR(1);} else {WAIT_BAR(0);} }while(0)
  for(;t+1<NT;t+=2){
    STEP(pB0,pB1,pA0,pA1,t,(t+3<NT),(t+1<NT),(t+1<NT));       ENDW(t);   RESC(); ROT();
    STEP(pA0,pA1,pB0,pB1,t+1,(t+4<NT),(t+2<NT),(t+2<NT));     ENDW(t+1); RESC(); ROT();
  }
  STEP(pB0,pB1,pA0,pA1,NT-1,false,false,false); RESC();
  { float sacc=pB0[0]+pB0[1]; _Pragma("unroll") for(int r=2;r<16;++r)sacc+=pB0[r]; _Pragma("unroll") for(int r=0;r<16;++r)sacc+=pB1[r]; l_reg+=sacc;
    pw0=(u32x4){PKW(pB0,0),PKW(pB0,2),PKW(pB0,4),PKW(pB0,6)};pw1=(u32x4){PKW(pB0,8),PKW(pB0,10),PKW(pB0,12),PKW(pB0,14)};pw2=(u32x4){PKW(pB1,0),PKW(pB1,2),PKW(pB1,4),PKW(pB1,6)};pw3=(u32x4){PKW(pB1,8),PKW(pB1,10),PKW(pB1,12),PKW(pB1,14)};
    SBAR(); pv(o,vb0+sl_cur,PAF(0),PAF(1),PAF(2),PAF(3)); }
  #undef PKW
  #undef PAF
  #undef VFR
  #undef PIN
  #undef MX3
  #undef GAPA
  #undef GAPB
  #undef EX
  #undef VRD
  #undef KRD
  #undef STEP
  #undef ENDW
  {auto rr=__builtin_amdgcn_permlane32_swap(__float_as_uint(l_reg),__float_as_uint(l_reg),false,false);l_reg=__uint_as_float(rr[0])+__uint_as_float(rr[1]);}
  if(hi==0)wsf[32+r32]=l_reg;asm volatile("s_waitcnt lgkmcnt(0)":::"memory");
  float rli[16];
  #pragma unroll
  for(int r=0;r<16;++r)rli[r]=__builtin_amdgcn_rcpf(wsf[32+crow(r,hi)]);
  bf16*Ow=O+(rowbase+q0+wid*QBLK)*DM+h*D;
  { bf16*stg=(bf16*)(shm+LDS_OST)+wid*2048;
    #pragma unroll
    for(int r=0;r<16;++r){const int orow=crow(r,hi);
      #pragma unroll
      for(int d0=0;d0<2;++d0)stg[orow*64+d0*32+r32]=__float2bfloat16(o[d0][r]*rli[r]);}
    asm volatile("s_waitcnt lgkmcnt(0)":::"memory");
    #pragma unroll
    for(int i=0;i<4;++i){const int row=i*8+(lane>>3),ch=lane&7; const u32x4 v=*(const u32x4*)(stg+row*64+ch*8); ATTN_STORE16(Ow+(long)row*DM+ch*8,v);} }
  asm volatile("s_waitcnt lgkmcnt(0)\n\ts_barrier":::"memory");
  #undef DMA_K
  #undef TILE
  #undef DMA_V
  #undef DMA_E
  #undef XLD
  #undef WAITB_A
  #undef QE
  #undef SETQE
  #undef BMASK
  #undef CMASK
  #undef START
  #undef RESC
  #undef ROT
}
constexpr int ATTN_LDS_BYTES=LDS_BYTES;
struct AttnTensors { const bf16* Q; const bf16* K; const bf16* V; bf16* O; const bf16* KX; const float* relb; };
struct AttnUnit { int bh; int qb; };
struct StaticOrder {
  int vcu;
  __device__ __forceinline__ explicit StaticOrder(int grid,int block):vcu((block%8)*(grid/8)+block/8){}
  __device__ __forceinline__ bool next(int i,AttnUnit&u)const{ if(i>=4)return false; const int s=vcu&7; u.bh=vcu>>3; u.qb=(i==0)?s:(i==1)?15-s:(i==2)?16+s:31-s; return true; }
  __device__ __forceinline__ bool next_band(int i,AttnUnit&u)const{ if(i>=4)return false; u.bh=vcu>>3; u.qb=(vcu&7)+8*i; return true; }
  __device__ __forceinline__ void a_ready(const AttnUnit&)const{}
  __device__ __forceinline__ void done(const AttnUnit&)const{}
};
template<int MODE,class Sched,int THRL=8> __device__ __forceinline__ void attn_phase(char*lds,const AttnTensors&T,const Sched&S){
  AttnUnit u;
  for(int i=0;(MODE==0?S.next(i,u):S.next_band(i,u));++i){ attn_unit<MODE,THRL>(u.bh/NHEAD,u.bh%NHEAD,u.qb,T.Q,T.K,T.V,T.O,lds,T.KX,T.relb+(MODE==1?(u.bh%NHEAD)*257:0)); }
}
#undef SBAR
#undef WAIT_BAR
}
namespace cg = cooperative_groups;
constexpr int NWAVES = 8;
#ifndef MK_PER_PHASE
#define MK_PER_PHASE 0
#endif
constexpr int N_PHASES = 12;
constexpr int MP = 16384, MS = 512, MT = MP + MS, DMODEL = 1024, DFF = 2816, NH = 16, SEQL = 8192;
constexpr int PAST = 1024, BPAST = 512, DECB = 32, DECT = 16;
constexpr size_t O_YP = 0, O_YS = 16777216, O_AKP = 17301504, O_AVP = 34078720, O_ALFP = 50855936, O_BKP = 51118080, O_BVP = 52166656,
                 O_AKS = 53215232, O_AVS = 53739520, O_ALFS = 54263808, O_BKS = 54272000, O_BVS = 71049216, O_END = 87826432;
constexpr size_t MiB = 1u << 20;
constexpr size_t WS_WQKV0 = 2 * MiB, WS_WO0 = 8 * MiB, WS_WGU0 = 10 * MiB, WS_WD0 = 21 * MiB, WS_WKVQ = 27 * MiB, WS_WO1 = 33 * MiB, WS_WGU1 = 35 * MiB, WS_WD1 = 46 * MiB;
constexpr size_t WS_SSP = 52 * MiB, SSP_STRIDE = 2 * MiB;
constexpr size_t WS_GS = 62 * MiB;
constexpr size_t WS_KX = 64 * MiB;
constexpr size_t WS_QO = 72 * MiB, WS_KB = 105 * MiB, WS_VB = 138 * MiB, WS_HB = 171 * MiB, WS_ACT = 204 * MiB, WS_END = 296 * MiB;
static_assert(WS_ACT + (size_t)MT * DFF * 2 <= WS_END && WS_QO + (size_t)MT * DMODEL * 2 <= WS_KB, "d_ws map");
constexpr int RING_BYTES = 131072, LDS_BYTES = 147456;
static_assert(attn_body::ATTN_LDS_BYTES <= RING_BYTES, "attention LDS");

#define GAS __attribute__((address_space(1)))
#define LAS __attribute__((address_space(3)))
typedef unsigned short bf16;
typedef unsigned v4u __attribute__((ext_vector_type(4)));
typedef float f32x4 __attribute__((ext_vector_type(4)));
typedef short bf16x8 __attribute__((ext_vector_type(8)));
#define LDS_WAIT() asm volatile("s_waitcnt lgkmcnt(0)" ::: "memory")
__device__ __forceinline__ unsigned f2bf(float f) { unsigned u = __builtin_bit_cast(unsigned, f); return (u + 0x7fffu + ((u >> 16) & 1u)) >> 16; }
__device__ __forceinline__ unsigned pk2(float lo, float hi) { return f2bf(lo) | (f2bf(hi) << 16); }
__device__ __forceinline__ float bf2f(unsigned short b) { return __uint_as_float((unsigned)b << 16); }

__device__ __forceinline__ void p0_transpose_item(const float* W, int ldw, int csrc, int k0, const float* gain, bf16* WT, int K, int drow, LAS float* scr, int lane) {
    float wv[32]; const float gl = gain ? gain[k0 + lane] : 1.f;
#pragma unroll
    for (int i = 0; i < 32; ++i) wv[i] = W[(size_t)(k0 + 2 * i + (lane >> 5)) * ldw + csrc + (lane & 31)];
#pragma unroll
    for (int i = 0; i < 32; ++i) { const int kk = 2 * i + (lane >> 5); scr[kk * 33 + (lane & 31)] = wv[i] * __shfl(gl, kk); }
    LDS_WAIT(); asm volatile("" ::: "memory");
    const int c = lane & 7;
#pragma unroll
    for (int j = 0; j < 4; ++j) { const int n = (lane >> 3) + 8 * j; const LAS float* s = scr + (8 * c) * 33 + n;
        v4u o; o.x = pk2(s[0 * 33], s[1 * 33]); o.y = pk2(s[2 * 33], s[3 * 33]); o.z = pk2(s[4 * 33], s[5 * 33]); o.w = pk2(s[6 * 33], s[7 * 33]);
        *(v4u*)(WT + (size_t)(drow + n) * K + k0 + 8 * c) = o; }
    LDS_WAIT(); asm volatile("" ::: "memory");
}
struct KArgs { const float* in[20]; float* out; unsigned char* ws; int ph_lo, ph_hi; };

__device__ __forceinline__ void p0_weight_item(const KArgs& a, int it, LAS float* scr, int lane) {
    unsigned char* ws = a.ws;
    constexpr int I_QKV = 16 * 96, I_O = 16 * 32, I_GU = 16 * 176, I_D = 44 * 32, I_Q1 = 16 * 32, I_KV = 16 * 64;
    const float* W; int ldw, ncols, K, roff = 0; const float* gain = nullptr; bf16* dst; bool perm = false;
    int r = it;
    if (r < I_QKV) { W = a.in[8]; ldw = 3088; ncols = 3072; K = 1024; gain = a.in[7]; dst = (bf16*)(ws + WS_WQKV0); }
    else if ((r -= I_QKV) < I_O) { W = a.in[10]; ldw = 1024; ncols = 1024; K = 1024; dst = (bf16*)(ws + WS_WO0); }
    else if ((r -= I_O) < I_GU) { W = a.in[17]; ldw = 5632; ncols = 5632; K = 1024; gain = a.in[16]; dst = (bf16*)(ws + WS_WGU0); perm = true; }
    else if ((r -= I_GU) < I_D) { W = a.in[18]; ldw = 1024; ncols = 1024; K = 2816; dst = (bf16*)(ws + WS_WD0); }
    else if ((r -= I_D) < I_Q1) { W = a.in[11]; ldw = 1024; ncols = 1024; K = 1024; gain = a.in[7] + 1024; dst = (bf16*)(ws + WS_WKVQ); }
    else if ((r -= I_Q1) < I_KV) { W = a.in[15]; ldw = 2048; ncols = 2048; K = 1024; gain = a.in[14]; dst = (bf16*)(ws + WS_WKVQ); roff = 1024; }
    else if ((r -= I_KV) < I_O) { W = a.in[13]; ldw = 1024; ncols = 1024; K = 1024; dst = (bf16*)(ws + WS_WO1); }
    else if ((r -= I_O) < I_GU) { W = a.in[17] + (size_t)1024 * 5632; ldw = 5632; ncols = 5632; K = 1024; gain = a.in[16] + 1024; dst = (bf16*)(ws + WS_WGU1); perm = true; }
    else { r -= I_GU; W = a.in[18] + (size_t)2816 * 1024; ldw = 1024; ncols = 1024; K = 2816; dst = (bf16*)(ws + WS_WD1); }
    const int nblk = ncols / 32, kb = r / nblk, nb = r % nblk, n0 = 32 * nb;
    int drow = roff + n0;
    if (perm) { drow = n0 < 2816 ? 256 * (n0 / 128) + (n0 % 128) : 256 * ((n0 - 2816) / 128) + 128 + ((n0 - 2816) % 128); }
    p0_transpose_item(W, ldw, n0, 64 * kb, gain, dst, K, drow, scr, lane);
}
constexpr int P0_FIRST = 16 * 96, P0_SECOND = P0_FIRST + 16 * 32 + 16 * 176 + 44 * 32 + 16 * 32 + 16 * 64;
constexpr int P0_NITEMS = 16 * 96 + 16 * 32 + 16 * 176 + 44 * 32 + 16 * 32 + 16 * 64 + 16 * 32 + 16 * 176 + 44 * 32;

__device__ __forceinline__ void p0_row_group(const KArgs& a, int g, const LAS unsigned char* wf, int lane) {
    const int fr = lane & 15, fq = lane >> 4;
    const int row = g * 16 + fr;
    const float* xr = (g < 1024 ? a.in[0] + (size_t)row * 1024 : a.in[1] + (size_t)(row - MP) * 1024) + 8 * fq;
    bf16* hb = (bf16*)(a.ws + WS_HB) + (size_t)row * 1024 + 8 * fq;
    f32x4 acc = {0.f, 0.f, 0.f, 0.f}; float ss = 0.f;
#pragma unroll 4
    for (int ks = 0; ks < 32; ++ks) {
        const f32x4 x0 = *(const f32x4*)(xr + 32 * ks), x1 = *(const f32x4*)(xr + 32 * ks + 4);
        ss += (x0[0] * x0[0] + x0[1] * x0[1]) + (x0[2] * x0[2] + x0[3] * x0[3]) + (x1[0] * x1[0] + x1[1] * x1[1]) + (x1[2] * x1[2] + x1[3] * x1[3]);
        v4u w; w.x = pk2(x0[0], x0[1]); w.y = pk2(x0[2], x0[3]); w.z = pk2(x1[0], x1[1]); w.w = pk2(x1[2], x1[3]);
        *(v4u*)(hb + 32 * ks) = w;
        const bf16x8 bfrag = *(const LAS bf16x8*)(wf + (ks * 64 + lane) * 16);
        acc = __builtin_amdgcn_mfma_f32_16x16x32_bf16(bfrag, __builtin_bit_cast(bf16x8, w), acc, 0, 0, 0);
    }
    ss += __shfl_xor(ss, 16); ss += __shfl_xor(ss, 32);
    float* ssp = (float*)(a.ws + WS_SSP) + (size_t)row * 16 + 4 * fq;
    *(f32x4*)ssp = (f32x4){fq == 0 ? ss : 0.f, 0.f, 0.f, 0.f};
    const float rstd = 1.0f / sqrtf(ss * (1.0f / 1024.0f) + 1e-6f);
    const f32x4 bf = *(const f32x4*)(a.in[9] + 4 * fq);
    f32x4 lf;
#pragma unroll
    for (int e = 0; e < 4; ++e) { const float z = acc[e] * rstd + bf[e]; lf[e] = fminf(z, 0.f) - log1pf(expf(-fabsf(z))); }
    float* lo = (g < 1024 ? a.out + O_ALFP + (size_t)row * 16 : a.out + O_ALFS + (size_t)(row - MP) * 16) + 4 * fq;
    *(f32x4*)lo = lf;
    if (g < 1024) {
#pragma unroll
        for (int o = 1; o < 16; o <<= 1) { lf[0] += __shfl_xor(lf[0], o); lf[1] += __shfl_xor(lf[1], o); lf[2] += __shfl_xor(lf[2], o); lf[3] += __shfl_xor(lf[3], o); }
        if (fr == 0) *(f32x4*)((float*)(a.ws + WS_GS) + g * 16 + 4 * fq) = lf;
    }
}

__device__ __forceinline__ void p1_scan(const KArgs& a, int v, LAS float* red, int tid) {
    const int batch = v >> 7, g0 = batch * 512, g1 = 4 * v, h = tid & 15, part = tid >> 4;
    const float* gs = (const float*)(a.ws + WS_GS);
    float s = 0.f;
    for (int g = g0 + part; g < g1; g += 32) s += gs[g * 16 + h];
    red[part * 16 + h] = s;
    __syncthreads();
    LAS float* lfs = red + 512;
    for (int e = tid; e < 1024; e += 512) lfs[e] = a.out[O_ALFP + (size_t)(64 * v) * 16 + e];
    __syncthreads();
    if (tid < 16) {
        float cum = 0.f;
        for (int p = 0; p < 32; ++p) cum += red[p * 16 + tid];
        bf16* kx = (bf16*)(a.ws + WS_KX) + ((size_t)(batch * 16 + tid) * 2 * SEQL) * 8;
        const int t0 = (64 * v) & (SEQL - 1);
#pragma unroll 8
        for (int r = 0; r < 64; ++r) {
            cum += lfs[r * 16 + tid];
            const float c = -cum * 1.4426950408889634f;
            const unsigned c1 = f2bf(c); const float r1 = c - bf2f((unsigned short)c1);
            const unsigned c2 = f2bf(r1); const float r2 = r1 - bf2f((unsigned short)c2);
            const unsigned c3 = f2bf(r2);
            *(v4u*)(kx + (size_t)(t0 + r) * 8) = (v4u){c1 | (c2 << 16), c3 | 0x3F800000u, 0x3F803F80u, 0u};
            *(v4u*)(kx + (size_t)(SEQL + t0 + r) * 8) = (v4u){0u, 0u, 0u, 0u};
        }
    }
    __syncthreads();
}

typedef float sf32x4 __attribute__((ext_vector_type(4)));
__device__ __forceinline__ bf16x8 pack8(const sf32x4 a, const sf32x4 b) {
    v4u w; w.x = attn_body::cvtpk_s(a[0], a[1]); w.y = attn_body::cvtpk_s(a[2], a[3]); w.z = attn_body::cvtpk_s(b[0], b[1]); w.w = attn_body::cvtpk_s(b[2], b[3]); return __builtin_bit_cast(bf16x8, w); }
template <int MODE> __device__ __forceinline__ void sample_attn(const KArgs& a, int b, int h, LAS unsigned char* lds, int tid) {
    constexpr int NC = MODE == 0 ? PAST : BPAST, NK = NC + 16, NKP = 1056, VRS = 80;
    constexpr float L2E = 1.4426950408889634f;
    LAS float* S = (LAS float*)lds;
    LAS float* bias = S + 16 * NKP;
    LAS float* rl = bias + NKP;
    LAS unsigned char* VT = (LAS unsigned char*)(rl + 16);
    const int lane = tid & 63, wid = __builtin_amdgcn_readfirstlane(tid >> 6), fr = lane & 15, fq = lane >> 4;
    const float* ck = a.in[MODE == 0 ? 2 : 5]; const float* cv = a.in[MODE == 0 ? 3 : 6];
    const float* nk = a.out + (MODE == 0 ? O_AKS + (size_t)(b * 16) * 1024 : O_BKS + (size_t)(b * 512 + 496) * 1024) + h * 64;
    const float* nv = a.out + (MODE == 0 ? O_AVS + (size_t)(b * 16) * 1024 : O_BVS + (size_t)(b * 512 + 496) * 1024) + h * 64;
    const bf16* qo = (const bf16*)(a.ws + WS_QO) + (size_t)(MP + b * 16) * 1024 + h * 64;
    const bf16x8 qf0 = *(const bf16x8*)(qo + (size_t)fr * 1024 + 8 * fq), qf1 = *(const bf16x8*)(qo + (size_t)fr * 1024 + 32 + 8 * fq);
    if (MODE == 0) {
        for (int j = tid; j < NK; j += 512) bias[j] = j < NC ? a.in[4][((size_t)b * NC + j) * 16 + h] : a.out[O_ALFS + (size_t)(b * 16 + (j - NC)) * 16 + h];
    } else {
        if (tid < 257) bias[tid] = a.in[12][h * 257 + tid] * L2E;
    }
    __syncthreads();
    if (MODE == 0) {
        if (wid == 0) { float carry = 0.f;
            for (int c = 0; c < (NK + 63) / 64; ++c) { const int j = 64 * c + lane; float v = j < NK ? bias[j] : 0.f;
#pragma unroll
                for (int o = 1; o < 64; o <<= 1) { const float t = __shfl_up(v, o); if (lane >= o) v += t; }
                v += carry; carry = __shfl(v, 63); if (j < NK) bias[j] = -v * L2E; } }
        __syncthreads();
    }
#pragma unroll 2
    for (int blk = wid; blk < NK / 16; blk += 8) {
        const int j0 = 16 * blk; const bool isnew = j0 >= NC;
        const float* kr = (isnew ? nk + (size_t)(j0 - NC + fr) * 1024 : ck + (((size_t)b * NC + j0 + fr) * 16 + h) * 64) + 8 * fq;
        const sf32x4 x0 = *(const sf32x4*)kr, x1 = *(const sf32x4*)(kr + 4), x2 = *(const sf32x4*)(kr + 32), x3 = *(const sf32x4*)(kr + 36);
        if (MODE == 1 && !isnew && j0 >= 16) { float* ok = a.out + O_BKS + (((size_t)b * 512 + (j0 + fr - 16)) * 16 + h) * 64 + 8 * fq;
            *(sf32x4*)ok = x0; *(sf32x4*)(ok + 4) = x1; *(sf32x4*)(ok + 32) = x2; *(sf32x4*)(ok + 36) = x3; }
        sf32x4 acc = {0.f, 0.f, 0.f, 0.f};
        acc = __builtin_amdgcn_mfma_f32_16x16x32_bf16(pack8(x0, x1), qf0, acc, 0, 0, 0);
        acc = __builtin_amdgcn_mfma_f32_16x16x32_bf16(pack8(x2, x3), qf1, acc, 0, 0, 0);
        if (MODE == 0) { const sf32x4 bv = *(const LAS sf32x4*)(bias + j0 + 4 * fq); acc = acc + bv;
            if (isnew) {
#pragma unroll
                for (int e = 0; e < 4; ++e) if (4 * fq + e > fr) acc[e] = -INFINITY; } }
        else {
#pragma unroll
            for (int e = 0; e < 4; ++e) { const int d = 512 + fr - (j0 + 4 * fq + e); acc[e] += bias[(d < 128 ? d : 128) + 128]; } }
        *(LAS sf32x4*)(S + fr * NKP + j0 + 4 * fq) = acc;
    }
    __syncthreads();
    for (int q = 2 * wid; q < 2 * wid + 2; ++q) { float m = -INFINITY;
        for (int j = lane; j < NK; j += 64) m = fmaxf(m, S[q * NKP + j]);
#pragma unroll
        for (int o = 1; o < 64; o <<= 1) m = fmaxf(m, __shfl_xor(m, o));
        float l = 0.f;
        for (int j = lane; j < NK; j += 64) { const float p = __builtin_amdgcn_exp2f(S[q * NKP + j] - m); S[q * NKP + j] = p; l += p; }
#pragma unroll
        for (int o = 1; o < 64; o <<= 1) l += __shfl_xor(l, o);
        if (lane == 0) rl[q] = 1.0f / l; }
    __syncthreads();
    { LAS unsigned char* vt = VT + wid * (64 * VRS);
        sf32x4 o[4];
#pragma unroll
        for (int db = 0; db < 4; ++db) o[db] = (sf32x4){0.f, 0.f, 0.f, 0.f};
        const int kr = lane >> 4, d4 = lane & 15;
        const int nit = NC / 256 + (wid == 7 ? 1 : 0);
        for (int it = 0; it < nit; ++it) {
            const bool isnew = it == NC / 256; const int c = isnew ? NC / 32 : wid + 8 * it;
            const int j0 = 32 * c; sf32x4 v4[8];
#pragma unroll
            for (int i = 0; i < 8; ++i) { const int key = 8 * (i >> 1) + 2 * kr + (i & 1);
                if (isnew) v4[i] = key < 16 ? *(const sf32x4*)(nv + (size_t)key * 1024 + 4 * d4) : (sf32x4){0.f, 0.f, 0.f, 0.f};
                else v4[i] = *(const sf32x4*)(cv + (((size_t)b * NC + j0 + key) * 16 + h) * 64 + 4 * d4); }
            if (MODE == 1 && !isnew) {
#pragma unroll
                for (int i = 0; i < 8; ++i) { const int j = j0 + 8 * (i >> 1) + 2 * kr + (i & 1); if (j >= 16) *(sf32x4*)(a.out + O_BVS + (((size_t)b * 512 + (j - 16)) * 16 + h) * 64 + 4 * d4) = v4[i]; } }
#pragma unroll
            for (int i = 0; i < 8; i += 2)
#pragma unroll
                for (int e = 0; e < 4; ++e) *(LAS unsigned*)(vt + (4 * d4 + e) * VRS + (8 * (i >> 1) + 2 * kr) * 2) = attn_body::cvtpk_s(v4[i][e], v4[i + 1][e]);
            bf16x8 pf;
            if (isnew && fq >= 2) pf = (bf16x8){0, 0, 0, 0, 0, 0, 0, 0};
            else { const sf32x4 p0 = *(const LAS sf32x4*)(S + fr * NKP + j0 + 8 * fq), p1 = *(const LAS sf32x4*)(S + fr * NKP + j0 + 8 * fq + 4); pf = pack8(p0, p1); }
#pragma unroll
            for (int db = 0; db < 4; ++db) { const bf16x8 vf = *(const LAS bf16x8*)(vt + (16 * db + fr) * VRS + fq * 16);
                o[db] = __builtin_amdgcn_mfma_f32_16x16x32_bf16(pf, vf, o[db], 0, 0, 0); }
        }
        LAS float* op = (LAS float*)vt;
#pragma unroll
        for (int db = 0; db < 4; ++db)
#pragma unroll
            for (int e = 0; e < 4; ++e) op[(4 * fq + e) * 64 + 16 * db + fr] = o[db][e]; }
    __syncthreads();
    for (int e = tid; e < 1024; e += 512) { const int q = e >> 6, d = e & 63; float o = 0.f;
#pragma unroll
        for (int w = 0; w < 8; ++w) o += ((const LAS float*)(VT + w * (64 * VRS)))[q * 64 + d];
        ((bf16*)(a.ws + WS_QO))[(size_t)(MP + b * 16 + q) * 1024 + h * 64 + d] = (bf16)f2bf(o * rl[q]); }
    __syncthreads();
}

#define RLX_AGENT __ATOMIC_RELAXED, __HIP_MEMORY_SCOPE_AGENT
#define XB_TMO      128
#define XB_XCNT(j)  (256  + 64 * (j))
#define XB_XSUB(j)  (1280 + 64 * (j))
#define XB_XGEN(j)  (2304 + 64 * (j))
#define XB_TOP      3328
#define XB_TOPGEN   3392
#define XCD_BAR_WORDS 3456
#define XB_SPIN_CAP (1u << 18)

__device__ __forceinline__ unsigned xb_ld(unsigned* p)              { return __hip_atomic_load(p, __ATOMIC_RELAXED, __HIP_MEMORY_SCOPE_AGENT); }
__device__ __forceinline__ unsigned xb_add(unsigned* p, unsigned v) { return __hip_atomic_fetch_add(p, v, __ATOMIC_RELAXED, __HIP_MEMORY_SCOPE_AGENT); }
__device__ __forceinline__ unsigned xb_xcc_id() { return (unsigned)__builtin_amdgcn_s_getreg((3 << 11) | 20) & 0xFu; }
#define XB_SPIN(cond, bar) do { unsigned _sp = 0; while (cond) { __builtin_amdgcn_s_sleep(1); \
    if ((++_sp & 255u) == 0u) { if (xb_ld(&(bar)[XB_TMO])) break; if (_sp > XB_SPIN_CAP) { atomicAdd(&(bar)[XB_TMO], 1u); break; } } } } while (0)

struct XcdBarrier {
    unsigned* bar; unsigned x;
    volatile LAS unsigned* st;
};

__device__ __forceinline__ XcdBarrier xcd_barrier_post(unsigned* bar, volatile LAS unsigned* st) {
    XcdBarrier b; b.bar = bar; b.x = xb_xcc_id(); b.st = st;
    if (threadIdx.x == 0) (void)xb_add(&bar[XB_XCNT(b.x)], 1u);
    return b;
}
__device__ __forceinline__ void xcd_barrier_complete(unsigned* bar, unsigned x, unsigned& nloc, unsigned& nx) {
    const unsigned G = gridDim.x * gridDim.y * gridDim.z;
    unsigned sum, cnt, mine, sp = 0u;
    for (;;) {
        sum = 0u; cnt = 0u; mine = 0u;
#pragma unroll
        for (unsigned j = 0; j < 16; ++j) { const unsigned c = xb_ld(&bar[XB_XCNT(j)]); sum += c; cnt += (c > 0u) ? 1u : 0u; mine = (j == x) ? c : mine; }
        if (sum == G) break;
        __builtin_amdgcn_s_sleep(1);
        if ((++sp & 255u) == 0u) { if (xb_ld(&bar[XB_TMO])) break; if (sp > XB_SPIN_CAP) { atomicAdd(&bar[XB_TMO], 1u); break; } }
    }
    nloc = mine > 0u ? mine : 1u; nx = cnt > 0u ? cnt : 1u;
}

__device__ __forceinline__ void xcd_barrier(const XcdBarrier& b) {
    asm volatile("s_waitcnt vmcnt(0)" ::: "memory");
    __syncthreads();
    if (threadIdx.x == 0) {
        unsigned* bar = b.bar;
        __builtin_amdgcn_s_waitcnt(0);
        unsigned nloc = b.st[0], nx = b.st[1];
        if (nloc == 0u) { xcd_barrier_complete(bar, b.x, nloc, nx); b.st[0] = nloc; b.st[1] = nx; }
        const unsigned old = xb_add(&bar[XB_XSUB(b.x)], 1u);
        const unsigned gen = old / nloc;
        if (old + 1u == (gen + 1u) * nloc) {
            __builtin_amdgcn_fence(__ATOMIC_RELEASE, "agent");
            asm volatile("s_waitcnt vmcnt(0)" ::: "memory");
            const unsigned og = xb_add(&bar[XB_TOP], 1u);
            const unsigned tg = og / nx;
            if (og + 1u == (tg + 1u) * nx) xb_add(&bar[XB_TOPGEN], 1u);
            else XB_SPIN(xb_ld(&bar[XB_TOPGEN]) == tg, bar);
            __builtin_amdgcn_fence(__ATOMIC_ACQUIRE, "agent");
            xb_add(&bar[XB_XGEN(b.x)], 1u);
            asm volatile("s_waitcnt vmcnt(0)" ::: "memory");
        } else {
            XB_SPIN(xb_ld(&bar[XB_XGEN(b.x)]) == gen, bar);
            __builtin_amdgcn_fence(__ATOMIC_ACQUIRE, "agent");
            asm volatile("s_waitcnt vmcnt(0)" ::: "memory");
        }
    }
    __syncthreads();
}

__device__ __forceinline__ KArgs load_args() {
#if !defined(__HIP_DEVICE_COMPILE__)
    return KArgs{};
#else
    auto p = __builtin_amdgcn_kernarg_segment_ptr(); asm volatile("" : "+s"(p)); return *(const __attribute__((address_space(4))) KArgs*)p;
#endif
}
__global__ void __launch_bounds__(NWAVES * 64, 2) fwd_mega(KArgs args_unused) {
    extern __shared__ __attribute__((aligned(16))) unsigned char lds[];
    LAS unsigned char* L = (LAS unsigned char*)lds;
    const int G = gridDim.x, bx = blockIdx.x, vcu = (G % 8 == 0) ? (bx % 8) * (G / 8) + bx / 8 : bx;
    int lo, hi; XcdBarrier xbar;
    { const KArgs a0 = load_args(); lo = a0.ph_lo; hi = a0.ph_hi;
      volatile LAS unsigned* st = (volatile LAS unsigned*)(L + RING_BYTES + 1024); if (threadIdx.x < 32) st[threadIdx.x] = 0u; __syncthreads();
      xbar = xcd_barrier_post((unsigned*)a0.ws + 4096, st); }
    if (hi > N_PHASES) cg::this_grid().sync();
#ifndef PHMASK
#define PHMASK 0xfff
#endif
#define IN(k) (((PHMASK >> (k)) & 1) && lo <= (k) && (k) < hi)
#define SEAM(k) do { if (IN(k) && IN((k) + 1)) { xcd_barrier(xbar); } } while (0)
#ifndef PROBE_MASK
#define PROBE_MASK 0
#endif
#define SEG_BEGIN(k) unsigned long long seg_t0_ = 0; if ((PROBE_MASK >> (k)) & 1) seg_t0_ = __builtin_amdgcn_s_memrealtime()
#define SEG_END(k) do { if ((PROBE_MASK >> (k)) & 1) { const unsigned long long t1_ = __builtin_amdgcn_s_memrealtime(), d_ = t1_ - seg_t0_; while (__builtin_amdgcn_s_memrealtime() - t1_ < d_) __builtin_amdgcn_s_sleep(8); } } while (0)
#define PHASE_ARGS() int tid = threadIdx.x; asm volatile("" : "+v"(tid)); const int lane = tid & 63, wave = __builtin_amdgcn_readfirstlane(tid >> 6); (void)lane; (void)wave; const KArgs args = load_args(); unsigned char* ws = args.ws; float* out = args.out; (void)out; \
    bf16* QO = (bf16*)(ws + WS_QO); bf16* KB = (bf16*)(ws + WS_KB); bf16* VB = (bf16*)(ws + WS_VB); bf16* HB = (bf16*)(ws + WS_HB); bf16* ACT = (bf16*)(ws + WS_ACT); (void)QO; (void)KB; (void)VB; (void)HB; (void)ACT
#define SSPN(i) ((float*)(ws + WS_SSP + (size_t)(i) * SSP_STRIDE))
#define SOFT_P(s_) ((unsigned*)ws + 8192 + 2048 * (s_))
#define SOFT_S(s_) ((unsigned*)ws + 8192 + 2048 * (s_) + 1088)
#define STW ((volatile LAS unsigned*)(L + RING_BYTES + 1024))
#define LARR ((LAS unsigned*)(L + RING_BYTES + 1024 + 64))

    if (IN(0)) {
        PHASE_ARGS();
        SEG_BEGIN(0);
        LAS unsigned char* wf = L + 98304;
        for (int e = tid; e < 32 * 64; e += NWAVES * 64) { const int ks = e >> 6, ln = e & 63, h = ln & 15, kq = ln >> 4, k0 = 32 * ks + 8 * kq; float v[8];
#pragma unroll
            for (int i = 0; i < 8; ++i) v[i] = args.in[8][(size_t)(k0 + i) * 3088 + 3072 + h] * args.in[7][k0 + i];
            *(LAS v4u*)(wf + e * 16) = (v4u){pk2(v[0], v[1]), pk2(v[2], v[3]), pk2(v[4], v[5]), pk2(v[6], v[7])}; }
        __syncthreads();
        { const int g = wave * G + vcu; if (g < MT / 16) p0_row_group(args, g, wf, lane); }
        LAS float* scr = (LAS float*)(L + wave * 8704);
        const int gw = vcu * NWAVES + wave, NGW = G * NWAVES;
        for (int it = gw; it < P0_FIRST; it += NGW) p0_weight_item(args, it, scr, lane);
        SEG_END(0);
    }
    SEAM(0);
    if (IN(1)) {
        PHASE_ARGS();
        SEG_BEGIN(1);
        p1_scan(args, vcu, (LAS float*)L, tid);
        pg8::Gemm g{HB, (const bf16*)(ws + WS_WQKV0), MT, 3072, 1024}; pg8::StaticOrder S; S.init(MT, 3072, G, bx);
        pg8::EpiQKV E{QO, KB, VB, out + O_AKP, out + O_AVP, out + O_AKS, out + O_AVS, SSPN(0), 0, attn_body::C2};
        pg8::gemm_phase<pg8::EpiQKV, pg8::StaticOrder, PG8_ALIGN, PG8_SP2>(L, g, S, E);
        { const int n4 = (MT / 256) * 12 - 3 * G;
          if (n4 >= 0 && n4 < G && bx >= n4) { LAS float* scr = (LAS float*)(L + wave * 8704); const int cw = (bx - n4) * NWAVES + wave, ncw = (G - n4) * NWAVES;
              for (int it = P0_FIRST + cw; it < P0_SECOND; it += ncw) p0_weight_item(args, it, scr, lane); } }
        SEG_END(1);
    }
    SEAM(1);
    if (IN(2)) {
        PHASE_ARGS();
        SEG_BEGIN(2);
        { SEG_BEGIN(12); for (int i = 0; i < 2; ++i) { const int u = 2 * vcu + i; if (u < DECB * NH) sample_attn<0>(args, u >> 4, u & 15, L, tid); } SEG_END(12); }
        const attn_body::AttnTensors AT{(const attn_body::bf16*)QO, (const attn_body::bf16*)KB, (const attn_body::bf16*)VB, (attn_body::bf16*)QO, (const attn_body::bf16*)(ws + WS_KX), args.in[12]};
        const attn_body::StaticOrder S(G, bx);
        attn_body::attn_phase<0, attn_body::StaticOrder>((char*)lds, AT, S);
        SEG_END(2);
    }
    SEAM(2);
    if (IN(3)) {
        PHASE_ARGS();
        SEG_BEGIN(3);
        pg8::Gemm g{QO, (const bf16*)(ws + WS_WO0), MT, 1024, 1024}; pg8::FlexOrder S; S.init(4, G, bx, 0, 0); S.arrP = SOFT_P(0); S.arrS = SOFT_S(0); S.larr = LARR; S.stw = STW;
        pg8::EpiRes E{args.in[0], args.in[1], out, HB, SSPN(1)};
        pg8::gemm_phase<pg8::EpiRes, pg8::FlexOrder, PG8_ALIGN, PG8_SP2>(L, g, S, E);
        SEG_END(3);
    }
    if (IN(4)) {
        PHASE_ARGS();
        SEG_BEGIN(4);
        pg8::Gemm g{HB, (const bf16*)(ws + WS_WGU0), MT, 5632, 1024}; pg8::FlexOrder S; S.init(22, G, bx, 8, 5); S.waitP = SOFT_P(0) + 1024; S.waitS = SOFT_S(0); S.tgtP = STW[1]; S.tgtS = 8u;
        pg8::EpiSwiGLU E{ACT, SSPN(1)};
        pg8::gemm_phase<pg8::EpiSwiGLU, pg8::FlexOrder, PG8_ALIGN, PG8_SP2>(L, g, S, E);
        SEG_END(4);
    }
    SEAM(4);
    if (IN(5)) {
        PHASE_ARGS();
        SEG_BEGIN(5);
        pg8::Gemm g{ACT, (const bf16*)(ws + WS_WD0), MT, 1024, 2816}; pg8::StaticOrder S; S.init(MT, 1024, G, bx);
        pg8::EpiRes E{out, out + (size_t)MP * 1024, out, HB, SSPN(2)};
        pg8::gemm_phase<pg8::EpiRes, pg8::StaticOrder, PG8_ALIGN, PG8_SP2>(L, g, S, E);
        SEG_END(5);
    }
    SEAM(5);
    if (IN(6)) {
        PHASE_ARGS();
        SEG_BEGIN(6);
        pg8::Gemm g{HB, (const bf16*)(ws + WS_WKVQ), MT, 3072, 1024}; pg8::StaticOrder S; S.init(MT, 3072, G, bx);
        pg8::EpiQKV E{QO, KB, VB, out + O_BKP, out + O_BVP, out + O_BKS, out + O_BVS, SSPN(2), 1, attn_body::C2};
        pg8::gemm_phase<pg8::EpiQKV, pg8::StaticOrder, PG8_ALIGN, PG8_SP2>(L, g, S, E);
        { const int n4 = (MT / 256) * 12 - 3 * G;
          if (n4 >= 0 && n4 < G && bx >= n4) { LAS float* scr = (LAS float*)(L + wave * 8704); const int cw = (bx - n4) * NWAVES + wave, ncw = (G - n4) * NWAVES;
              for (int it = P0_SECOND + cw; it < P0_NITEMS; it += ncw) p0_weight_item(args, it, scr, lane); } }
        SEG_END(6);
    }
    SEAM(6);
    if (IN(7)) {
        PHASE_ARGS();
        SEG_BEGIN(7);
        { SEG_BEGIN(13); for (int i = 0; i < 2; ++i) { const int u = 2 * vcu + i; if (u < DECB * NH) sample_attn<1>(args, u >> 4, u & 15, L, tid); } SEG_END(13); }
        const attn_body::AttnTensors AT{(const attn_body::bf16*)QO, (const attn_body::bf16*)KB, (const attn_body::bf16*)VB, (attn_body::bf16*)QO, (const attn_body::bf16*)(ws + WS_KX), args.in[12]};
        const attn_body::StaticOrder S(G, bx);
        attn_body::attn_phase<1, attn_body::StaticOrder>((char*)lds, AT, S);
        SEG_END(7);
    }
    SEAM(7);
    if (IN(8)) {
        PHASE_ARGS();
        SEG_BEGIN(8);
        pg8::Gemm g{QO, (const bf16*)(ws + WS_WO1), MT, 1024, 1024}; pg8::FlexOrder S; S.init(4, G, bx, 0, 0); S.arrP = SOFT_P(2); S.arrS = SOFT_S(2); S.larr = LARR; S.stw = STW;
        pg8::EpiRes E{out, out + (size_t)MP * 1024, out, HB, SSPN(3)};
        pg8::gemm_phase<pg8::EpiRes, pg8::FlexOrder, PG8_ALIGN, PG8_SP2>(L, g, S, E);
        SEG_END(8);
    }
    if (IN(9)) {
        PHASE_ARGS();
        SEG_BEGIN(9);
        pg8::Gemm g{HB, (const bf16*)(ws + WS_WGU1), MT, 5632, 1024}; pg8::FlexOrder S; S.init(22, G, bx, 8, 5); S.waitP = SOFT_P(2) + 1024; S.waitS = SOFT_S(2); S.tgtP = STW[1]; S.tgtS = 8u;
        pg8::EpiSwiGLU E{ACT, SSPN(3)};
        pg8::gemm_phase<pg8::EpiSwiGLU, pg8::FlexOrder, PG8_ALIGN, PG8_SP2>(L, g, S, E);
        SEG_END(9);
    }
    SEAM(9);
    if (IN(10)) {
        PHASE_ARGS();
        SEG_BEGIN(10);
        pg8::Gemm g{ACT, (const bf16*)(ws + WS_WD1), MT, 1024, 2816}; pg8::StaticOrder S; S.init(MT, 1024, G, bx);
        pg8::EpiRes E{out, out + (size_t)MP * 1024, out, HB, SSPN(4)};
        pg8::gemm_phase<pg8::EpiRes, pg8::StaticOrder, PG8_ALIGN, PG8_SP2>(L, g, S, E);
        SEG_END(10);
    }
    SEAM(10);
    if (IN(11)) {
        PHASE_ARGS();
        SEG_BEGIN(11);
        const int gw = vcu * NWAVES + wave, NGW = G * NWAVES; const float* gf = args.in[19]; const float* ssp = SSPN(4);
        f32x4 gv[4];
#pragma unroll
        for (int j = 0; j < 4; ++j) gv[j] = *(const f32x4*)(gf + 256 * j + 4 * lane);
        for (int m = gw; m < MT; m += NGW) {
            float s = 0.f;
#pragma unroll
            for (int j = 0; j < 4; ++j) { const f32x4 p = *(const f32x4*)(ssp + (size_t)m * 16 + 4 * j); s += (p[0] + p[1]) + (p[2] + p[3]); }
            const float rstd = 1.0f / sqrtf(s * (1.0f / 1024.0f) + 1e-6f);
            float* r = out + (size_t)m * 1024 + 4 * lane;
#pragma unroll
            for (int j = 0; j < 4; ++j) { f32x4 v = *(f32x4*)(r + 256 * j); v = v * rstd * gv[j]; *(f32x4*)(r + 256 * j) = v; }
        }
        SEG_END(11);
    }
#undef IN
#undef SEAM
}

extern "C" void kernel_launch(void* const* d_in, const int* in_sizes, int n_in, void* d_out, int out_size, void* d_ws, size_t ws_size, hipStream_t stream) {
    static int grid = 0;
    if (grid == 0) {
        if (n_in != 20 || (size_t)out_size != O_END || ws_size < WS_END) { fprintf(stderr, "kernel_launch: unexpected shapes (n_in %d out %d ws %zu)\n", n_in, out_size, ws_size); grid = -1; return; }
        int dev = 0, cus = 0, per_cu = 0;
        hipGetDevice(&dev); hipDeviceGetAttribute(&cus, hipDeviceAttributeMultiprocessorCount, dev);
        if (hipFuncSetAttribute((const void*)fwd_mega, hipFuncAttributeMaxDynamicSharedMemorySize, LDS_BYTES) != hipSuccess) { fprintf(stderr, "kernel_launch: hipFuncSetAttribute failed\n"); grid = -1; return; }
        if (hipOccupancyMaxActiveBlocksPerMultiprocessor(&per_cu, (const void*)fwd_mega, NWAVES * 64, LDS_BYTES) != hipSuccess || per_cu < 1) { fprintf(stderr, "kernel_launch: occupancy query says %d\n", per_cu); per_cu = 1; }
        (void)hipGetLastError();
        grid = cus * per_cu;
        if (grid != 256) fprintf(stderr, "kernel_launch: grid %d (expected 256)\n", grid);
    }
    if (grid < 0) return;
    if (hipMemsetAsync(d_ws, 0, 131072, stream) != hipSuccess) { fprintf(stderr, "kernel_launch: memset failed\n"); return; }
    KArgs a{};
    for (int i = 0; i < 20; ++i) a.in[i] = (const float*)d_in[i];
    a.out = (float*)d_out; a.ws = (unsigned char*)d_ws;
#if MK_PER_PHASE
    for (int p = 0; p < N_PHASES; ++p) { a.ph_lo = p; a.ph_hi = p + 1; void* kargs[] = {&a};
        hipError_t e = hipLaunchCooperativeKernel((const void*)fwd_mega, dim3(grid), dim3(NWAVES * 64), kargs, LDS_BYTES, stream);
        if (e != hipSuccess) { fprintf(stderr, "kernel_launch: launch %d failed: %s\n", p, hipGetErrorString(e)); break; } }
#else
    a.ph_lo = 0; a.ph_hi = N_PHASES; void* kargs[] = {&a};
    hipError_t e = hipLaunchCooperativeKernel((const void*)fwd_mega, dim3(grid), dim3(NWAVES * 64), kargs, LDS_BYTES, stream);
    if (e != hipSuccess) fprintf(stderr, "kernel_launch: cooperative launch failed: %s (grid %d)\n", hipGetErrorString(e), grid);
#endif
}
```

```cpp
#include <hip/hip_cooperative_groups.h>
#include <hip/hip_runtime.h>
#include <cstdio>
#include <cstdint>
namespace pg8 {
#define PG8_LAS __attribute__((address_space(3)))
typedef unsigned short bf16_t;
typedef short bf16x8 __attribute__((ext_vector_type(8)));
typedef float f32x4 __attribute__((ext_vector_type(4)));
typedef unsigned u32x4 __attribute__((ext_vector_type(4)));
constexpr int BM = 256, BK = 64, HALF = 128, HTB = HALF * BK * 2  , STAGE_BYTES = 8 * HTB, NXCD = 8, WGM = 8;

__host__ __device__ __forceinline__ int lds_byte(int r, int c) { const int st = (r >> 4) * 2 + (c >> 5), rr = r & 15, cc = c & 31, ob = rr * 64 + cc * 2; return st * 1024 + (ob ^ (((ob >> 9) & 1) << 5)); }
__host__ __device__ __forceinline__ void stage_rc(int b, int& R, int& C) { const int st = b / 1024, sb = b % 1024, swz = sb ^ (((sb >> 9) & 1) << 5); R = (st >> 1) * 16 + swz / 64; C = (st & 1) * 32 + (swz % 64) / 2; }
__host__ __device__ __forceinline__ int perm32(int rho) { const int n = rho >> 4, i = rho & 15; return 8 * (i >> 2) + 4 * n + (i & 3); }

struct Unit { int pm, pn; };
struct Gemm { const bf16_t* A; const bf16_t* Bt; int M, N, K; };

struct StaticOrder {
    int nM, nN, nwg, G, c;
    __host__ __device__ void init(int M, int N, int G_, int c_) { nM = M / BM; nN = N / BM; nwg = nM * nN; G = G_; c = c_; }
    __host__ __device__ bool next(int i, Unit& u) const {
        const long L = (long)i * G + c; if (L >= nwg) return false;
        int wgid = (int)L; { const int q = nwg / NXCD, r = nwg % NXCD, xcd = wgid % NXCD, off = wgid / NXCD; wgid = (xcd < r ? xcd * (q + 1) : r * (q + 1) + (xcd - r) * q) + off; }
        const int nig = WGM * nN, gid = wgid / nig, fm = gid * WGM, gsz = (nM - fm) < WGM ? (nM - fm) : WGM;
        u.pm = fm + ((wgid % nig) % gsz); u.pn = (wgid % nig) / gsz; return true;
    }
    __device__ __forceinline__ void a_ready(const Unit&) const {}
    __device__ __forceinline__ void done(const Unit&) const {}
};

struct FlexOrder {
    int nN, nwg, nprompt, G, c, ns, ks, nmain;
    unsigned *arrP, *arrS, *waitP, *waitS; unsigned tgtP, tgtS; PG8_LAS unsigned* larr; volatile PG8_LAS unsigned* stw; mutable int acq;
    __device__ void init(int nN_, int G_, int c_, int ns_, int ks_, int rot = 0) { nN = nN_; nprompt = 64 * nN_; nwg = 66 * nN_; G = G_; c = (c_ + rot) % G_; ns = ns_; ks = ks_; nmain = nwg - ns_ * ks_;
        arrP = arrS = waitP = waitS = nullptr; tgtP = tgtS = 0u; larr = nullptr; stw = nullptr; acq = 0; }
    __device__ bool next(int i, Unit& u) const {
        int L;
        if (c >= ns) { L = i * (G - ns) + (c - ns); if (L >= nmain) return false; } else { if (i >= ks) return false; L = nmain + i * ns + c; }
        if (L < nprompt) { int wgid = L; { const int q = nprompt / NXCD, r = nprompt % NXCD, xcd = wgid % NXCD, off = wgid / NXCD; wgid = (xcd < r ? xcd * (q + 1) : r * (q + 1) + (xcd - r) * q) + off; }
            const int nig = WGM * nN, gid = wgid / nig, fm = gid * WGM, gsz = (64 - fm) < WGM ? (64 - fm) : WGM;
            u.pm = fm + ((wgid % nig) % gsz); u.pn = (wgid % nig) / gsz; }
        else { const int s = L - nprompt; u.pm = 64 + s / nN; u.pn = s % nN; }
        return true;
    }
    __device__ __forceinline__ void a_ready(const Unit& u) const {
        if (!waitP) return;
        const int bit = u.pm >= 64 ? 2 : 1; if (acq & bit) return;
        unsigned* p = bit == 1 ? waitP : waitS; const unsigned tgt = bit == 1 ? tgtP : tgtS; unsigned sp = 0;
        while (__hip_atomic_load(p, __ATOMIC_RELAXED, __HIP_MEMORY_SCOPE_AGENT) < tgt) { __builtin_amdgcn_s_sleep(4); if (++sp > (1u << 22)) break; }
        __builtin_amdgcn_fence(__ATOMIC_ACQUIRE, "agent"); asm volatile("s_waitcnt vmcnt(0)" ::: "memory");
        acq |= bit;
    }
    __device__ __forceinline__ void done(const Unit& u) const {
        if (!arrP) return;
        asm volatile("s_waitcnt vmcnt(0)" ::: "memory");
        if ((threadIdx.x & 63) == 0) {
            const unsigned old = __hip_atomic_fetch_add(larr, 1u, __ATOMIC_RELAXED, __HIP_MEMORY_SCOPE_WORKGROUP);
            if ((old & 7u) == 7u) {
                if (u.pm >= 64) { __builtin_amdgcn_fence(__ATOMIC_RELEASE, "agent"); asm volatile("s_waitcnt vmcnt(0)" ::: "memory");
                    __hip_atomic_fetch_add(arrS, 1u, __ATOMIC_RELAXED, __HIP_MEMORY_SCOPE_AGENT); }
                else {
                    const unsigned x = (unsigned)__builtin_amdgcn_s_getreg((3 << 11) | 20) & 0xFu, nloc = stw[0];
                    const unsigned o = __hip_atomic_fetch_add(arrP + 64 * x, 1u, __ATOMIC_RELAXED, __HIP_MEMORY_SCOPE_AGENT);
                    if (o + 1u == nloc) { __builtin_amdgcn_fence(__ATOMIC_RELEASE, "agent"); asm volatile("s_waitcnt vmcnt(0)" ::: "memory");
                        __hip_atomic_fetch_add(arrP + 1024, 1u, __ATOMIC_RELAXED, __HIP_MEMORY_SCOPE_AGENT); } } }
        }
    }
};

__device__ __forceinline__ unsigned cvt_pk_bf16(float lo, float hi) { unsigned r; asm volatile("v_cvt_pk_bf16_f32 %0, %1, %2" : "=v"(r) : "v"(lo), "v"(hi)); return r; }
__device__ __forceinline__ void st16(void* p, u32x4 v) {
#if defined(EPI_WT) && EPI_WT
    asm volatile("global_store_dwordx4 %0, %1, off sc1" : : "v"(p), "v"(v) : "memory");
#else
    *(u32x4*)p = v;
#endif
}
__device__ __forceinline__ void st16f(void* p, f32x4 v) { st16(p, __builtin_bit_cast(u32x4, v)); }
constexpr int MP_ROWS = 16384;
constexpr float RMS_EPS = 1e-6f;
__device__ __forceinline__ void row_rstd(float (&rs)[2][4], const float* ssp, int row0, int fq) {
#pragma unroll
    for (int ai = 0; ai < 2; ++ai)
#pragma unroll
        for (int m = 0; m < 4; ++m) { const f32x4 p = *(const f32x4*)(ssp + (size_t)(row0 + ai * HALF + m * 16) * 16 + 4 * fq);
            float s = (p[0] + p[1]) + (p[2] + p[3]); s += __shfl_xor(s, 16); s += __shfl_xor(s, 32);
            rs[ai][m] = 1.0f / sqrtf(s * (1.0f / 1024.0f) + RMS_EPS); }
}
struct EpiQKV {
    static constexpr bool PERM = true, AFTER_DRAIN = false;
    bf16_t *Qb, *Kb, *Vb; float *kp, *vp, *ks, *vs; const float* ssp; int layer; float qscale;
    __device__ __forceinline__ long frow(int row) const {
        if (layer == 0) return row < MP_ROWS ? (long)row * 1024 : (long)(row - MP_ROWS) * 1024;
        if (row < MP_ROWS) { const int t = row & 8191, b = row >> 13; return t >= 7680 ? (long)(b * 512 + t - 7680) * 1024 : -1; }
        const int sr = row - MP_ROWS; return (long)((sr >> 4) * 512 + 496 + (sr & 15)) * 1024;
    }
    __device__ __forceinline__ void operator()(const f32x4 (&acc)[2][2][4][2], const Unit& u, int wr, int wc, int fr, int fq) const {
        const int t = u.pn >> 2, colt = (u.pn & 3) * BM, row0 = u.pm * BM + wr * 64 + fr, col0 = colt + wc * 32 + 8 * fq;
        float rs[2][4]; row_rstd(rs, ssp, row0, fq);
        bf16_t* const qb_ = Qb; bf16_t* const kb_ = Kb; bf16_t* const vb_ = Vb; float* const kp_ = kp; float* const vp_ = vp; float* const ks_ = ks; float* const vs_ = vs;
        bf16_t* B = t == 0 ? qb_ : (t == 1 ? kb_ : vb_); const float sc = t == 0 ? qscale : 1.f;
        const bool prow = u.pm < 64;
        float* fb = t == 1 ? (prow ? kp_ : ks_) : (prow ? vp_ : vs_);
        const bool anyf = t > 0 && (layer == 0 || !prow || (u.pm & 31) >= 30);
#pragma unroll
        for (int ai = 0; ai < 2; ++ai)
#pragma unroll
            for (int m = 0; m < 4; ++m) { const int row = row0 + ai * HALF + m * 16; const float r = rs[ai][m];
                const long fo = anyf ? frow(row) : -1;
#pragma unroll
                for (int bj = 0; bj < 2; ++bj) { f32x4 v0 = acc[ai][bj][m][0] * r, v1 = acc[ai][bj][m][1] * r;
                    if (fo >= 0) { float* fp = fb + fo + col0 + bj * HALF; st16f(fp, v0); st16f(fp + 4, v1); }
                    v0 = v0 * sc; v1 = v1 * sc; u32x4 w; w.x = cvt_pk_bf16(v0[0], v0[1]); w.y = cvt_pk_bf16(v0[2], v0[3]); w.z = cvt_pk_bf16(v1[0], v1[1]); w.w = cvt_pk_bf16(v1[2], v1[3]);
                    st16(B + (size_t)row * 1024 + col0 + bj * HALF, w); } }
    }
};
struct EpiRes {
    static constexpr bool PERM = true, AFTER_DRAIN = false;
    const float *base_p, *base_s; float* H; bf16_t* HB; float* ssp;
    __device__ __forceinline__ void operator()(const f32x4 (&acc)[2][2][4][2], const Unit& u, int wr, int wc, int fr, int fq) const {
        const int col0 = u.pn * BM + wc * 32 + 8 * fq, rl0 = wr * 64 + fr;
        const float* base = u.pm < 64 ? base_p + (size_t)u.pm * BM * 1024 : base_s + (size_t)(u.pm - 64) * BM * 1024;
#pragma unroll
        for (int ai = 0; ai < 2; ++ai)
#pragma unroll
            for (int m = 0; m < 4; ++m) { const int rl = rl0 + ai * HALF + m * 16; const size_t row = (size_t)u.pm * BM + rl; float ss = 0.f;
#pragma unroll
                for (int bj = 0; bj < 2; ++bj) { const float* bp = base + (size_t)rl * 1024 + col0 + bj * HALF;
                    const f32x4 v0 = acc[ai][bj][m][0] + *(const f32x4*)bp, v1 = acc[ai][bj][m][1] + *(const f32x4*)(bp + 4);
                    ss += (v0[0] * v0[0] + v0[1] * v0[1]) + (v0[2] * v0[2] + v0[3] * v0[3]) + (v1[0] * v1[0] + v1[1] * v1[1]) + (v1[2] * v1[2] + v1[3] * v1[3]);
                    float* hp = H + row * 1024 + col0 + bj * HALF; st16f(hp, v0); st16f(hp + 4, v1);
                    u32x4 w; w.x = cvt_pk_bf16(v0[0], v0[1]); w.y = cvt_pk_bf16(v0[2], v0[3]); w.z = cvt_pk_bf16(v1[0], v1[1]); w.w = cvt_pk_bf16(v1[2], v1[3]);
                    st16(HB + row * 1024 + col0 + bj * HALF, w); }
                ss += __shfl_xor(ss, 16); ss += __shfl_xor(ss, 32);
                if (fq == 0) ssp[row * 16 + u.pn * 4 + wc] = ss;
                if (m & 1) asm volatile("" ::: "memory"); }
    }
};
struct EpiSwiGLU {
    static constexpr bool PERM = true, AFTER_DRAIN = false;
    bf16_t* ACT; const float* ssp;
    __device__ __forceinline__ void operator()(const f32x4 (&acc)[2][2][4][2], const Unit& u, int wr, int wc, int fr, int fq) const {
        const int row0 = u.pm * BM + wr * 64 + fr, col0 = u.pn * HALF + wc * 32 + 8 * fq;
        float rs[2][4]; row_rstd(rs, ssp, row0, fq);
#pragma unroll
        for (int ai = 0; ai < 2; ++ai)
#pragma unroll
            for (int m = 0; m < 4; ++m) { const int row = row0 + ai * HALF + m * 16; const float r = rs[ai][m]; float o[8];
#pragma unroll
                for (int n = 0; n < 2; ++n)
#pragma unroll
                    for (int e = 0; e < 4; ++e) { const float g = acc[ai][0][m][n][e] * r, up = acc[ai][1][m][n][e] * r;
                        o[n * 4 + e] = g * __builtin_amdgcn_rcpf(1.0f + __builtin_amdgcn_exp2f(g * -1.4426950408889634f)) * up; }
                u32x4 w; w.x = cvt_pk_bf16(o[0], o[1]); w.y = cvt_pk_bf16(o[2], o[3]); w.z = cvt_pk_bf16(o[4], o[5]); w.w = cvt_pk_bf16(o[6], o[7]);
                st16(ACT + (size_t)row * 2816 + col0, w); }
    }
};

template <class Epi, class Sched, bool ALIGN_EPI = false, bool SP2 = false>
__device__ __forceinline__ void gemm_phase(PG8_LAS unsigned char* lds, const Gemm g, const Sched& S, const Epi& E) {
    int tid_ = threadIdx.x; asm volatile("" : "+v"(tid_));
    const int tid = tid_, wid = __builtin_amdgcn_readfirstlane(tid >> 6), lane = tid & 63, wr = wid >> 2, wc = wid & 3, fr = lane & 15, fq = lane >> 4;
    const int K = g.K, nt = K / BK;
    unsigned voffA[2], voffB[2];
#pragma unroll
    for (int i = 0; i < 2; ++i) { int R, C; stage_rc(tid * 16 + i * 8192, R, C); const int Rb = Epi::PERM ? ((R & ~31) + perm32(R & 31)) : R;
        voffA[i] = (unsigned)(R * K + C) * 2u; voffB[i] = (unsigned)(Rb * K + C) * 2u; }
    const size_t kstep = (size_t)(BK * 2);
    const size_t hstep = (size_t)HALF * K * 2;
    const size_t tstep = 2 * hstep;
    const unsigned ldsw = (unsigned)wid * 1024u;
    const int aoff = lds_byte(wr * 64 + fr, fq * 8), boff = lds_byte(wc * 32 + fr, fq * 8);
#define PG8_SA(b, h) (((b) * 2 + (h)) * HTB)
#define PG8_SB(b, h) ((4 + (b) * 2 + (h)) * HTB)
#define PG8_STAGE(bufoff, gbase, voff) do { _Pragma("unroll") for (int _i = 0; _i < 2; ++_i) \
        __builtin_amdgcn_global_load_lds((const unsigned*)((const char*)(gbase) + (voff)[_i]), (PG8_LAS unsigned*)(lds + (bufoff) + ldsw + _i * 8192), 16, 0, 0); } while (0)
#define PG8_LDA(dst, b, h) do { _Pragma("unroll") for (int m = 0; m < 4; ++m) _Pragma("unroll") for (int k = 0; k < 2; ++k) dst[m][k] = *(const PG8_LAS bf16x8*)(lds + PG8_SA(b, h) + aoff + m * 2048 + k * 1024); } while (0)
#define PG8_LDB(dst, b, h) do { _Pragma("unroll") for (int n = 0; n < 2; ++n) _Pragma("unroll") for (int k = 0; k < 2; ++k) dst[n][k] = *(const PG8_LAS bf16x8*)(lds + PG8_SB(b, h) + boff + n * 2048 + k * 1024); } while (0)
#define PG8_MMA(ai, bj, At, Bt) do { __builtin_amdgcn_s_setprio(1); _Pragma("unroll") for (int m = 0; m < 4; ++m) _Pragma("unroll") for (int n = 0; n < 2; ++n) _Pragma("unroll") for (int k = 0; k < 2; ++k) \
        acc[ai][bj][m][n] = __builtin_amdgcn_mfma_f32_16x16x32_bf16(Bt[n][k], At[m][k], acc[ai][bj][m][n], 0, 0, 0); __builtin_amdgcn_s_setprio(0); } while (0)
#define PG8_WAIT_V(n) asm volatile("s_waitcnt vmcnt(" #n ")" ::: "memory")
#define PG8_WAIT_L(n) asm volatile("s_waitcnt lgkmcnt(" #n ")" ::: "memory")
#define PG8_BAR __builtin_amdgcn_s_barrier()
#define PG8_SCHED __builtin_amdgcn_sched_barrier(0)
    Unit cur, nxt; int ui = 0;
    if (!S.next(0, cur)) return;
    f32x4 acc[2][2][4][2];
#pragma unroll
    for (int a = 0; a < 2; ++a)
#pragma unroll
        for (int b = 0; b < 2; ++b)
#pragma unroll
            for (int m = 0; m < 4; ++m)
#pragma unroll
                for (int n = 0; n < 2; ++n) acc[a][b][m][n] = (f32x4){0.f, 0.f, 0.f, 0.f};
    bf16x8 At[4][2], B0[2][2], B1[2][2];
    const char* cA = (const char*)g.A + (size_t)cur.pm * tstep; const char* cB = (const char*)g.Bt + (size_t)cur.pn * tstep;
    S.a_ready(cur);
    if constexpr (SP2) {
        PG8_STAGE(PG8_SB(0, 0), cB, voffB); PG8_STAGE(PG8_SB(0, 1), cB + hstep, voffB); PG8_STAGE(PG8_SA(0, 0), cA, voffA); PG8_STAGE(PG8_SA(0, 1), cA + hstep, voffA);
        if (wr == 1) PG8_BAR;
        PG8_WAIT_V(2); PG8_BAR;
        PG8_STAGE(PG8_SB(1, 0), cB + kstep, voffB); PG8_STAGE(PG8_SA(1, 0), cA + kstep, voffA); PG8_STAGE(PG8_SB(1, 1), cB + hstep + kstep, voffB);
        PG8_WAIT_V(6); PG8_BAR;
    } else {
        PG8_STAGE(PG8_SB(0, 0), cB, voffB); PG8_STAGE(PG8_SA(0, 0), cA, voffA); PG8_STAGE(PG8_SB(0, 1), cB + hstep, voffB); PG8_STAGE(PG8_SA(0, 1), cA + hstep, voffA);
        if (wr == 1) PG8_BAR;
        PG8_WAIT_V(4); PG8_BAR;
        PG8_STAGE(PG8_SB(1, 0), cB + kstep, voffB); PG8_STAGE(PG8_SA(1, 0), cA + kstep, voffA); PG8_STAGE(PG8_SB(1, 1), cB + hstep + kstep, voffB);
        PG8_WAIT_V(6); PG8_BAR;
    }
    for (;;) {
        const bool has_next = S.next(ui + 1, nxt);
        const char* nA = has_next ? (const char*)g.A + (size_t)nxt.pm * tstep : cA; const char* nB = has_next ? (const char*)g.Bt + (size_t)nxt.pn * tstep : cB;
        for (int t = 0; t < nt; t += 2) {
            const bool last = (t == nt - 2);
            const char* a1 = cA + (size_t)(t + 1) * kstep;
            const char* a2 = last ? nA : cA + (size_t)(t + 2) * kstep; const char* b2 = last ? nB : cB + (size_t)(t + 2) * kstep;
            const char* a3 = a2 + kstep; const char* b3 = b2 + kstep;
            if (last && has_next) S.a_ready(nxt);
            if constexpr (SP2) {
            PG8_LDB(B0, 0, 0); PG8_LDB(B1, 0, 1); PG8_SCHED; PG8_LDA(At, 0, 0); PG8_STAGE(PG8_SA(1, 1), a1 + hstep, voffA);
            PG8_WAIT_V(8); PG8_WAIT_L(0); PG8_BAR; PG8_MMA(0, 0, At, B0); PG8_MMA(0, 1, At, B1); PG8_BAR; PG8_SCHED;
            PG8_LDA(At, 0, 1); PG8_STAGE(PG8_SB(0, 0), b2, voffB); PG8_STAGE(PG8_SB(0, 1), b2 + hstep, voffB); PG8_STAGE(PG8_SA(0, 0), a2, voffA);
            PG8_WAIT_V(8); PG8_WAIT_L(0); PG8_BAR; PG8_MMA(1, 0, At, B0); PG8_MMA(1, 1, At, B1); PG8_BAR; PG8_SCHED;
            PG8_LDB(B0, 1, 0); PG8_LDB(B1, 1, 1); PG8_SCHED; PG8_LDA(At, 1, 0); PG8_STAGE(PG8_SA(0, 1), a2 + hstep, voffA);
            PG8_WAIT_V(8); PG8_WAIT_L(0); PG8_BAR; PG8_MMA(0, 0, At, B0); PG8_MMA(0, 1, At, B1); PG8_BAR; PG8_SCHED;
            PG8_LDA(At, 1, 1); PG8_STAGE(PG8_SB(1, 0), b3, voffB); PG8_STAGE(PG8_SB(1, 1), b3 + hstep, voffB); PG8_STAGE(PG8_SA(1, 0), a3, voffA);
            PG8_WAIT_V(8); PG8_WAIT_L(0); PG8_BAR; PG8_MMA(1, 0, At, B0); PG8_MMA(1, 1, At, B1); PG8_BAR; PG8_SCHED;
            } else {
            PG8_LDB(B0, 0, 0); PG8_SCHED; PG8_LDA(At, 0, 0); PG8_STAGE(PG8_SA(1, 1), a1 + hstep, voffA);
            PG8_WAIT_L(8); PG8_BAR; PG8_WAIT_L(0); PG8_MMA(0, 0, At, B0); PG8_BAR; PG8_SCHED;
            PG8_LDB(B1, 0, 1); PG8_STAGE(PG8_SB(0, 0), b2, voffB);
            PG8_BAR; PG8_WAIT_L(0); PG8_MMA(0, 1, At, B1); PG8_BAR;
            PG8_LDA(At, 0, 1); PG8_STAGE(PG8_SA(0, 0), a2, voffA);
            PG8_BAR; PG8_WAIT_L(0); PG8_MMA(1, 0, At, B0); PG8_BAR; PG8_SCHED;
            PG8_STAGE(PG8_SB(0, 1), b2 + hstep, voffB);
            PG8_WAIT_V(6); PG8_BAR; PG8_MMA(1, 1, At, B1); PG8_BAR;
            PG8_LDB(B0, 1, 0); PG8_SCHED; PG8_LDA(At, 1, 0); PG8_STAGE(PG8_SA(0, 1), a2 + hstep, voffA);
            PG8_WAIT_L(8); PG8_BAR; PG8_WAIT_L(0); PG8_MMA(0, 0, At, B0); PG8_BAR; PG8_SCHED;
            PG8_LDB(B1, 1, 1); PG8_STAGE(PG8_SB(1, 0), b3, voffB);
            PG8_BAR; PG8_WAIT_L(0); PG8_MMA(0, 1, At, B1); PG8_BAR;
            PG8_LDA(At, 1, 1); PG8_STAGE(PG8_SA(1, 0), a3, voffA);
            PG8_BAR; PG8_WAIT_L(0); PG8_MMA(1, 0, At, B0); PG8_BAR; PG8_SCHED;
            PG8_STAGE(PG8_SB(1, 1), b3 + hstep, voffB);
            PG8_WAIT_V(6); PG8_BAR; PG8_MMA(1, 1, At, B1); PG8_BAR;
            }
        }
        if constexpr (ALIGN_EPI) { if (wr == 0) PG8_BAR; }
        if constexpr (!Epi::AFTER_DRAIN) { E(acc, cur, wr, wc, fr, fq); S.done(cur); }
        if (!has_next) break;
#pragma unroll
        for (int a = 0; a < 2; ++a)
#pragma unroll
            for (int b = 0; b < 2; ++b)
#pragma unroll
                for (int m = 0; m < 4; ++m)
#pragma unroll
                    for (int n = 0; n < 2; ++n) acc[a][b][m][n] = (f32x4){0.f, 0.f, 0.f, 0.f};
        cur = nxt; cA = nA; cB = nB; ++ui;
        if constexpr (ALIGN_EPI) { if (wr == 1) PG8_BAR; }
    }
    PG8_WAIT_V(0);
    if constexpr (!ALIGN_EPI) { if (wr == 0) PG8_BAR; }
    PG8_BAR;
    if constexpr (Epi::AFTER_DRAIN) { E.fused(acc, cur, wr, wc, fr, fq, lds, wid, lane); S.done(cur); }
#undef PG8_SA
#undef PG8_SB
#undef PG8_STAGE
#undef PG8_LDA
#undef PG8_LDB
#undef PG8_MMA
#undef PG8_WAIT_V
#undef PG8_WAIT_L
#undef PG8_BAR
#undef PG8_SCHED
}
}

#ifndef PG8_SP2
#define PG8_SP2 true
#endif
#ifndef PG8_ALIGN
#define PG8_ALIGN true
#endif
#include <hip/hip_bf16.h>
#include <cmath>
namespace attn_body {
using bf16=__hip_bfloat16;
using bf16x8=__attribute__((ext_vector_type(8)))short;
using s16x4=__attribute__((ext_vector_type(4)))short;
using f32x16=__attribute__((ext_vector_type(16)))float;
using u32x4=__attribute__((ext_vector_type(4)))unsigned;
constexpr int BATCH=2,NHEAD=16,SEQ=8192,D=64,DM=NHEAD*D;
constexpr int NW=8,QBLK=32,QB=QBLK*NW,KVBLK=64,NQB=SEQ/QB;
constexpr int ATTN_PITCH=DM, ATTN_UNIT_ROWS=QB;
__device__ __forceinline__ int crow(int r,int hi){return (r&3)+8*(r>>2)+4*hi;}
#define SBAR() __builtin_amdgcn_sched_barrier(0)
__device__ __forceinline__ void cmask(f32x16&p0,f32x16&p1,int jb,int qrel,int hi){
  const float NEG=-INFINITY; int kb=64*jb+4*hi;
  #pragma unroll
  for(int r=0;r<16;++r){int kv=kb+(r&3)+8*(r>>2); if(kv>qrel)p0[r]=NEG; if(kv+32>qrel)p1[r]=NEG;}
}

constexpr int NSLOT=3, SLOTB=8192;
constexpr int LDS_K=0, LDS_V=NSLOT*SLOTB, LDS_WS=2*NSLOT*SLOTB, LDS_OST=LDS_WS+NW*64*4, LDS_X=LDS_OST+NW*4096, LDS_BT=LDS_X+NSLOT*2048, LDS_BYTES=LDS_BT+2048;
constexpr float C2=0.125f*1.4426950408889634f;
__device__ __forceinline__ void glds16(const void*gsrc,unsigned lds_dst){unsigned keep;
  asm volatile("s_mov_b32 %0, m0\n\ts_mov_b32 m0, %2\n\ts_nop 0\n\tglobal_load_lds_dwordx4 %1, off\n\ts_mov_b32 m0, %0":"=&s"(keep):"v"(gsrc),"s"(lds_dst):"memory");}
__device__ __forceinline__ void glds16s(const void*sbase,unsigned voff,unsigned lds_dst){unsigned keep;
  asm volatile("s_mov_b32 %0, m0\n\ts_mov_b32 m0, %3\n\ts_nop 0\n\tglobal_load_lds_dwordx4 %1, %2\n\ts_mov_b32 m0, %0":"=&s"(keep):"v"(voff),"s"(sbase),"s"(lds_dst):"memory");}
__device__ __forceinline__ void glds4s(const void*sbase,unsigned voff,unsigned lds_dst){unsigned keep;
  asm volatile("s_mov_b32 %0, m0\n\ts_mov_b32 m0, %3\n\ts_nop 0\n\tglobal_load_lds_dword %1, %2\n\ts_mov_b32 m0, %0":"=&s"(keep):"v"(voff),"s"(sbase),"s"(lds_dst):"memory");}
__device__ __forceinline__ void glds4(const void*gsrc,unsigned lds_dst){unsigned keep;
  asm volatile("s_mov_b32 %0, m0\n\ts_mov_b32 m0, %2\n\ts_nop 0\n\tglobal_load_lds_dword %1, off\n\ts_mov_b32 m0, %0":"=&s"(keep):"v"(gsrc),"s"(lds_dst):"memory");}
__device__ __forceinline__ float max3f(float a,float b,float c){float r;asm("v_max3_f32 %0, %1, %2, %3":"=v"(r):"v"(a),"v"(b),"v"(c));return r;}
__device__ __forceinline__ float max2f(float a,float b){float r;asm("v_max_f32_e32 %0, %1, %2":"=v"(r):"v"(a),"v"(b));return r;}
__device__ __forceinline__ float fadd_s(float a,float b){float r;asm("v_add_f32_e32 %0, %1, %2":"=v"(r):"v"(a),"v"(b));return r;}
__device__ __forceinline__ float fsub_s(float a,float b){float r;asm("v_sub_f32_e32 %0, %1, %2":"=v"(r):"v"(a),"v"(b));return r;}
typedef float f32x2_t __attribute__((ext_vector_type(2))); typedef __bf16 bf16x2_t __attribute__((ext_vector_type(2)));
__device__ __forceinline__ unsigned cvtpk_s(float lo,float hi){f32x2_t v={lo,hi};bf16x2_t b=__builtin_convertvector(v,bf16x2_t);return __builtin_bit_cast(unsigned,b);}
#define WAIT_BAR(N) asm volatile("s_waitcnt vmcnt(" #N ") lgkmcnt(0)\n\ts_barrier":::"memory")

__device__ __forceinline__ void qkt(f32x16&p0,f32x16&p1,const char*Kslot,const bf16x8*qr,bf16x8 kx0,bf16x8 kx1,bf16x8 qe,int r32,int hi){
  const char*kb=Kslot+hi*1024+r32*16;
  #pragma unroll
  for(int d0=0;d0<4;++d0){
    const bf16x8 b0=*reinterpret_cast<const bf16x8*>(kb+d0*2048);
    const bf16x8 b1=*reinterpret_cast<const bf16x8*>(kb+d0*2048+512);
    if(d0==0){const f32x16 z=f32x16{};p0=__builtin_amdgcn_mfma_f32_32x32x16_bf16(kx0,qe,z,0,0,0);p1=__builtin_amdgcn_mfma_f32_32x32x16_bf16(kx1,qe,z,0,0,0);}
    {p0=__builtin_amdgcn_mfma_f32_32x32x16_bf16(b0,qr[d0],p0,0,0,0);p1=__builtin_amdgcn_mfma_f32_32x32x16_bf16(b1,qr[d0],p1,0,0,0);}}
}
typedef __attribute__((address_space(3))) const char* lds_cptr;
typedef short v4i16_t __attribute__((ext_vector_type(4)));
__device__ __forceinline__ void kload8(bf16x8*kf,lds_cptr kp){
  kf[0]=*(const __attribute__((address_space(3))) bf16x8*)(kp);      kf[1]=*(const __attribute__((address_space(3))) bf16x8*)(kp+512);
  kf[2]=*(const __attribute__((address_space(3))) bf16x8*)(kp+2048); kf[3]=*(const __attribute__((address_space(3))) bf16x8*)(kp+2560);
  kf[4]=*(const __attribute__((address_space(3))) bf16x8*)(kp+4096); kf[5]=*(const __attribute__((address_space(3))) bf16x8*)(kp+4608);
  kf[6]=*(const __attribute__((address_space(3))) bf16x8*)(kp+6144); kf[7]=*(const __attribute__((address_space(3))) bf16x8*)(kp+6656);
}
__device__ __forceinline__ void kload2(bf16x8*kf,lds_cptr kp,int j){ kf[2*j]=*(const __attribute__((address_space(3))) bf16x8*)(kp+j*2048); kf[2*j+1]=*(const __attribute__((address_space(3))) bf16x8*)(kp+j*2048+512); }
__device__ __forceinline__ s16x4 vtr(lds_cptr p){ return __builtin_bit_cast(s16x4,__builtin_amdgcn_ds_read_tr16_b64_v4i16((__attribute__((address_space(3))) v4i16_t*)p)); }
__device__ __forceinline__ float rowmax(const f32x16&p0,const f32x16&p1){
  float a=max3f(p0[0],p0[1],p1[0]),b=max3f(p0[2],p0[3],p1[1]);a=max3f(a,p1[2],p1[3]);
  #pragma unroll
  for(int r=4;r<16;r+=4){a=max3f(a,p0[r],p0[r+1]);b=max3f(b,p0[r+2],p0[r+3]);a=max3f(a,p1[r],p1[r+1]);b=max3f(b,p1[r+2],p1[r+3]);}
  const float m=max2f(a,b);
  auto rr=__builtin_amdgcn_permlane32_swap(__float_as_uint(m),__float_as_uint(m),false,false);
  return max2f(__uint_as_float(rr[0]),__uint_as_float(rr[1]));
}
__device__ __forceinline__ void pv(f32x16*o,int vb,bf16x8 pa0,bf16x8 pa1,bf16x8 pa2,bf16x8 pa3){
  #pragma unroll
  for(int d0=0;d0<2;++d0){s16x4 lo[4],hi[4];
    #pragma unroll
    for(int ks=0;ks<4;++ks){
      asm volatile("ds_read_b64_tr_b16 %0,%1 offset:%c2":"=&v"(lo[ks]):"v"(vb),"i"(d0*4096+ks*1024):"memory");
      asm volatile("ds_read_b64_tr_b16 %0,%1 offset:%c2":"=&v"(hi[ks]):"v"(vb),"i"(d0*4096+ks*1024+512):"memory");}
    asm volatile("s_waitcnt lgkmcnt(0)":::"memory");SBAR();
    #define PK(k) (bf16x8){lo[k][0],lo[k][1],lo[k][2],lo[k][3],hi[k][0],hi[k][1],hi[k][2],hi[k][3]}
    o[d0]=__builtin_amdgcn_mfma_f32_32x32x16_bf16(pa0,PK(0),o[d0],0,0,0);
    o[d0]=__builtin_amdgcn_mfma_f32_32x32x16_bf16(pa1,PK(1),o[d0],0,0,0);
    o[d0]=__builtin_amdgcn_mfma_f32_32x32x16_bf16(pa2,PK(2),o[d0],0,0,0);
    o[d0]=__builtin_amdgcn_mfma_f32_32x32x16_bf16(pa3,PK(3),o[d0],0,0,0);
    #undef PK
  }
}

#ifndef ATTN_STORE16
#define ATTN_STORE16(p,v) (*(u32x4*)(p)=(v))
#endif
template<int MODE,int THRL> __device__ __forceinline__ void attn_unit(int b,int h,int qb,const bf16*Q,const bf16*K,const bf16*V,bf16*O,char*shm,const bf16*KX,const float*relb){
  int tid_=threadIdx.x; asm volatile("":"+v"(tid_));
  const int tid=tid_,lane=tid&63,r32=lane&31,hi=lane>>5; const int wid=__builtin_amdgcn_readfirstlane(tid>>6);
  const long rowbase=(long)b*SEQ; const int q0=qb*QB;
  const bf16*Qw=Q+(rowbase+q0+wid*QBLK)*DM+h*D;
  const int kc0=(MODE==1)?((4*qb-8)>0?(4*qb-8):0):0;
  const bf16*Kh=K+(rowbase+(long)kc0*KVBLK)*DM+h*D,*Vh=V+(rowbase+(long)kc0*KVBLK)*DM+h*D;
  const unsigned lds0=(unsigned)(uintptr_t)shm;
  float*wsf=(float*)(shm+LDS_WS)+wid*64;
  const unsigned kvo=(unsigned)(lane*DM+wid*8)*2u, vvo=(unsigned)((16*(wid&3)+(lane>>2))*DM+(wid>>2)*32+(lane&3)*8)*2u;
  const unsigned kdst=lds0+LDS_K+wid*1024, vdst=lds0+LDS_V+wid*1024;
  #define TILE(s_) ((MODE==0)?(NT-1-(s_)):(s_))
  #define DMA_K(t,slot) glds16s(Kh+(long)TILE(t)*KVBLK*DM,kvo,(unsigned)__builtin_amdgcn_readfirstlane(kdst+(slot)))
  #define DMA_V(t,slot) glds16s(Vh+(long)TILE(t)*KVBLK*DM,vvo,(unsigned)__builtin_amdgcn_readfirstlane(vdst+(slot)))
  const bf16*xsrc=KX+((long)(b*NHEAD+h)*2*SEQ+(long)(wid>>2)*SEQ+16*(wid&3))*8; const unsigned xvo=(unsigned)lane*4u; const unsigned xdst=lds0+LDS_X+wid*256;
  #define DMA_E(t,slot) do{ if(MODE==0) glds4s(xsrc+(long)TILE(t)*KVBLK*8,xvo,(unsigned)__builtin_amdgcn_readfirstlane(xdst+((slot)>>2))); }while(0)
  const lds_cptr xp0=(lds_cptr)shm+LDS_X+hi*1024+r32*16;
  #define XLD(sl) do{ if(MODE==0){ ke0=*(const __attribute__((address_space(3))) bf16x8*)(xp0+((sl)>>2)); ke1=*(const __attribute__((address_space(3))) bf16x8*)(xp0+((sl)>>2)+512); } }while(0)
  #define WAITB_A() do{ if(MODE==0){WAIT_BAR(3);}else{WAIT_BAR(2);} }while(0)
  const int vb0=(int)(lds0+LDS_V)+((lane>>4)&1)*32+(lane&3)*8+(4*hi+((lane&15)>>2))*64;
  const char*Kbase=shm+LDS_K; bf16x8 kf[8];
  const lds_cptr shm3=(lds_cptr)shm; const lds_cptr kp0=shm3+LDS_K+hi*1024+r32*16; const lds_cptr vp0=shm3+LDS_V+((lane>>4)&1)*32+(lane&3)*8+(4*hi+((lane&15)>>2))*64;
  const int NT=(q0+QB)/KVBLK-kc0;
  if(MODE==1){ float*bt=(float*)(shm+LDS_BT); if(tid<257) bt[tid]=(relb[tid]-relb[256])*1.4426950408889634f; }
  u32x4 qev=(u32x4){0x3F803F80u,0x3F80u,0u,0u};
  bf16x8 ke0,ke1; { const u32x4 kc_=(hi==0)?(u32x4){0u,0x3F800000u,0x3F803F80u,0u}:(u32x4){0u,0u,0u,0u}; ke0=__builtin_bit_cast(bf16x8,kc_); ke1=ke0; }
  #define QE() __builtin_bit_cast(bf16x8,qev)
  #define SETQE() do{ const float nm_=-mhat; const unsigned a_=cvtpk_s(nm_,0.f)&0xffffu; const float r1_=nm_-__uint_as_float(a_<<16); const unsigned b_=cvtpk_s(r1_,0.f)&0xffffu; \
    const float r2_=r1_-__uint_as_float(b_<<16); const unsigned c_=cvtpk_s(r2_,0.f)&0xffffu; qev[1]=0x3F80u|(a_<<16); qev[2]=b_|(c_<<16); }while(0)
  DMA_K(0,0);DMA_E(0,0);DMA_V(0,0);DMA_K(1,SLOTB);DMA_E(1,SLOTB);
  bf16x8 qr[4];
  #pragma unroll
  for(int d0=0;d0<4;++d0)qr[d0]=*reinterpret_cast<const bf16x8*>(&Qw[(long)r32*DM+d0*16+hi*8]);
  float mhat=0.f,l_reg=0.f;f32x16 o[2];o[0]=f32x16{};o[1]=f32x16{};
  const int qrel=wid*QBLK+r32;
  const int cw=4*qb+(wid>>1);
  #define BMASK(P0,P1,t) do{ const int kc_=kc0+(t); if(kc_>cw||kc_<cw-8){ _Pragma("unroll") for(int r=0;r<16;++r){P0[r]=-INFINITY;P1[r]=-INFINITY;} } \
    else if(kc_>=cw-2){ const float*bt_=(const float*)(shm+LDS_BT); const int dq_=64*(cw-kc_)+32*(wid&1)+r32-4*hi; \
      _Pragma("unroll") for(int r=0;r<16;++r){ const int d0_=dq_-((r&3)+8*(r>>2)), d1_=d0_-32; P0[r]+=bt_[(d0_<128?d0_:128)+128]; P1[r]+=bt_[(d1_<128?d1_:128)+128]; } } }while(0)
  #define CMASK(P0,P1,t) do{ if(MODE==1){BMASK(P0,P1,t);} else {int jb_=3-(t); if(jb_>=0)cmask(P0,P1,jb_,qrel,hi);} }while(0)
  bool resc=false;
  #define START(P0,P1) do{ float rm=rowmax(P0,P1); rm=max2f(rm,-64.f); resc=false;     \
    { const float dl=rm; mhat=fadd_s(mhat,dl); \
      _Pragma("unroll") for(int r=0;r<16;++r){P0[r]=fsub_s(P0[r],dl);P1[r]=fsub_s(P1[r],dl);} \
      SETQE(); } \
    _Pragma("unroll") for(int r=0;r<16;++r)P0[r]=__builtin_amdgcn_exp2f(P0[r]); }while(0)
  #define RESC() do{ if(resc){ asm volatile("s_waitcnt lgkmcnt(0)":::"memory"); \
      _Pragma("unroll") for(int d_=0;d_<2;++d_) _Pragma("unroll") for(int r=0;r<16;++r)o[d_][r]*=wsf[crow(r,hi)]; } }while(0)
  f32x16 pA0,pA1,pB0,pB1;
  int sl_prev=0,sl_cur=0,sl_next=SLOTB;
  #define ROT() do{sl_prev=sl_cur;sl_cur=sl_next;sl_next=(sl_next==(NSLOT-1)*SLOTB)?0:sl_next+SLOTB;}while(0)
  DMA_K(2,2*SLOTB);DMA_E(2,2*SLOTB);
  if(MODE==0){WAIT_BAR(5);}else{WAIT_BAR(3);}
  XLD(0);
  qkt(pA0,pA1,Kbase,qr,ke0,ke1,QE(),r32,hi);asm volatile("s_nop 15\n\ts_nop 7":"+v"(pA0),"+v"(pA1));CMASK(pA0,pA1,0);
  START(pA0,pA1);
  _Pragma("unroll") for(int r=0;r<16;++r)pA1[r]=__builtin_amdgcn_exp2f(pA1[r]);
  WAIT_BAR(0);
  DMA_K(3,0);DMA_E(3,0);DMA_V(1,SLOTB);
  ROT();
  kload8(kf,kp0+sl_cur); XLD(sl_cur);
  WAITB_A();
  s16x4 vlo[8],vhi[8]; u32x4 pw0,pw1,pw2,pw3;
  #define PKW(P,B) cvtpk_s(P[B],P[B+1])
  #define PAF(k) __builtin_bit_cast(bf16x8,pw##k)
  #define VFR(i) (bf16x8){vlo[i][0],vlo[i][1],vlo[i][2],vlo[i][3],vhi[i][0],vhi[i][1],vhi[i][2],vhi[i][3]}
  #define PIN(x) asm volatile("":"+v"(x))
  #define MX3(a,b,c) __builtin_fmaxf(__builtin_fmaxf((a),(b)),(c))
  #define GAPA(MF,A0,A1,A2,A3,W0,W1,PW) do{ MF; sacc+=A0; sacc+=A1; sacc+=A2; sacc+=A3; PIN(sacc); W0; W1; PIN(PW); SBAR(); }while(0)
  #define EX(v) __builtin_amdgcn_exp2f(v)
  #define GAPB(MF,X,B) do{ MF; X[B]=EX(X[B]); X[B+1]=EX(X[B+1]); X[B+2]=EX(X[B+2]); X[B+3]=EX(X[B+3]); PIN(X); SBAR(); }while(0)
  #define VRD(i) do{ vlo[i]=vtr(vp_+(((i)>>2)*4096+((i)&3)*1024)); vhi[i]=vtr(vp_+(((i)>>2)*4096+((i)&3)*1024+512)); }while(0)
  #define KRD(G,j) do{ if(G){ kload2(kf,kp0+sl_next,j); SBAR(); } }while(0)
  #define STEP(C0,C1,P0,P1,t,GK,GV,GL) do{ SBAR(); \
    const lds_cptr vp_=vp0+sl_prev; \
    { const f32x16 z_=f32x16{}; C0=__builtin_amdgcn_mfma_f32_32x32x16_bf16(ke0,QE(),z_,0,0,0); C1=__builtin_amdgcn_mfma_f32_32x32x16_bf16(ke1,QE(),z_,0,0,0); } SBAR(); \
    VRD(0); SBAR(); float sacc=(P0[0]+P0[1]); \
    GAPA(C0=__builtin_amdgcn_mfma_f32_32x32x16_bf16(kf[0],qr[0],C0,0,0,0), P0[2],P0[3],P0[4],P0[5],     pw0[0]=PKW(P0,0), pw0[1]=PKW(P0,2), pw0); \
    VRD(4); SBAR(); GAPA(C1=__builtin_amdgcn_mfma_f32_32x32x16_bf16(kf[1],qr[0],C1,0,0,0), P0[6],P0[7],P0[8],P0[9],     pw0[2]=PKW(P0,4), pw0[3]=PKW(P0,6), pw0); \
    VRD(1); SBAR(); GAPA(C0=__builtin_amdgcn_mfma_f32_32x32x16_bf16(kf[2],qr[1],C0,0,0,0),   P0[10],P0[11],P0[12],P0[13], pw1[0]=PKW(P0,8), pw1[1]=PKW(P0,10), pw1); \
    VRD(5); SBAR(); GAPA(C1=__builtin_amdgcn_mfma_f32_32x32x16_bf16(kf[3],qr[1],C1,0,0,0),   P0[14],P0[15],P1[0],P1[1],   pw1[2]=PKW(P0,12),pw1[3]=PKW(P0,14), pw1); \
    VRD(2); SBAR(); GAPA(C0=__builtin_amdgcn_mfma_f32_32x32x16_bf16(kf[4],qr[2],C0,0,0,0),   P1[2],P1[3],P1[4],P1[5],     pw2[0]=PKW(P1,0), pw2[1]=PKW(P1,2), pw2); \
    VRD(6); SBAR(); GAPA(C1=__builtin_amdgcn_mfma_f32_32x32x16_bf16(kf[5],qr[2],C1,0,0,0),   P1[6],P1[7],P1[8],P1[9],     pw2[2]=PKW(P1,4), pw2[3]=PKW(P1,6), pw2); \
    VRD(3); SBAR(); GAPA(C0=__builtin_amdgcn_mfma_f32_32x32x16_bf16(kf[6],qr[3],C0,0,0,0),   P1[10],P1[11],P1[12],P1[13], pw3[0]=PKW(P1,8), pw3[1]=PKW(P1,10), pw3); \
    VRD(7); SBAR(); GAPA(C1=__builtin_amdgcn_mfma_f32_32x32x16_bf16(kf[7],qr[3],C1,0,0,0),   P1[14],P1[15],0.f,0.f,       pw3[2]=PKW(P1,12),pw3[3]=PKW(P1,14), pw3); \
    l_reg+=sacc; \
    if(GK){DMA_K((t)+3,sl_cur);DMA_E((t)+3,sl_cur);} if(GV){DMA_V((t)+1,sl_next);} \
    CMASK(C0,C1,t); \
    { float a=MX3(C0[0],C0[1],C1[0]),b=MX3(C0[2],C0[3],C1[1]); a=MX3(a,C1[2],C1[3]); \
      _Pragma("unroll") for(int r=4;r<16;r+=4){a=MX3(a,C0[r],C0[r+1]);b=MX3(b,C0[r+2],C0[r+3]);a=MX3(a,C1[r],C1[r+1]);b=MX3(b,C1[r+2],C1[r+3]);} \
      float rm=__builtin_fmaxf(a,b); { auto rr=__builtin_amdgcn_permlane32_swap(__float_as_uint(rm),__float_as_uint(rm),false,false); rm=__builtin_fmaxf(__uint_as_float(rr[0]),__uint_as_float(rr[1])); } \
      resc=false; \
      if(__builtin_expect(__any(rm>(float)THRL),0)){ const float dl=__builtin_fmaxf(rm,0.f); mhat+=dl; \
        _Pragma("unroll") for(int r=0;r<16;++r){C0[r]-=dl;C1[r]-=dl;} \
        SETQE(); \
        const float f=__builtin_amdgcn_exp2f(-dl); l_reg*=f; if(hi==0)wsf[r32]=f; resc=true; } } \
    SBAR(); \
    GAPB(o[0]=__builtin_amdgcn_mfma_f32_32x32x16_bf16(PAF(0),VFR(0),o[0],0,0,0), C0,0); \
    GAPB(o[1]=__builtin_amdgcn_mfma_f32_32x32x16_bf16(PAF(0),VFR(4),o[1],0,0,0), C0,4); \
    KRD(GL,0); GAPB(o[0]=__builtin_amdgcn_mfma_f32_32x32x16_bf16(PAF(1),VFR(1),o[0],0,0,0), C0,8); \
    KRD(GL,1); GAPB(o[1]=__builtin_amdgcn_mfma_f32_32x32x16_bf16(PAF(1),VFR(5),o[1],0,0,0), C0,12); \
    KRD(GL,2); GAPB(o[0]=__builtin_amdgcn_mfma_f32_32x32x16_bf16(PAF(2),VFR(2),o[0],0,0,0), C1,0); \
    KRD(GL,3); GAPB(o[1]=__builtin_amdgcn_mfma_f32_32x32x16_bf16(PAF(2),VFR(6),o[1],0,0,0), C1,4); \
    if(GL){ XLD(sl_next); SBAR(); } GAPB(o[0]=__builtin_amdgcn_mfma_f32_32x32x16_bf16(PAF(3),VFR(3),o[0],0,0,0), C1,8); \
    GAPB(o[1]=__builtin_amdgcn_mfma_f32_32x32x16_bf16(PAF(3),VFR(7),o[1],0,0,0), C1,12); \
    }while(0)
  int t=1;
  if(MODE==0) for(;t+5<NT;t+=2){
    STEP(pB0,pB1,pA0,pA1,t,true,true,true);     WAIT_BAR(3); RESC(); ROT();
    STEP(pA0,pA1,pB0,pB1,t+1,true,true,true);   WAIT_BAR(3); RESC(); ROT();
  }
  #define ENDW(tt) do{ if((tt)+3<NT){WAITB_A();} else if((tt)+2<NT){WAIT_BAR(1);} else {WAIT_BAR(0);} }while(0)
  for(;t+1<NT;t+=2){
    STEP(pB0,pB1,pA0,pA1,t,(t+3<NT),(t+1<NT),(t+1<NT));       ENDW(t);   RESC(); ROT();
    STEP(pA0,pA1,pB0,pB1,t+1,(t+4<NT),(t+2<NT),(t+2<NT));     ENDW(t+1); RESC(); ROT();
  }
  STEP(pB0,pB1,pA0,pA1,NT-1,false,false,false); RESC();
  { float sacc=pB0[0]+pB0[1]; _Pragma("unroll") for(int r=2;r<16;++r)sacc+=pB0[r]; _Pragma("unroll") for(int r=0;r<16;++r)sacc+=pB1[r]; l_reg+=sacc;
    pw0=(u32x4){PKW(pB0,0),PKW(pB0,2),PKW(pB0,4),PKW(pB0,6)};pw1=(u32x4){PKW(pB0,8),PKW(pB0,10),PKW(pB0,12),PKW(pB0,14)};pw2=(u32x4){PKW(pB1,0),PKW(pB1,2),PKW(pB1,4),PKW(pB1,6)};pw3=(u32x4){PKW(pB1,8),PKW(pB1,10),PKW(pB1,12),PKW(pB1,14)};
    SBAR(); pv(o,vb0+sl_cur,PAF(0),PAF(1),PAF(2),PAF(3)); }
  #undef PKW
  #undef PAF
  #undef VFR
  #undef PIN
  #undef MX3
  #undef GAPA
  #undef GAPB
  #undef EX
  #undef VRD
  #undef KRD
  #undef STEP
  #undef ENDW
  {auto rr=__builtin_amdgcn_permlane32_swap(__float_as_uint(l_reg),__float_as_uint(l_reg),false,false);l_reg=__uint_as_float(rr[0])+__uint_as_float(rr[1]);}
  if(hi==0)wsf[32+r32]=l_reg;asm volatile("s_waitcnt lgkmcnt(0)":::"memory");
  float rli[16];
  #pragma unroll
  for(int r=0;r<16;++r)rli[r]=__builtin_amdgcn_rcpf(wsf[32+crow(r,hi)]);
  bf16*Ow=O+(rowbase+q0+wid*QBLK)*DM+h*D;
  { bf16*stg=(bf16*)(shm+LDS_OST)+wid*2048;
    #pragma unroll
    for(int r=0;r<16;++r){const int orow=crow(r,hi);
      #pragma unroll
      for(int d0=0;d0<2;++d0)stg[orow*64+d0*32+r32]=__float2bfloat16(o[d0][r]*rli[r]);}
    asm volatile("s_waitcnt lgkmcnt(0)":::"memory");
    #pragma unroll
    for(int i=0;i<4;++i){const int row=i*8+(lane>>3),ch=lane&7; const u32x4 v=*(const u32x4*)(stg+row*64+ch*8); ATTN_STORE16(Ow+(long)row*DM+ch*8,v);} }
  asm volatile("s_waitcnt lgkmcnt(0)\n\ts_barrier":::"memory");
  #undef DMA_K
  #undef TILE
  #undef DMA_V
  #undef DMA_E
  #undef XLD
  #undef WAITB_A
  #undef QE
  #undef SETQE
  #undef BMASK
  #undef CMASK
  #undef START
  #undef RESC
  #undef ROT
}
constexpr int ATTN_LDS_BYTES=LDS_BYTES;
struct AttnTensors { const bf16* Q; const bf16* K; const bf16* V; bf16* O; const bf16* KX; const float* relb; };
struct AttnUnit { int bh; int qb; };
struct StaticOrder {
  int vcu;
  __device__ __forceinline__ explicit StaticOrder(int grid,int block):vcu((block%8)*(grid/8)+block/8){}
  __device__ __forceinline__ bool next(int i,AttnUnit&u)const{ if(i>=4)return false; const int s=vcu&7; u.bh=vcu>>3; u.qb=(i==0)?s:(i==1)?15-s:(i==2)?16+s:31-s; return true; }
  __device__ __forceinline__ bool next_band(int i,AttnUnit&u)const{ if(i>=4)return false; u.bh=vcu>>3; u.qb=(vcu&7)+8*i; return true; }
  __device__ __forceinline__ void a_ready(const AttnUnit&)const{}
  __device__ __forceinline__ void done(const AttnUnit&)const{}
};
template<int MODE,class Sched,int THRL=8> __device__ __forceinline__ void attn_phase(char*lds,const AttnTensors&T,const Sched&S){
  AttnUnit u;
  for(int i=0;(MODE==0?S.next(i,u):S.next_band(i,u));++i){ attn_unit<MODE,THRL>(u.bh/NHEAD,u.bh%NHEAD,u.qb,T.Q,T.K,T.V,T.O,lds,T.KX,T.relb+(MODE==1?(u.bh%NHEAD)*257:0)); }
}
#undef SBAR
#undef WAIT_BAR
}
namespace cg = cooperative_groups;
constexpr int NWAVES = 8;
#ifndef MK_PER_PHASE
#define MK_PER_PHASE 0
#endif
constexpr int N_PHASES = 12;
constexpr int MP = 16384, MS = 512, MT = MP + MS, DMODEL = 1024, DFF = 2816, NH = 16, SEQL = 8192;
constexpr int PAST = 1024, BPAST = 512, DECB = 32, DECT = 16;
constexpr size_t O_YP = 0, O_YS = 16777216, O_AKP = 17301504, O_AVP = 34078720, O_ALFP = 50855936, O_BKP = 51118080, O_BVP = 52166656,
                 O_AKS = 53215232, O_AVS = 53739520, O_ALFS = 54263808, O_BKS = 54272000, O_BVS = 71049216, O_END = 87826432;
constexpr size_t MiB = 1u << 20;
constexpr size_t WS_WQKV0 = 2 * MiB, WS_WO0 = 8 * MiB, WS_WGU0 = 10 * MiB, WS_WD0 = 21 * MiB, WS_WKVQ = 27 * MiB, WS_WO1 = 33 * MiB, WS_WGU1 = 35 * MiB, WS_WD1 = 46 * MiB;
constexpr size_t WS_SSP = 52 * MiB, SSP_STRIDE = 2 * MiB;
constexpr size_t WS_GS = 62 * MiB;
constexpr size_t WS_KX = 64 * MiB;
constexpr size_t WS_QO = 72 * MiB, WS_KB = 105 * MiB, WS_VB = 138 * MiB, WS_HB = 171 * MiB, WS_ACT = 204 * MiB, WS_END = 296 * MiB;
static_assert(WS_ACT + (size_t)MT * DFF * 2 <= WS_END && WS_QO + (size_t)MT * DMODEL * 2 <= WS_KB, "d_ws map");
constexpr int RING_BYTES = 131072, LDS_BYTES = 147456;
static_assert(attn_body::ATTN_LDS_BYTES <= RING_BYTES, "attention LDS");

#define GAS __attribute__((address_space(1)))
#define LAS __attribute__((address_space(3)))
typedef unsigned short bf16;
typedef unsigned v4u __attribute__((ext_vector_type(4)));
typedef float f32x4 __attribute__((ext_vector_type(4)));
typedef short bf16x8 __attribute__((ext_vector_type(8)));
#define LDS_WAIT() asm volatile("s_waitcnt lgkmcnt(0)" ::: "memory")
__device__ __forceinline__ unsigned f2bf(float f) { unsigned u = __builtin_bit_cast(unsigned, f); return (u + 0x7fffu + ((u >> 16) & 1u)) >> 16; }
__device__ __forceinline__ unsigned pk2(float lo, float hi) { return f2bf(lo) | (f2bf(hi) << 16); }
__device__ __forceinline__ float bf2f(unsigned short b) { return __uint_as_float((unsigned)b << 16); }

__device__ __forceinline__ void p0_transpose_item(const float* W, int ldw, int csrc, int k0, const float* gain, bf16* WT, int K, int drow, LAS float* scr, int lane) {
    float wv[32]; const float gl = gain ? gain[k0 + lane] : 1.f;
#pragma unroll
    for (int i = 0; i < 32; ++i) wv[i] = W[(size_t)(k0 + 2 * i + (lane >> 5)) * ldw + csrc + (lane & 31)];
#pragma unroll
    for (int i = 0; i < 32; ++i) { const int kk = 2 * i + (lane >> 5); scr[kk * 33 + (lane & 31)] = wv[i] * __shfl(gl, kk); }
    LDS_WAIT(); asm volatile("" ::: "memory");
    const int c = lane & 7;
#pragma unroll
    for (int j = 0; j < 4; ++j) { const int n = (lane >> 3) + 8 * j; const LAS float* s = scr + (8 * c) * 33 + n;
        v4u o; o.x = pk2(s[0 * 33], s[1 * 33]); o.y = pk2(s[2 * 33], s[3 * 33]); o.z = pk2(s[4 * 33], s[5 * 33]); o.w = pk2(s[6 * 33], s[7 * 33]);
        *(v4u*)(WT + (size_t)(drow + n) * K + k0 + 8 * c) = o; }
    LDS_WAIT(); asm volatile("" ::: "memory");
}
struct KArgs { const float* in[20]; float* out; unsigned char* ws; int ph_lo, ph_hi; };

__device__ __forceinline__ void p0_weight_item(const KArgs& a, int it, LAS float* scr, int lane) {
    unsigned char* ws = a.ws;
    constexpr int I_QKV = 16 * 96, I_O = 16 * 32, I_GU = 16 * 176, I_D = 44 * 32, I_Q1 = 16 * 32, I_KV = 16 * 64;
    const float* W; int ldw, ncols, K, roff = 0; const float* gain = nullptr; bf16* dst; bool perm = false;
    int r = it;
    if (r < I_QKV) { W = a.in[8]; ldw = 3088; ncols = 3072; K = 1024; gain = a.in[7]; dst = (bf16*)(ws + WS_WQKV0); }
    else if ((r -= I_QKV) < I_O) { W = a.in[10]; ldw = 1024; ncols = 1024; K = 1024; dst = (bf16*)(ws + WS_WO0); }
    else if ((r -= I_O) < I_GU) { W = a.in[17]; ldw = 5632; ncols = 5632; K = 1024; gain = a.in[16]; dst = (bf16*)(ws + WS_WGU0); perm = true; }
    else if ((r -= I_GU) < I_D) { W = a.in[18]; ldw = 1024; ncols = 1024; K = 2816; dst = (bf16*)(ws + WS_WD0); }
    else if ((r -= I_D) < I_Q1) { W = a.in[11]; ldw = 1024; ncols = 1024; K = 1024; gain = a.in[7] + 1024; dst = (bf16*)(ws + WS_WKVQ); }
    else if ((r -= I_Q1) < I_KV) { W = a.in[15]; ldw = 2048; ncols = 2048; K = 1024; gain = a.in[14]; dst = (bf16*)(ws + WS_WKVQ); roff = 1024; }
    else if ((r -= I_KV) < I_O) { W = a.in[13]; ldw = 1024; ncols = 1024; K = 1024; dst = (bf16*)(ws + WS_WO1); }
    else if ((r -= I_O) < I_GU) { W = a.in[17] + (size_t)1024 * 5632; ldw = 5632; ncols = 5632; K = 1024; gain = a.in[16] + 1024; dst = (bf16*)(ws + WS_WGU1); perm = true; }
    else { r -= I_GU; W = a.in[18] + (size_t)2816 * 1024; ldw = 1024; ncols = 1024; K = 2816; dst = (bf16*)(ws + WS_WD1); }
    const int nblk = ncols / 32, kb = r / nblk, nb = r % nblk, n0 = 32 * nb;
    int drow = roff + n0;
    if (perm) { drow = n0 < 2816 ? 256 * (n0 / 128) + (n0 % 128) : 256 * ((n0 - 2816) / 128) + 128 + ((n0 - 2816) % 128); }
    p0_transpose_item(W, ldw, n0, 64 * kb, gain, dst, K, drow, scr, lane);
}
constexpr int P0_FIRST = 16 * 96, P0_SECOND = P0_FIRST + 16 * 32 + 16 * 176 + 44 * 32 + 16 * 32 + 16 * 64;
constexpr int P0_NITEMS = 16 * 96 + 16 * 32 + 16 * 176 + 44 * 32 + 16 * 32 + 16 * 64 + 16 * 32 + 16 * 176 + 44 * 32;

__device__ __forceinline__ void p0_row_group(const KArgs& a, int g, const LAS unsigned char* wf, int lane) {
    const int fr = lane & 15, fq = lane >> 4;
    const int row = g * 16 + fr;
    const float* xr = (g < 1024 ? a.in[0] + (size_t)row * 1024 : a.in[1] + (size_t)(row - MP) * 1024) + 8 * fq;
    bf16* hb = (bf16*)(a.ws + WS_HB) + (size_t)row * 1024 + 8 * fq;
    f32x4 acc = {0.f, 0.f, 0.f, 0.f}; float ss = 0.f;
#pragma unroll 4
    for (int ks = 0; ks < 32; ++ks) {
        const f32x4 x0 = *(const f32x4*)(xr + 32 * ks), x1 = *(const f32x4*)(xr + 32 * ks + 4);
        ss += (x0[0] * x0[0] + x0[1] * x0[1]) + (x0[2] * x0[2] + x0[3] * x0[3]) + (x1[0] * x1[0] + x1[1] * x1[1]) + (x1[2] * x1[2] + x1[3] * x1[3]);
        v4u w; w.x = pk2(x0[0], x0[1]); w.y = pk2(x0[2], x0[3]); w.z = pk2(x1[0], x1[1]); w.w = pk2(x1[2], x1[3]);
        *(v4u*)(hb + 32 * ks) = w;
        const bf16x8 bfrag = *(const LAS bf16x8*)(wf + (ks * 64 + lane) * 16);
        acc = __builtin_amdgcn_mfma_f32_16x16x32_bf16(bfrag, __builtin_bit_cast(bf16x8, w), acc, 0, 0, 0);
    }
    ss += __shfl_xor(ss, 16); ss += __shfl_xor(ss, 32);
    float* ssp = (float*)(a.ws + WS_SSP) + (size_t)row * 16 + 4 * fq;
    *(f32x4*)ssp = (f32x4){fq == 0 ? ss : 0.f, 0.f, 0.f, 0.f};
    const float rstd = 1.0f / sqrtf(ss * (1.0f / 1024.0f) + 1e-6f);
    const f32x4 bf = *(const f32x4*)(a.in[9] + 4 * fq);
    f32x4 lf;
#pragma unroll
    for (int e = 0; e < 4; ++e) { const float z = acc[e] * rstd + bf[e]; lf[e] = fminf(z, 0.f) - log1pf(expf(-fabsf(z))); }
    float* lo = (g < 1024 ? a.out + O_ALFP + (size_t)row * 16 : a.out + O_ALFS + (size_t)(row - MP) * 16) + 4 * fq;
    *(f32x4*)lo = lf;
    if (g < 1024) {
#pragma unroll
        for (int o = 1; o < 16; o <<= 1) { lf[0] += __shfl_xor(lf[0], o); lf[1] += __shfl_xor(lf[1], o); lf[2] += __shfl_xor(lf[2], o); lf[3] += __shfl_xor(lf[3], o); }
        if (fr == 0) *(f32x4*)((float*)(a.ws + WS_GS) + g * 16 + 4 * fq) = lf;
    }
}

__device__ __forceinline__ void p1_scan(const KArgs& a, int v, LAS float* red, int tid) {
    const int batch = v >> 7, g0 = batch * 512, g1 = 4 * v, h = tid & 15, part = tid >> 4;
    const float* gs = (const float*)(a.ws + WS_GS);
    float s = 0.f;
    for (int g = g0 + part; g < g1; g += 32) s += gs[g * 16 + h];
    red[part * 16 + h] = s;
    __syncthreads();
    LAS float* lfs = red + 512;
    for (int e = tid; e < 1024; e += 512) lfs[e] = a.out[O_ALFP + (size_t)(64 * v) * 16 + e];
    __syncthreads();
    if (tid < 16) {
        float cum = 0.f;
        for (int p = 0; p < 32; ++p) cum += red[p * 16 + tid];
        bf16* kx = (bf16*)(a.ws + WS_KX) + ((size_t)(batch * 16 + tid) * 2 * SEQL) * 8;
        const int t0 = (64 * v) & (SEQL - 1);
#pragma unroll 8
        for (int r = 0; r < 64; ++r) {
            cum += lfs[r * 16 + tid];
            const float c = -cum * 1.4426950408889634f;
            const unsigned c1 = f2bf(c); const float r1 = c - bf2f((unsigned short)c1);
            const unsigned c2 = f2bf(r1); const float r2 = r1 - bf2f((unsigned short)c2);
            const unsigned c3 = f2bf(r2);
            *(v4u*)(kx + (size_t)(t0 + r) * 8) = (v4u){c1 | (c2 << 16), c3 | 0x3F800000u, 0x3F803F80u, 0u};
            *(v4u*)(kx + (size_t)(SEQL + t0 + r) * 8) = (v4u){0u, 0u, 0u, 0u};
        }
    }
    __syncthreads();
}

typedef float sf32x4 __attribute__((ext_vector_type(4)));
__device__ __forceinline__ bf16x8 pack8(const sf32x4 a, const sf32x4 b) {
    v4u w; w.x = attn_body::cvtpk_s(a[0], a[1]); w.y = attn_body::cvtpk_s(a[2], a[3]); w.z = attn_body::cvtpk_s(b[0], b[1]); w.w = attn_body::cvtpk_s(b[2], b[3]); return __builtin_bit_cast(bf16x8, w); }
template <int MODE> __device__ __forceinline__ void sample_attn(const KArgs& a, int b, int h, LAS unsigned char* lds, int tid) {
    constexpr int NC = MODE == 0 ? PAST : BPAST, NK = NC + 16, NKP = 1056, VRS = 80;
    constexpr float L2E = 1.4426950408889634f;
    LAS float* S = (LAS float*)lds;
    LAS float* bias = S + 16 * NKP;
    LAS float* rl = bias + NKP;
    LAS unsigned char* VT = (LAS unsigned char*)(rl + 16);
    const int lane = tid & 63, wid = __builtin_amdgcn_readfirstlane(tid >> 6), fr = lane & 15, fq = lane >> 4;
    const float* ck = a.in[MODE == 0 ? 2 : 5]; const float* cv = a.in[MODE == 0 ? 3 : 6];
    const float* nk = a.out + (MODE == 0 ? O_AKS + (size_t)(b * 16) * 1024 : O_BKS + (size_t)(b * 512 + 496) * 1024) + h * 64;
    const float* nv = a.out + (MODE == 0 ? O_AVS + (size_t)(b * 16) * 1024 : O_BVS + (size_t)(b * 512 + 496) * 1024) + h * 64;
    const bf16* qo = (const bf16*)(a.ws + WS_QO) + (size_t)(MP + b * 16) * 1024 + h * 64;
    const bf16x8 qf0 = *(const bf16x8*)(qo + (size_t)fr * 1024 + 8 * fq), qf1 = *(const bf16x8*)(qo + (size_t)fr * 1024 + 32 + 8 * fq);
    if (MODE == 0) {
        for (int j = tid; j < NK; j += 512) bias[j] = j < NC ? a.in[4][((size_t)b * NC + j) * 16 + h] : a.out[O_ALFS + (size_t)(b * 16 + (j - NC)) * 16 + h];
    } else {
        if (tid < 257) bias[tid] = a.in[12][h * 257 + tid] * L2E;
    }
    __syncthreads();
    if (MODE == 0) {
        if (wid == 0) { float carry = 0.f;
            for (int c = 0; c < (NK + 63) / 64; ++c) { const int j = 64 * c + lane; float v = j < NK ? bias[j] : 0.f;
#pragma unroll
                for (int o = 1; o < 64; o <<= 1) { const float t = __shfl_up(v, o); if (lane >= o) v += t; }
                v += carry; carry = __shfl(v, 63); if (j < NK) bias[j] = -v * L2E; } }
        __syncthreads();
    }
#pragma unroll 2
    for (int blk = wid; blk < NK / 16; blk += 8) {
        const int j0 = 16 * blk; const bool isnew = j0 >= NC;
        const float* kr = (isnew ? nk + (size_t)(j0 - NC + fr) * 1024 : ck + (((size_t)b * NC + j0 + fr) * 16 + h) * 64) + 8 * fq;
        const sf32x4 x0 = *(const sf32x4*)kr, x1 = *(const sf32x4*)(kr + 4), x2 = *(const sf32x4*)(kr + 32), x3 = *(const sf32x4*)(kr + 36);
        if (MODE == 1 && !isnew && j0 >= 16) { float* ok = a.out + O_BKS + (((size_t)b * 512 + (j0 + fr - 16)) * 16 + h) * 64 + 8 * fq;
            *(sf32x4*)ok = x0; *(sf32x4*)(ok + 4) = x1; *(sf32x4*)(ok + 32) = x2; *(sf32x4*)(ok + 36) = x3; }
        sf32x4 acc = {0.f, 0.f, 0.f, 0.f};
        acc = __builtin_amdgcn_mfma_f32_16x16x32_bf16(pack8(x0, x1), qf0, acc, 0, 0, 0);
        acc = __builtin_amdgcn_mfma_f32_16x16x32_bf16(pack8(x2, x3), qf1, acc, 0, 0, 0);
        if (MODE == 0) { const sf32x4 bv = *(const LAS sf32x4*)(bias + j0 + 4 * fq); acc = acc + bv;
            if (isnew) {
#pragma unroll
                for (int e = 0; e < 4; ++e) if (4 * fq + e > fr) acc[e] = -INFINITY; } }
        else {
#pragma unroll
            for (int e = 0; e < 4; ++e) { const int d = 512 + fr - (j0 + 4 * fq + e); acc[e] += bias[(d < 128 ? d : 128) + 128]; } }
        *(LAS sf32x4*)(S + fr * NKP + j0 + 4 * fq) = acc;
    }
    __syncthreads();
    for (int q = 2 * wid; q < 2 * wid + 2; ++q) { float m = -INFINITY;
        for (int j = lane; j < NK; j += 64) m = fmaxf(m, S[q * NKP + j]);
#pragma unroll
        for (int o = 1; o < 64; o <<= 1) m = fmaxf(m, __shfl_xor(m, o));
        float l = 0.f;
        for (int j = lane; j < NK; j += 64) { const float p = __builtin_amdgcn_exp2f(S[q * NKP + j] - m); S[q * NKP + j] = p; l += p; }
#pragma unroll
        for (int o = 1; o < 64; o <<= 1) l += __shfl_xor(l, o);
        if (lane == 0) rl[q] = 1.0f / l; }
    __syncthreads();
    { LAS unsigned char* vt = VT + wid * (64 * VRS);
        sf32x4 o[4];
#pragma unroll
        for (int db = 0; db < 4; ++db) o[db] = (sf32x4){0.f, 0.f, 0.f, 0.f};
        const int kr = lane >> 4, d4 = lane & 15;
        const int nit = NC / 256 + (wid == 7 ? 1 : 0);
        for (int it = 0; it < nit; ++it) {
            const bool isnew = it == NC / 256; const int c = isnew ? NC / 32 : wid + 8 * it;
            const int j0 = 32 * c; sf32x4 v4[8];
#pragma unroll
            for (int i = 0; i < 8; ++i) { const int key = 8 * (i >> 1) + 2 * kr + (i & 1);
                if (isnew) v4[i] = key < 16 ? *(const sf32x4*)(nv + (size_t)key * 1024 + 4 * d4) : (sf32x4){0.f, 0.f, 0.f, 0.f};
                else v4[i] = *(const sf32x4*)(cv + (((size_t)b * NC + j0 + key) * 16 + h) * 64 + 4 * d4); }
            if (MODE == 1 && !isnew) {
#pragma unroll
                for (int i = 0; i < 8; ++i) { const int j = j0 + 8 * (i >> 1) + 2 * kr + (i & 1); if (j >= 16) *(sf32x4*)(a.out + O_BVS + (((size_t)b * 512 + (j - 16)) * 16 + h) * 64 + 4 * d4) = v4[i]; } }
#pragma unroll
            for (int i = 0; i < 8; i += 2)
#pragma unroll
                for (int e = 0; e < 4; ++e) *(LAS unsigned*)(vt + (4 * d4 + e) * VRS + (8 * (i >> 1) + 2 * kr) * 2) = attn_body::cvtpk_s(v4[i][e], v4[i + 1][e]);
            bf16x8 pf;
            if (isnew && fq >= 2) pf = (bf16x8){0, 0, 0, 0, 0, 0, 0, 0};
            else { const sf32x4 p0 = *(const LAS sf32x4*)(S + fr * NKP + j0 + 8 * fq), p1 = *(const LAS sf32x4*)(S + fr * NKP + j0 + 8 * fq + 4); pf = pack8(p0, p1); }
#pragma unroll
            for (int db = 0; db < 4; ++db) { const bf16x8 vf = *(const LAS bf16x8*)(vt + (16 * db + fr) * VRS + fq * 16);
                o[db] = __builtin_amdgcn_mfma_f32_16x16x32_bf16(pf, vf, o[db], 0, 0, 0); }
        }
        LAS float* op = (LAS float*)vt;
#pragma unroll
        for (int db = 0; db < 4; ++db)
#pragma unroll
            for (int e = 0; e < 4; ++e) op[(4 * fq + e) * 64 + 16 * db + fr] = o[db][e]; }
    __syncthreads();
    for (int e = tid; e < 1024; e += 512) { const int q = e >> 6, d = e & 63; float o = 0.f;
#pragma unroll
        for (int w = 0; w < 8; ++w) o += ((const LAS float*)(VT + w * (64 * VRS)))[q * 64 + d];
        ((bf16*)(a.ws + WS_QO))[(size_t)(MP + b * 16 + q) * 1024 + h * 64 + d] = (bf16)f2bf(o * rl[q]); }
    __syncthreads();
}

#define RLX_AGENT __ATOMIC_RELAXED, __HIP_MEMORY_SCOPE_AGENT
#define XB_TMO      128
#define XB_XCNT(j)  (256  + 64 * (j))
#define XB_XSUB(j)  (1280 + 64 * (j))
#define XB_XGEN(j)  (2304 + 64 * (j))
#define XB_TOP      3328
#define XB_TOPGEN   3392
#define XCD_BAR_WORDS 3456
#define XB_SPIN_CAP (1u << 18)

__device__ __forceinline__ unsigned xb_ld(unsigned* p)              { return __hip_atomic_load(p, __ATOMIC_RELAXED, __HIP_MEMORY_SCOPE_AGENT); }
__device__ __forceinline__ unsigned xb_add(unsigned* p, unsigned v) { return __hip_atomic_fetch_add(p, v, __ATOMIC_RELAXED, __HIP_MEMORY_SCOPE_AGENT); }
__device__ __forceinline__ unsigned xb_xcc_id() { return (unsigned)__builtin_amdgcn_s_getreg((3 << 11) | 20) & 0xFu; }
#define XB_SPIN(cond, bar) do { unsigned _sp = 0; while (cond) { __builtin_amdgcn_s_sleep(1); \
    if ((++_sp & 255u) == 0u) { if (xb_ld(&(bar)[XB_TMO])) break; if (_sp > XB_SPIN_CAP) { atomicAdd(&(bar)[XB_TMO], 1u); break; } } } } while (0)

struct XcdBarrier {
    unsigned* bar; unsigned x;
    volatile LAS unsigned* st;
};

__device__ __forceinline__ XcdBarrier xcd_barrier_post(unsigned* bar, volatile LAS unsigned* st) {
    XcdBarrier b; b.bar = bar; b.x = xb_xcc_id(); b.st = st;
    if (threadIdx.x == 0) (void)xb_add(&bar[XB_XCNT(b.x)], 1u);
    return b;
}
__device__ __forceinline__ void xcd_barrier_complete(unsigned* bar, unsigned x, unsigned& nloc, unsigned& nx) {
    const unsigned G = gridDim.x * gridDim.y * gridDim.z;
    unsigned sum, cnt, mine, sp = 0u;
    for (;;) {
        sum = 0u; cnt = 0u; mine = 0u;
#pragma unroll
        for (unsigned j = 0; j < 16; ++j) { const unsigned c = xb_ld(&bar[XB_XCNT(j)]); sum += c; cnt += (c > 0u) ? 1u : 0u; mine = (j == x) ? c : mine; }
        if (sum == G) break;
        __builtin_amdgcn_s_sleep(1);
        if ((++sp & 255u) == 0u) { if (xb_ld(&bar[XB_TMO])) break; if (sp > XB_SPIN_CAP) { atomicAdd(&bar[XB_TMO], 1u); break; } }
    }
    nloc = mine > 0u ? mine : 1u; nx = cnt > 0u ? cnt : 1u;
}

__device__ __forceinline__ void xcd_barrier(const XcdBarrier& b) {
    asm volatile("s_waitcnt vmcnt(0)" ::: "memory");
    __syncthreads();
    if (threadIdx.x == 0) {
        unsigned* bar = b.bar;
        __builtin_amdgcn_s_waitcnt(0);
        unsigned nloc = b.st[0], nx = b.st[1];
        if (nloc == 0u) { xcd_barrier_complete(bar, b.x, nloc, nx); b.st[0] = nloc; b.st[1] = nx; }
        const unsigned old = xb_add(&bar[XB_XSUB(b.x)], 1u);
        const unsigned gen = old / nloc;
        if (old + 1u == (gen + 1u) * nloc) {
            __builtin_amdgcn_fence(__ATOMIC_RELEASE, "agent");
            asm volatile("s_waitcnt vmcnt(0)" ::: "memory");
            const unsigned og = xb_add(&bar[XB_TOP], 1u);
            const unsigned tg = og / nx;
            if (og + 1u == (tg + 1u) * nx) xb_add(&bar[XB_TOPGEN], 1u);
            else XB_SPIN(xb_ld(&bar[XB_TOPGEN]) == tg, bar);
            __builtin_amdgcn_fence(__ATOMIC_ACQUIRE, "agent");
            xb_add(&bar[XB_XGEN(b.x)], 1u);
            asm volatile("s_waitcnt vmcnt(0)" ::: "memory");
        } else {
            XB_SPIN(xb_ld(&bar[XB_XGEN(b.x)]) == gen, bar);
            __builtin_amdgcn_fence(__ATOMIC_ACQUIRE, "agent");
            asm volatile("s_waitcnt vmcnt(0)" ::: "memory");
        }
    }
    __syncthreads();
}

__device__ __forceinline__ KArgs load_args() {
#if !defined(__HIP_DEVICE_COMPILE__)
    return KArgs{};
#else
    auto p = __builtin_amdgcn_kernarg_segment_ptr(); asm volatile("" : "+s"(p)); return *(const __attribute__((address_space(4))) KArgs*)p;
#endif
}
__global__ void __launch_bounds__(NWAVES * 64, 2) fwd_mega(KArgs args_unused) {
    extern __shared__ __attribute__((aligned(16))) unsigned char lds[];
    LAS unsigned char* L = (LAS unsigned char*)lds;
    const int G = gridDim.x, bx = blockIdx.x, vcu = (G % 8 == 0) ? (bx % 8) * (G / 8) + bx / 8 : bx;
    int lo, hi; XcdBarrier xbar;
    { const KArgs a0 = load_args(); lo = a0.ph_lo; hi = a0.ph_hi;
      volatile LAS unsigned* st = (volatile LAS unsigned*)(L + RING_BYTES + 1024); if (threadIdx.x < 32) st[threadIdx.x] = 0u; __syncthreads();
      xbar = xcd_barrier_post((unsigned*)a0.ws + 4096, st); }
    if (hi > N_PHASES) cg::this_grid().sync();
#ifndef PHMASK
#define PHMASK 0xfff
#endif
#define IN(k) (((PHMASK >> (k)) & 1) && lo <= (k) && (k) < hi)
#define SEAM(k) do { if (IN(k) && IN((k) + 1)) { xcd_barrier(xbar); if ((PROBE_MASK >> 14) & 1) xcd_barrier(xbar); } } while (0)
#ifndef PROBE_MASK
#define PROBE_MASK 0
#endif
#define SEG_BEGIN(k) unsigned long long seg_t0_ = 0; if ((PROBE_MASK >> (k)) & 1) seg_t0_ = __builtin_amdgcn_s_memrealtime()
#define SEG_END(k) do { if ((PROBE_MASK >> (k)) & 1) { const unsigned long long t1_ = __builtin_amdgcn_s_memrealtime(), d_ = t1_ - seg_t0_; while (__builtin_amdgcn_s_memrealtime() - t1_ < d_) __builtin_amdgcn_s_sleep(8); } } while (0)
#define PHASE_ARGS() int tid = threadIdx.x; asm volatile("" : "+v"(tid)); const int lane = tid & 63, wave = __builtin_amdgcn_readfirstlane(tid >> 6); (void)lane; (void)wave; const KArgs args = load_args(); unsigned char* ws = args.ws; float* out = args.out; (void)out; \
    bf16* QO = (bf16*)(ws + WS_QO); bf16* KB = (bf16*)(ws + WS_KB); bf16* VB = (bf16*)(ws + WS_VB); bf16* HB = (bf16*)(ws + WS_HB); bf16* ACT = (bf16*)(ws + WS_ACT); (void)QO; (void)KB; (void)VB; (void)HB; (void)ACT
#define SSPN(i) ((float*)(ws + WS_SSP + (size_t)(i) * SSP_STRIDE))
#define SOFT_P(s_) ((unsigned*)ws + 8192 + 2048 * (s_))
#define SOFT_S(s_) ((unsigned*)ws + 8192 + 2048 * (s_) + 1088)
#define STW ((volatile LAS unsigned*)(L + RING_BYTES + 1024))
#define LARR ((LAS unsigned*)(L + RING_BYTES + 1024 + 64))

    if (IN(0)) {
        PHASE_ARGS();
        SEG_BEGIN(0);
        LAS unsigned char* wf = L + 98304;
        for (int e = tid; e < 32 * 64; e += NWAVES * 64) { const int ks = e >> 6, ln = e & 63, h = ln & 15, kq = ln >> 4, k0 = 32 * ks + 8 * kq; float v[8];
#pragma unroll
            for (int i = 0; i < 8; ++i) v[i] = args.in[8][(size_t)(k0 + i) * 3088 + 3072 + h] * args.in[7][k0 + i];
            *(LAS v4u*)(wf + e * 16) = (v4u){pk2(v[0], v[1]), pk2(v[2], v[3]), pk2(v[4], v[5]), pk2(v[6], v[7])}; }
        __syncthreads();
        { const int g = wave * G + vcu; if (g < MT / 16) p0_row_group(args, g, wf, lane); }
        LAS float* scr = (LAS float*)(L + wave * 8704);
        const int gw = vcu * NWAVES + wave, NGW = G * NWAVES;
        for (int it = gw; it < P0_FIRST; it += NGW) p0_weight_item(args, it, scr, lane);
        SEG_END(0);
    }
    SEAM(0);
    if (IN(1)) {
        PHASE_ARGS();
        SEG_BEGIN(1);
        p1_scan(args, vcu, (LAS float*)L, tid);
        pg8::Gemm g{HB, (const bf16*)(ws + WS_WQKV0), MT, 3072, 1024}; pg8::StaticOrder S; S.init(MT, 3072, G, bx);
        pg8::EpiQKV E{QO, KB, VB, out + O_AKP, out + O_AVP, out + O_AKS, out + O_AVS, SSPN(0), 0, attn_body::C2};
        pg8::gemm_phase<pg8::EpiQKV, pg8::StaticOrder, PG8_ALIGN, PG8_SP2>(L, g, S, E);
        { const int n4 = (MT / 256) * 12 - 3 * G;
          if (n4 >= 0 && n4 < G && bx >= n4) { LAS float* scr = (LAS float*)(L + wave * 8704); const int cw = (bx - n4) * NWAVES + wave, ncw = (G - n4) * NWAVES;
              for (int it = P0_FIRST + cw; it < P0_SECOND; it += ncw) p0_weight_item(args, it, scr, lane); } }
        SEG_END(1);
    }
    SEAM(1);
    if (IN(2)) {
        PHASE_ARGS();
        SEG_BEGIN(2);
        { SEG_BEGIN(12); for (int i = 0; i < 2; ++i) { const int u = 2 * vcu + i; if (u < DECB * NH) sample_attn<0>(args, u >> 4, u & 15, L, tid); } SEG_END(12); }
        const attn_body::AttnTensors AT{(const attn_body::bf16*)QO, (const attn_body::bf16*)KB, (const attn_body::bf16*)VB, (attn_body::bf16*)QO, (const attn_body::bf16*)(ws + WS_KX), args.in[12]};
        const attn_body::StaticOrder S(G, bx);
        attn_body::attn_phase<0, attn_body::StaticOrder>((char*)lds, AT, S);
        SEG_END(2);
    }
    SEAM(2);
    if (IN(3)) {
        PHASE_ARGS();
        SEG_BEGIN(3);
        pg8::Gemm g{QO, (const bf16*)(ws + WS_WO0), MT, 1024, 1024}; pg8::FlexOrder S; S.init(4, G, bx, 0, 0); S.arrP = SOFT_P(0); S.arrS = SOFT_S(0); S.larr = LARR; S.stw = STW;
        pg8::EpiRes E{args.in[0], args.in[1], out, HB, SSPN(1)};
        pg8::gemm_phase<pg8::EpiRes, pg8::FlexOrder, PG8_ALIGN, PG8_SP2>(L, g, S, E);
        SEG_END(3);
    }
    if (IN(4)) {
        PHASE_ARGS();
        SEG_BEGIN(4);
        pg8::Gemm g{HB, (const bf16*)(ws + WS_WGU0), MT, 5632, 1024}; pg8::FlexOrder S; S.init(22, G, bx, 0, 0, 176);     S.waitP = SOFT_P(0) + 1024; S.waitS = SOFT_S(0); S.tgtP = STW[1]; S.tgtS = 8u;
        pg8::EpiSwiGLU E{ACT, SSPN(1)};
        pg8::gemm_phase<pg8::EpiSwiGLU, pg8::FlexOrder, PG8_ALIGN, PG8_SP2>(L, g, S, E);
        SEG_END(4);
    }
    SEAM(4);
    if (IN(5)) {
        PHASE_ARGS();
        SEG_BEGIN(5);
        pg8::Gemm g{ACT, (const bf16*)(ws + WS_WD0), MT, 1024, 2816}; pg8::FlexOrder S; S.init(4, G, bx, 0, 0); S.arrP = SOFT_P(1); S.arrS = SOFT_S(1); S.larr = LARR; S.stw = STW;
        pg8::EpiRes E{out, out + (size_t)MP * 1024, out, HB, SSPN(2)};
        pg8::gemm_phase<pg8::EpiRes, pg8::FlexOrder, PG8_ALIGN, PG8_SP2>(L, g, S, E);
        SEG_END(5);
    }
    if (IN(6)) {
        PHASE_ARGS();
        SEG_BEGIN(6);
        pg8::Gemm g{HB, (const bf16*)(ws + WS_WKVQ), MT, 3072, 1024}; pg8::FlexOrder S; S.init(12, G, bx, 8, 1); S.waitP = SOFT_P(1) + 1024; S.waitS = SOFT_S(1); S.tgtP = STW[1]; S.tgtS = 8u;
        pg8::EpiQKV E{QO, KB, VB, out + O_BKP, out + O_BVP, out + O_BKS, out + O_BVS, SSPN(2), 1, attn_body::C2};
        pg8::gemm_phase<pg8::EpiQKV, pg8::FlexOrder, PG8_ALIGN, PG8_SP2>(L, g, S, E);
        { const int n4 = 8 + (784 - 3 * (G - 8));
          if (n4 >= 0 && n4 < G && bx >= n4) { LAS float* scr = (LAS float*)(L + wave * 8704); const int cw = (bx - n4) * NWAVES + wave, ncw = (G - n4) * NWAVES;
              for (int it = P0_SECOND + cw; it < P0_NITEMS; it += ncw) p0_weight_item(args, it, scr, lane); } }
        SEG_END(6);
    }
    SEAM(6);
    if (IN(7)) {
        PHASE_ARGS();
        SEG_BEGIN(7);
        { SEG_BEGIN(13); for (int i = 0; i < 2; ++i) { const int u = 2 * vcu + i; if (u < DECB * NH) sample_attn<1>(args, u >> 4, u & 15, L, tid); } SEG_END(13); }
        const attn_body::AttnTensors AT{(const attn_body::bf16*)QO, (const attn_body::bf16*)KB, (const attn_body::bf16*)VB, (attn_body::bf16*)QO, (const attn_body::bf16*)(ws + WS_KX), args.in[12]};
        const attn_body::StaticOrder S(G, bx);
        attn_body::attn_phase<1, attn_body::StaticOrder>((char*)lds, AT, S);
        SEG_END(7);
    }
    SEAM(7);
    if (IN(8)) {
        PHASE_ARGS();
        SEG_BEGIN(8);
        pg8::Gemm g{QO, (const bf16*)(ws + WS_WO1), MT, 1024, 1024}; pg8::FlexOrder S; S.init(4, G, bx, 0, 0); S.arrP = SOFT_P(2); S.arrS = SOFT_S(2); S.larr = LARR; S.stw = STW;
        pg8::EpiRes E{out, out + (size_t)MP * 1024, out, HB, SSPN(3)};
        pg8::gemm_phase<pg8::EpiRes, pg8::FlexOrder, PG8_ALIGN, PG8_SP2>(L, g, S, E);
        SEG_END(8);
    }
    if (IN(9)) {
        PHASE_ARGS();
        SEG_BEGIN(9);
        pg8::Gemm g{HB, (const bf16*)(ws + WS_WGU1), MT, 5632, 1024}; pg8::FlexOrder S; S.init(22, G, bx, 0, 0, 176);     S.waitP = SOFT_P(2) + 1024; S.waitS = SOFT_S(2); S.tgtP = STW[1]; S.tgtS = 8u;
        pg8::EpiSwiGLU E{ACT, SSPN(3)};
        pg8::gemm_phase<pg8::EpiSwiGLU, pg8::FlexOrder, PG8_ALIGN, PG8_SP2>(L, g, S, E);
        SEG_END(9);
    }
    SEAM(9);
    if (IN(10)) {
        PHASE_ARGS();
        SEG_BEGIN(10);
        pg8::Gemm g{ACT, (const bf16*)(ws + WS_WD1), MT, 1024, 2816}; pg8::StaticOrder S; S.init(MT, 1024, G, bx);
        pg8::EpiRes E{out, out + (size_t)MP * 1024, out, HB, SSPN(4)};
        pg8::gemm_phase<pg8::EpiRes, pg8::StaticOrder, PG8_ALIGN, PG8_SP2>(L, g, S, E);
        SEG_END(10);
    }
    SEAM(10);
    if (IN(11)) {
        PHASE_ARGS();
        SEG_BEGIN(11);
        const int gw = vcu * NWAVES + wave, NGW = G * NWAVES; const float* gf = args.in[19]; const float* ssp = SSPN(4);
        f32x4 gv[4];
#pragma unroll
        for (int j = 0; j < 4; ++j) gv[j] = *(const f32x4*)(gf + 256 * j + 4 * lane);
        for (int m = gw; m < MT; m += NGW) {
            float s = 0.f;
#pragma unroll
            for (int j = 0; j < 4; ++j) { const f32x4 p = *(const f32x4*)(ssp + (size_t)m * 16 + 4 * j); s += (p[0] + p[1]) + (p[2] + p[3]); }
            const float rstd = 1.0f / sqrtf(s * (1.0f / 1024.0f) + 1e-6f);
            float* r = out + (size_t)m * 1024 + 4 * lane;
#pragma unroll
            for (int j = 0; j < 4; ++j) { f32x4 v = *(f32x4*)(r + 256 * j); v = v * rstd * gv[j]; *(f32x4*)(r + 256 * j) = v; }
        }
        SEG_END(11);
    }
#undef IN
#undef SEAM
}

extern "C" void kernel_launch(void* const* d_in, const int* in_sizes, int n_in, void* d_out, int out_size, void* d_ws, size_t ws_size, hipStream_t stream) {
    static int grid = 0;
    if (grid == 0) {
        if (n_in != 20 || (size_t)out_size != O_END || ws_size < WS_END) { fprintf(stderr, "kernel_launch: unexpected shapes (n_in %d out %d ws %zu)\n", n_in, out_size, ws_size); grid = -1; return; }
        int dev = 0, cus = 0, per_cu = 0;
        hipGetDevice(&dev); hipDeviceGetAttribute(&cus, hipDeviceAttributeMultiprocessorCount, dev);
        if (hipFuncSetAttribute((const void*)fwd_mega, hipFuncAttributeMaxDynamicSharedMemorySize, LDS_BYTES) != hipSuccess) { fprintf(stderr, "kernel_launch: hipFuncSetAttribute failed\n"); grid = -1; return; }
        if (hipOccupancyMaxActiveBlocksPerMultiprocessor(&per_cu, (const void*)fwd_mega, NWAVES * 64, LDS_BYTES) != hipSuccess || per_cu < 1) { fprintf(stderr, "kernel_launch: occupancy query says %d\n", per_cu); per_cu = 1; }
        (void)hipGetLastError();
        grid = cus * per_cu;
        if (grid != 256) fprintf(stderr, "kernel_launch: grid %d (expected 256)\n", grid);
    }
    if (grid < 0) return;
    if (hipMemsetAsync(d_ws, 0, 131072, stream) != hipSuccess) { fprintf(stderr, "kernel_launch: memset failed\n"); return; }
    KArgs a{};
    for (int i = 0; i < 20; ++i) a.in[i] = (const float*)d_in[i];
    a.out = (float*)d_out; a.ws = (unsigned char*)d_ws;
#if MK_PER_PHASE
    for (int p = 0; p < N_PHASES; ++p) { a.ph_lo = p; a.ph_hi = p + 1; void* kargs[] = {&a};
        hipError_t e = hipLaunchCooperativeKernel((const void*)fwd_mega, dim3(grid), dim3(NWAVES * 64), kargs, LDS_BYTES, stream);
        if (e != hipSuccess) { fprintf(stderr, "kernel_launch: launch %d failed: %s\n", p, hipGetErrorString(e)); break; } }
#else
    a.ph_lo = 0; a.ph_hi = N_PHASES; void* kargs[] = {&a};
    hipError_t e = hipLaunchCooperativeKernel((const void*)fwd_mega, dim3(grid), dim3(NWAVES * 64), kargs, LDS_BYTES, stream);
    if (e != hipSuccess) fprintf(stderr, "kernel_launch: cooperative launch failed: %s (grid %d)\n", hipGetErrorString(e), grid);
#endif
}
```

```cpp
#include <hip/hip_cooperative_groups.h>
#include <hip/hip_runtime.h>
#include <cstdio>
#include <cstdint>
namespace pg8 {
#define PG8_LAS __attribute__((address_space(3)))
typedef unsigned short bf16_t;
typedef short bf16x8 __attribute__((ext_vector_type(8)));
typedef float f32x4 __attribute__((ext_vector_type(4)));
typedef unsigned u32x4 __attribute__((ext_vector_type(4)));
constexpr int BM = 256, BK = 64, HALF = 128, HTB = HALF * BK * 2  , STAGE_BYTES = 8 * HTB, NXCD = 8, WGM = 8;

__host__ __device__ __forceinline__ int lds_byte(int r, int c) { const int st = (r >> 4) * 2 + (c >> 5), rr = r & 15, cc = c & 31, ob = rr * 64 + cc * 2; return st * 1024 + (ob ^ (((ob >> 9) & 1) << 5)); }
__host__ __device__ __forceinline__ void stage_rc(int b, int& R, int& C) { const int st = b / 1024, sb = b % 1024, swz = sb ^ (((sb >> 9) & 1) << 5); R = (st >> 1) * 16 + swz / 64; C = (st & 1) * 32 + (swz % 64) / 2; }
__host__ __device__ __forceinline__ int perm32(int rho) { const int n = rho >> 4, i = rho & 15; return 8 * (i >> 2) + 4 * n + (i & 3); }

struct Unit { int pm, pn; };
struct Gemm { const bf16_t* A; const bf16_t* Bt; int M, N, K; };

struct StaticOrder {
    int nM, nN, nwg, G, c;
    __host__ __device__ void init(int M, int N, int G_, int c_) { nM = M / BM; nN = N / BM; nwg = nM * nN; G = G_; c = c_; }
    __host__ __device__ bool next(int i, Unit& u) const {
        const long L = (long)i * G + c; if (L >= nwg) return false;
        int wgid = (int)L; { const int q = nwg / NXCD, r = nwg % NXCD, xcd = wgid % NXCD, off = wgid / NXCD; wgid = (xcd < r ? xcd * (q + 1) : r * (q + 1) + (xcd - r) * q) + off; }
        const int nig = WGM * nN, gid = wgid / nig, fm = gid * WGM, gsz = (nM - fm) < WGM ? (nM - fm) : WGM;
        u.pm = fm + ((wgid % nig) % gsz); u.pn = (wgid % nig) / gsz; return true;
    }
    __device__ __forceinline__ void a_ready(const Unit&) const {}
    __device__ __forceinline__ void done(const Unit&) const {}
};

struct FlexOrder {
    int nN, nwg, nprompt, G, c, ns, ks, nmain;
    unsigned *arrP, *arrS, *waitP, *waitS; unsigned tgtP, tgtS; PG8_LAS unsigned* larr; volatile PG8_LAS unsigned* stw; mutable int acq;
    __device__ void init(int nN_, int G_, int c_, int ns_, int ks_, int rot = 0) { nN = nN_; nprompt = 64 * nN_; nwg = 66 * nN_; G = G_; c = (c_ + rot) % G_; ns = ns_; ks = ks_; nmain = nwg - ns_ * ks_;
        arrP = arrS = waitP = waitS = nullptr; tgtP = tgtS = 0u; larr = nullptr; stw = nullptr; acq = 0; }
    __device__ bool next(int i, Unit& u) const {
        int L;
        if (c >= ns) { L = i * (G - ns) + (c - ns); if (L >= nmain) return false; } else { if (i >= ks) return false; L = nmain + i * ns + c; }
        if (L < nprompt) { int wgid = L; { const int q = nprompt / NXCD, r = nprompt % NXCD, xcd = wgid % NXCD, off = wgid / NXCD; wgid = (xcd < r ? xcd * (q + 1) : r * (q + 1) + (xcd - r) * q) + off; }
            const int nig = WGM * nN, gid = wgid / nig, fm = gid * WGM, gsz = (64 - fm) < WGM ? (64 - fm) : WGM;
            u.pm = fm + ((wgid % nig) % gsz); u.pn = (wgid % nig) / gsz; }
        else { const int s = L - nprompt; u.pm = 64 + s / nN; u.pn = s % nN; }
        return true;
    }
    __device__ __forceinline__ void a_ready(const Unit& u) const {
        if (!waitP) return;
        const int bit = u.pm >= 64 ? 2 : 1; if (acq & bit) return;
        unsigned* p = bit == 1 ? waitP : waitS; const unsigned tgt = bit == 1 ? tgtP : tgtS; unsigned sp = 0;
        while (__hip_atomic_load(p, __ATOMIC_RELAXED, __HIP_MEMORY_SCOPE_AGENT) < tgt) { __builtin_amdgcn_s_sleep(4); if (++sp > (1u << 22)) break; }
        __builtin_amdgcn_fence(__ATOMIC_ACQUIRE, "agent"); asm volatile("s_waitcnt vmcnt(0)" ::: "memory");
        acq |= bit;
    }
    __device__ __forceinline__ void done(const Unit& u) const {
        if (u.pm >= 64 ? !arrS : !arrP) return;
        asm volatile("s_waitcnt vmcnt(0)" ::: "memory");
        if ((threadIdx.x & 63) == 0) {
            const unsigned old = __hip_atomic_fetch_add(larr, 1u, __ATOMIC_RELAXED, __HIP_MEMORY_SCOPE_WORKGROUP);
            if ((old & 7u) == 7u) {
                if (u.pm >= 64) { __builtin_amdgcn_fence(__ATOMIC_RELEASE, "agent"); asm volatile("s_waitcnt vmcnt(0)" ::: "memory");
                    __hip_atomic_fetch_add(arrS, 1u, __ATOMIC_RELAXED, __HIP_MEMORY_SCOPE_AGENT); }
                else {
                    const unsigned x = (unsigned)__builtin_amdgcn_s_getreg((3 << 11) | 20) & 0xFu, nloc = stw[0];
                    const unsigned o = __hip_atomic_fetch_add(arrP + 64 * x, 1u, __ATOMIC_RELAXED, __HIP_MEMORY_SCOPE_AGENT);
                    if (o + 1u == nloc) { __builtin_amdgcn_fence(__ATOMIC_RELEASE, "agent"); asm volatile("s_waitcnt vmcnt(0)" ::: "memory");
                        __hip_atomic_fetch_add(arrP + 1024, 1u, __ATOMIC_RELAXED, __HIP_MEMORY_SCOPE_AGENT); } } }
        }
    }
};

struct GuDeal : FlexOrder {
    int cp;
    __device__ void init2(int G_, int c_, int rot) { init(22, G_, c_, 0, 0, 0); cp = (c_ + rot) % G_; }
    __device__ bool next(int i, Unit& u) const {
        const int c = cp; int P = -1, s = -1;
        if (c < 128) { if (i < 6) P = i * 256 + c; }
        else if (c < 172) { if (i == 0) P = c; else if (i == 1) s = c - 128; else if (i < 6) P = (i - 1) * 256 + c; }
        else if (c < 248) { if (i < 5) P = i * 256 + c; else if (i == 5 && c < 188) P = c < 180 ? 3 * 256 + (c + 76) : 4 * 256 + (c + 68); }
        else { if (i < 3) P = i * 256 + c; }
        if (P < 0 && s < 0) return false;
        if (s >= 0) { u.pm = 64 + s / 22; u.pn = s % 22; return true; }
        int wgid = P; { const int q = 1408 / NXCD, xcd = wgid % NXCD, off = wgid / NXCD; wgid = xcd * q + off; }
        const int nig = WGM * 22, gid = wgid / nig, fm = gid * WGM;
        u.pm = fm + ((wgid % nig) % WGM); u.pn = (wgid % nig) / WGM; return true;
    }
};
struct OneUnitOrder {
    int pm, pn; unsigned* waitc; unsigned tgt;
    __device__ bool next(int i, Unit& u) const { if (i > 0) return false; u.pm = pm; u.pn = pn; return true; }
    __device__ __forceinline__ void a_ready(const Unit&) const { unsigned sp = 0;
        while (__hip_atomic_load(waitc, __ATOMIC_RELAXED, __HIP_MEMORY_SCOPE_AGENT) < tgt) { __builtin_amdgcn_s_sleep(4); if (++sp > (1u << 22)) break; }
        __builtin_amdgcn_fence(__ATOMIC_ACQUIRE, "agent"); asm volatile("s_waitcnt vmcnt(0)" ::: "memory"); }
    __device__ __forceinline__ void done(const Unit&) const {}
};

__device__ __forceinline__ unsigned cvt_pk_bf16(float lo, float hi) { unsigned r; asm volatile("v_cvt_pk_bf16_f32 %0, %1, %2" : "=v"(r) : "v"(lo), "v"(hi)); return r; }
__device__ __forceinline__ void st16(void* p, u32x4 v) {
#if defined(EPI_WT) && EPI_WT
    asm volatile("global_store_dwordx4 %0, %1, off sc1" : : "v"(p), "v"(v) : "memory");
#else
    *(u32x4*)p = v;
#endif
}
__device__ __forceinline__ void st16f(void* p, f32x4 v) { st16(p, __builtin_bit_cast(u32x4, v)); }
constexpr int MP_ROWS = 16384;
constexpr float RMS_EPS = 1e-6f;
__device__ __forceinline__ void row_rstd(float (&rs)[2][4], const float* ssp, int row0, int fq) {
#pragma unroll
    for (int ai = 0; ai < 2; ++ai)
#pragma unroll
        for (int m = 0; m < 4; ++m) { const f32x4 p = *(const f32x4*)(ssp + (size_t)(row0 + ai * HALF + m * 16) * 16 + 4 * fq);
            float s = (p[0] + p[1]) + (p[2] + p[3]); s += __shfl_xor(s, 16); s += __shfl_xor(s, 32);
            rs[ai][m] = 1.0f / sqrtf(s * (1.0f / 1024.0f) + RMS_EPS); }
}
struct EpiQKV {
    static constexpr bool PERM = true, AFTER_DRAIN = false;
    bf16_t *Qb, *Kb, *Vb; float *kp, *vp, *ks, *vs; const float* ssp; int layer; float qscale;
    __device__ __forceinline__ long frow(int row) const {
        if (layer == 0) return row < MP_ROWS ? (long)row * 1024 : (long)(row - MP_ROWS) * 1024;
        if (row < MP_ROWS) { const int t = row & 8191, b = row >> 13; return t >= 7680 ? (long)(b * 512 + t - 7680) * 1024 : -1; }
        const int sr = row - MP_ROWS; return (long)((sr >> 4) * 512 + 496 + (sr & 15)) * 1024;
    }
    __device__ __forceinline__ void operator()(const f32x4 (&acc)[2][2][4][2], const Unit& u, int wr, int wc, int fr, int fq) const {
        const int t = u.pn >> 2, colt = (u.pn & 3) * BM, row0 = u.pm * BM + wr * 64 + fr, col0 = colt + wc * 32 + 8 * fq;
        float rs[2][4]; row_rstd(rs, ssp, row0, fq);
        bf16_t* const qb_ = Qb; bf16_t* const kb_ = Kb; bf16_t* const vb_ = Vb; float* const kp_ = kp; float* const vp_ = vp; float* const ks_ = ks; float* const vs_ = vs;
        bf16_t* B = t == 0 ? qb_ : (t == 1 ? kb_ : vb_); const float sc = t == 0 ? qscale : 1.f;
        const bool prow = u.pm < 64;
        float* fb = t == 1 ? (prow ? kp_ : ks_) : (prow ? vp_ : vs_);
        const bool anyf = t > 0 && (layer == 0 || !prow || (u.pm & 31) >= 30);
#pragma unroll
        for (int ai = 0; ai < 2; ++ai)
#pragma unroll
            for (int m = 0; m < 4; ++m) { const int row = row0 + ai * HALF + m * 16; const float r = rs[ai][m];
                const long fo = anyf ? frow(row) : -1;
#pragma unroll
                for (int bj = 0; bj < 2; ++bj) { f32x4 v0 = acc[ai][bj][m][0] * r, v1 = acc[ai][bj][m][1] * r;
                    if (fo >= 0) { float* fp = fb + fo + col0 + bj * HALF; st16f(fp, v0); st16f(fp + 4, v1); }
                    v0 = v0 * sc; v1 = v1 * sc; u32x4 w; w.x = cvt_pk_bf16(v0[0], v0[1]); w.y = cvt_pk_bf16(v0[2], v0[3]); w.z = cvt_pk_bf16(v1[0], v1[1]); w.w = cvt_pk_bf16(v1[2], v1[3]);
                    st16(B + (size_t)row * 1024 + col0 + bj * HALF, w); } }
    }
};
struct EpiRes {
    static constexpr bool PERM = true, AFTER_DRAIN = false;
    const float *base_p, *base_s; float* H; bf16_t* HB; float* ssp;
    __device__ __forceinline__ void operator()(const f32x4 (&acc)[2][2][4][2], const Unit& u, int wr, int wc, int fr, int fq) const {
        const int col0 = u.pn * BM + wc * 32 + 8 * fq, rl0 = wr * 64 + fr;
        const float* base = u.pm < 64 ? base_p + (size_t)u.pm * BM * 1024 : base_s + (size_t)(u.pm - 64) * BM * 1024;
#pragma unroll
        for (int ai = 0; ai < 2; ++ai)
#pragma unroll
            for (int m = 0; m < 4; ++m) { const int rl = rl0 + ai * HALF + m * 16; const size_t row = (size_t)u.pm * BM + rl; float ss = 0.f;
#pragma unroll
                for (int bj = 0; bj < 2; ++bj) { const float* bp = base + (size_t)rl * 1024 + col0 + bj * HALF;
                    const f32x4 v0 = acc[ai][bj][m][0] + *(const f32x4*)bp, v1 = acc[ai][bj][m][1] + *(const f32x4*)(bp + 4);
                    ss += (v0[0] * v0[0] + v0[1] * v0[1]) + (v0[2] * v0[2] + v0[3] * v0[3]) + (v1[0] * v1[0] + v1[1] * v1[1]) + (v1[2] * v1[2] + v1[3] * v1[3]);
                    float* hp = H + row * 1024 + col0 + bj * HALF; st16f(hp, v0); st16f(hp + 4, v1);
                    u32x4 w; w.x = cvt_pk_bf16(v0[0], v0[1]); w.y = cvt_pk_bf16(v0[2], v0[3]); w.z = cvt_pk_bf16(v1[0], v1[1]); w.w = cvt_pk_bf16(v1[2], v1[3]);
                    st16(HB + row * 1024 + col0 + bj * HALF, w); }
                ss += __shfl_xor(ss, 16); ss += __shfl_xor(ss, 32);
                if (fq == 0) ssp[row * 16 + u.pn * 4 + wc] = ss;
                if (m & 1) asm volatile("" ::: "memory"); }
    }
};
struct EpiSwiGLU {
    static constexpr bool PERM = true, AFTER_DRAIN = false;
    bf16_t* ACT; const float* ssp;
    __device__ __forceinline__ void operator()(const f32x4 (&acc)[2][2][4][2], const Unit& u, int wr, int wc, int fr, int fq) const {
        const int row0 = u.pm * BM + wr * 64 + fr, col0 = u.pn * HALF + wc * 32 + 8 * fq;
        float rs[2][4]; row_rstd(rs, ssp, row0, fq);
#pragma unroll
        for (int ai = 0; ai < 2; ++ai)
#pragma unroll
            for (int m = 0; m < 4; ++m) { const int row = row0 + ai * HALF + m * 16; const float r = rs[ai][m]; float o[8];
#pragma unroll
                for (int n = 0; n < 2; ++n)
#pragma unroll
                    for (int e = 0; e < 4; ++e) { const float g = acc[ai][0][m][n][e] * r, up = acc[ai][1][m][n][e] * r;
                        o[n * 4 + e] = g * __builtin_amdgcn_rcpf(1.0f + __builtin_amdgcn_exp2f(g * -1.4426950408889634f)) * up; }
                u32x4 w; w.x = cvt_pk_bf16(o[0], o[1]); w.y = cvt_pk_bf16(o[2], o[3]); w.z = cvt_pk_bf16(o[4], o[5]); w.w = cvt_pk_bf16(o[6], o[7]);
                st16(ACT + (size_t)row * 2816 + col0, w); }
    }
};

template <class Epi, class Sched, bool ALIGN_EPI = false, bool SP2 = false>
__device__ __forceinline__ void gemm_phase(PG8_LAS unsigned char* lds, const Gemm g, const Sched& S, const Epi& E) {
    int tid_ = threadIdx.x; asm volatile("" : "+v"(tid_));
    const int tid = tid_, wid = __builtin_amdgcn_readfirstlane(tid >> 6), lane = tid & 63, wr = wid >> 2, wc = wid & 3, fr = lane & 15, fq = lane >> 4;
    const int K = g.K, nt = K / BK;
    unsigned voffA[2], voffB[2];
#pragma unroll
    for (int i = 0; i < 2; ++i) { int R, C; stage_rc(tid * 16 + i * 8192, R, C); const int Rb = Epi::PERM ? ((R & ~31) + perm32(R & 31)) : R;
        voffA[i] = (unsigned)(R * K + C) * 2u; voffB[i] = (unsigned)(Rb * K + C) * 2u; }
    const size_t kstep = (size_t)(BK * 2);
    const size_t hstep = (size_t)HALF * K * 2;
    const size_t tstep = 2 * hstep;
    const unsigned ldsw = (unsigned)wid * 1024u;
    const int aoff = lds_byte(wr * 64 + fr, fq * 8), boff = lds_byte(wc * 32 + fr, fq * 8);
#define PG8_SA(b, h) (((b) * 2 + (h)) * HTB)
#define PG8_SB(b, h) ((4 + (b) * 2 + (h)) * HTB)
#define PG8_STAGE(bufoff, gbase, voff) do { _Pragma("unroll") for (int _i = 0; _i < 2; ++_i) \
        __builtin_amdgcn_global_load_lds((const unsigned*)((const char*)(gbase) + (voff)[_i]), (PG8_LAS unsigned*)(lds + (bufoff) + ldsw + _i * 8192), 16, 0, 0); } while (0)
#define PG8_LDA(dst, b, h) do { _Pragma("unroll") for (int m = 0; m < 4; ++m) _Pragma("unroll") for (int k = 0; k < 2; ++k) dst[m][k] = *(const PG8_LAS bf16x8*)(lds + PG8_SA(b, h) + aoff + m * 2048 + k * 1024); } while (0)
#define PG8_LDB(dst, b, h) do { _Pragma("unroll") for (int n = 0; n < 2; ++n) _Pragma("unroll") for (int k = 0; k < 2; ++k) dst[n][k] = *(const PG8_LAS bf16x8*)(lds + PG8_SB(b, h) + boff + n * 2048 + k * 1024); } while (0)
#define PG8_MMA(ai, bj, At, Bt) do { __builtin_amdgcn_s_setprio(1); _Pragma("unroll") for (int m = 0; m < 4; ++m) _Pragma("unroll") for (int n = 0; n < 2; ++n) _Pragma("unroll") for (int k = 0; k < 2; ++k) \
        acc[ai][bj][m][n] = __builtin_amdgcn_mfma_f32_16x16x32_bf16(Bt[n][k], At[m][k], acc[ai][bj][m][n], 0, 0, 0); __builtin_amdgcn_s_setprio(0); } while (0)
#define PG8_WAIT_V(n) asm volatile("s_waitcnt vmcnt(" #n ")" ::: "memory")
#define PG8_WAIT_L(n) asm volatile("s_waitcnt lgkmcnt(" #n ")" ::: "memory")
#define PG8_BAR __builtin_amdgcn_s_barrier()
#define PG8_SCHED __builtin_amdgcn_sched_barrier(0)
    Unit cur, nxt; int ui = 0;
    if (!S.next(0, cur)) return;
    f32x4 acc[2][2][4][2];
#pragma unroll
    for (int a = 0; a < 2; ++a)
#pragma unroll
        for (int b = 0; b < 2; ++b)
#pragma unroll
            for (int m = 0; m < 4; ++m)
#pragma unroll
                for (int n = 0; n < 2; ++n) acc[a][b][m][n] = (f32x4){0.f, 0.f, 0.f, 0.f};
    bf16x8 At[4][2], B0[2][2], B1[2][2];
    const char* cA = (const char*)g.A + (size_t)cur.pm * tstep; const char* cB = (const char*)g.Bt + (size_t)cur.pn * tstep;
    S.a_ready(cur);
    if constexpr (SP2) {
        PG8_STAGE(PG8_SB(0, 0), cB, voffB); PG8_STAGE(PG8_SB(0, 1), cB + hstep, voffB); PG8_STAGE(PG8_SA(0, 0), cA, voffA); PG8_STAGE(PG8_SA(0, 1), cA + hstep, voffA);
        if (wr == 1) PG8_BAR;
        PG8_WAIT_V(2); PG8_BAR;
        PG8_STAGE(PG8_SB(1, 0), cB + kstep, voffB); PG8_STAGE(PG8_SA(1, 0), cA + kstep, voffA); PG8_STAGE(PG8_SB(1, 1), cB + hstep + kstep, voffB);
        PG8_WAIT_V(6); PG8_BAR;
    } else {
        PG8_STAGE(PG8_SB(0, 0), cB, voffB); PG8_STAGE(PG8_SA(0, 0), cA, voffA); PG8_STAGE(PG8_SB(0, 1), cB + hstep, voffB); PG8_STAGE(PG8_SA(0, 1), cA + hstep, voffA);
        if (wr == 1) PG8_BAR;
        PG8_WAIT_V(4); PG8_BAR;
        PG8_STAGE(PG8_SB(1, 0), cB + kstep, voffB); PG8_STAGE(PG8_SA(1, 0), cA + kstep, voffA); PG8_STAGE(PG8_SB(1, 1), cB + hstep + kstep, voffB);
        PG8_WAIT_V(6); PG8_BAR;
    }
    for (;;) {
        const bool has_next = S.next(ui + 1, nxt);
        const char* nA = has_next ? (const char*)g.A + (size_t)nxt.pm * tstep : cA; const char* nB = has_next ? (const char*)g.Bt + (size_t)nxt.pn * tstep : cB;
        for (int t = 0; t < nt; t += 2) {
            const bool last = (t == nt - 2);
            const char* a1 = cA + (size_t)(t + 1) * kstep;
            const char* a2 = last ? nA : cA + (size_t)(t + 2) * kstep; const char* b2 = last ? nB : cB + (size_t)(t + 2) * kstep;
            const char* a3 = a2 + kstep; const char* b3 = b2 + kstep;
            if (last && has_next) S.a_ready(nxt);
            if constexpr (SP2) {
            PG8_LDB(B0, 0, 0); PG8_LDB(B1, 0, 1); PG8_SCHED; PG8_LDA(At, 0, 0); PG8_STAGE(PG8_SA(1, 1), a1 + hstep, voffA);
            PG8_WAIT_V(8); PG8_WAIT_L(0); PG8_BAR; PG8_MMA(0, 0, At, B0); PG8_MMA(0, 1, At, B1); PG8_BAR; PG8_SCHED;
            PG8_LDA(At, 0, 1); PG8_STAGE(PG8_SB(0, 0), b2, voffB); PG8_STAGE(PG8_SB(0, 1), b2 + hstep, voffB); PG8_STAGE(PG8_SA(0, 0), a2, voffA);
            PG8_WAIT_V(8); PG8_WAIT_L(0); PG8_BAR; PG8_MMA(1, 0, At, B0); PG8_MMA(1, 1, At, B1); PG8_BAR; PG8_SCHED;
            PG8_LDB(B0, 1, 0); PG8_LDB(B1, 1, 1); PG8_SCHED; PG8_LDA(At, 1, 0); PG8_STAGE(PG8_SA(0, 1), a2 + hstep, voffA);
            PG8_WAIT_V(8); PG8_WAIT_L(0); PG8_BAR; PG8_MMA(0, 0, At, B0); PG8_MMA(0, 1, At, B1); PG8_BAR; PG8_SCHED;
            PG8_LDA(At, 1, 1); PG8_STAGE(PG8_SB(1, 0), b3, voffB); PG8_STAGE(PG8_SB(1, 1), b3 + hstep, voffB); PG8_STAGE(PG8_SA(1, 0), a3, voffA);
            PG8_WAIT_V(8); PG8_WAIT_L(0); PG8_BAR; PG8_MMA(1, 0, At, B0); PG8_MMA(1, 1, At, B1); PG8_BAR; PG8_SCHED;
            } else {
            PG8_LDB(B0, 0, 0); PG8_SCHED; PG8_LDA(At, 0, 0); PG8_STAGE(PG8_SA(1, 1), a1 + hstep, voffA);
            PG8_WAIT_L(8); PG8_BAR; PG8_WAIT_L(0); PG8_MMA(0, 0, At, B0); PG8_BAR; PG8_SCHED;
            PG8_LDB(B1, 0, 1); PG8_STAGE(PG8_SB(0, 0), b2, voffB);
            PG8_BAR; PG8_WAIT_L(0); PG8_MMA(0, 1, At, B1); PG8_BAR;
            PG8_LDA(At, 0, 1); PG8_STAGE(PG8_SA(0, 0), a2, voffA);
            PG8_BAR; PG8_WAIT_L(0); PG8_MMA(1, 0, At, B0); PG8_BAR; PG8_SCHED;
            PG8_STAGE(PG8_SB(0, 1), b2 + hstep, voffB);
            PG8_WAIT_V(6); PG8_BAR; PG8_MMA(1, 1, At, B1); PG8_BAR;
            PG8_LDB(B0, 1, 0); PG8_SCHED; PG8_LDA(At, 1, 0); PG8_STAGE(PG8_SA(0, 1), a2 + hstep, voffA);
            PG8_WAIT_L(8); PG8_BAR; PG8_WAIT_L(0); PG8_MMA(0, 0, At, B0); PG8_BAR; PG8_SCHED;
            PG8_LDB(B1, 1, 1); PG8_STAGE(PG8_SB(1, 0), b3, voffB);
            PG8_BAR; PG8_WAIT_L(0); PG8_MMA(0, 1, At, B1); PG8_BAR;
            PG8_LDA(At, 1, 1); PG8_STAGE(PG8_SA(1, 0), a3, voffA);
            PG8_BAR; PG8_WAIT_L(0); PG8_MMA(1, 0, At, B0); PG8_BAR; PG8_SCHED;
            PG8_STAGE(PG8_SB(1, 1), b3 + hstep, voffB);
            PG8_WAIT_V(6); PG8_BAR; PG8_MMA(1, 1, At, B1); PG8_BAR;
            }
        }
        if constexpr (ALIGN_EPI) { if (wr == 0) PG8_BAR; }
        if constexpr (!Epi::AFTER_DRAIN) { E(acc, cur, wr, wc, fr, fq); S.done(cur); }
        if (!has_next) break;
#pragma unroll
        for (int a = 0; a < 2; ++a)
#pragma unroll
            for (int b = 0; b < 2; ++b)
#pragma unroll
                for (int m = 0; m < 4; ++m)
#pragma unroll
                    for (int n = 0; n < 2; ++n) acc[a][b][m][n] = (f32x4){0.f, 0.f, 0.f, 0.f};
        cur = nxt; cA = nA; cB = nB; ++ui;
        if constexpr (ALIGN_EPI) { if (wr == 1) PG8_BAR; }
    }
    PG8_WAIT_V(0);
    if constexpr (!ALIGN_EPI) { if (wr == 0) PG8_BAR; }
    PG8_BAR;
    if constexpr (Epi::AFTER_DRAIN) { E.fused(acc, cur, wr, wc, fr, fq, lds, wid, lane); S.done(cur); }
#undef PG8_SA
#undef PG8_SB
#undef PG8_STAGE
#undef PG8_LDA
#undef PG8_LDB
#undef PG8_MMA
#undef PG8_WAIT_V
#undef PG8_WAIT_L
#undef PG8_BAR
#undef PG8_SCHED
}
}

#ifndef PG8_SP2
#define PG8_SP2 true
#endif
#ifndef PG8_ALIGN
#define PG8_ALIGN true
#endif
#include <hip/hip_bf16.h>
#include <cmath>
namespace attn_body {
using bf16=__hip_bfloat16;
using bf16x8=__attribute__((ext_vector_type(8)))short;
using s16x4=__attribute__((ext_vector_type(4)))short;
using f32x16=__attribute__((ext_vector_type(16)))float;
using u32x4=__attribute__((ext_vector_type(4)))unsigned;
constexpr int BATCH=2,NHEAD=16,SEQ=8192,D=64,DM=NHEAD*D;
constexpr int NW=8,QBLK=32,QB=QBLK*NW,KVBLK=64,NQB=SEQ/QB;
constexpr int ATTN_PITCH=DM, ATTN_UNIT_ROWS=QB;
__device__ __forceinline__ int crow(int r,int hi){return (r&3)+8*(r>>2)+4*hi;}
#define SBAR() __builtin_amdgcn_sched_barrier(0)
__device__ __forceinline__ void cmask(f32x16&p0,f32x16&p1,int jb,int qrel,int hi){
  const float NEG=-INFINITY; int kb=64*jb+4*hi;
  #pragma unroll
  for(int r=0;r<16;++r){int kv=kb+(r&3)+8*(r>>2); if(kv>qrel)p0[r]=NEG; if(kv+32>qrel)p1[r]=NEG;}
}

constexpr int NSLOT=3, SLOTB=8192;
constexpr int LDS_K=0, LDS_V=NSLOT*SLOTB, LDS_WS=2*NSLOT*SLOTB, LDS_OST=LDS_WS+NW*64*4, LDS_X=LDS_OST+NW*4096, LDS_BT=LDS_X+NSLOT*2048, LDS_BYTES=LDS_BT+2048;
constexpr float C2=0.125f*1.4426950408889634f;
__device__ __forceinline__ void glds16(const void*gsrc,unsigned lds_dst){unsigned keep;
  asm volatile("s_mov_b32 %0, m0\n\ts_mov_b32 m0, %2\n\ts_nop 0\n\tglobal_load_lds_dwordx4 %1, off\n\ts_mov_b32 m0, %0":"=&s"(keep):"v"(gsrc),"s"(lds_dst):"memory");}
__device__ __forceinline__ void glds16s(const void*sbase,unsigned voff,unsigned lds_dst){unsigned keep;
  asm volatile("s_mov_b32 %0, m0\n\ts_mov_b32 m0, %3\n\ts_nop 0\n\tglobal_load_lds_dwordx4 %1, %2\n\ts_mov_b32 m0, %0":"=&s"(keep):"v"(voff),"s"(sbase),"s"(lds_dst):"memory");}
__device__ __forceinline__ void glds4s(const void*sbase,unsigned voff,unsigned lds_dst){unsigned keep;
  asm volatile("s_mov_b32 %0, m0\n\ts_mov_b32 m0, %3\n\ts_nop 0\n\tglobal_load_lds_dword %1, %2\n\ts_mov_b32 m0, %0":"=&s"(keep):"v"(voff),"s"(sbase),"s"(lds_dst):"memory");}
__device__ __forceinline__ void glds4(const void*gsrc,unsigned lds_dst){unsigned keep;
  asm volatile("s_mov_b32 %0, m0\n\ts_mov_b32 m0, %2\n\ts_nop 0\n\tglobal_load_lds_dword %1, off\n\ts_mov_b32 m0, %0":"=&s"(keep):"v"(gsrc),"s"(lds_dst):"memory");}
__device__ __forceinline__ float max3f(float a,float b,float c){float r;asm("v_max3_f32 %0, %1, %2, %3":"=v"(r):"v"(a),"v"(b),"v"(c));return r;}
__device__ __forceinline__ float max2f(float a,float b){float r;asm("v_max_f32_e32 %0, %1, %2":"=v"(r):"v"(a),"v"(b));return r;}
__device__ __forceinline__ float fadd_s(float a,float b){float r;asm("v_add_f32_e32 %0, %1, %2":"=v"(r):"v"(a),"v"(b));return r;}
__device__ __forceinline__ float fsub_s(float a,float b){float r;asm("v_sub_f32_e32 %0, %1, %2":"=v"(r):"v"(a),"v"(b));return r;}
typedef float f32x2_t __attribute__((ext_vector_type(2))); typedef __bf16 bf16x2_t __attribute__((ext_vector_type(2)));
__device__ __forceinline__ unsigned cvtpk_s(float lo,float hi){f32x2_t v={lo,hi};bf16x2_t b=__builtin_convertvector(v,bf16x2_t);return __builtin_bit_cast(unsigned,b);}
#define WAIT_BAR(N) asm volatile("s_waitcnt vmcnt(" #N ") lgkmcnt(0)\n\ts_barrier":::"memory")

__device__ __forceinline__ void qkt(f32x16&p0,f32x16&p1,const char*Kslot,const bf16x8*qr,bf16x8 kx0,bf16x8 kx1,bf16x8 qe,int r32,int hi){
  const char*kb=Kslot+hi*1024+r32*16;
  #pragma unroll
  for(int d0=0;d0<4;++d0){
    const bf16x8 b0=*reinterpret_cast<const bf16x8*>(kb+d0*2048);
    const bf16x8 b1=*reinterpret_cast<const bf16x8*>(kb+d0*2048+512);
    if(d0==0){const f32x16 z=f32x16{};p0=__builtin_amdgcn_mfma_f32_32x32x16_bf16(kx0,qe,z,0,0,0);p1=__builtin_amdgcn_mfma_f32_32x32x16_bf16(kx1,qe,z,0,0,0);}
    {p0=__builtin_amdgcn_mfma_f32_32x32x16_bf16(b0,qr[d0],p0,0,0,0);p1=__builtin_amdgcn_mfma_f32_32x32x16_bf16(b1,qr[d0],p1,0,0,0);}}
}
typedef __attribute__((address_space(3))) const char* lds_cptr;
typedef short v4i16_t __attribute__((ext_vector_type(4)));
__device__ __forceinline__ void kload8(bf16x8*kf,lds_cptr kp){
  kf[0]=*(const __attribute__((address_space(3))) bf16x8*)(kp);      kf[1]=*(const __attribute__((address_space(3))) bf16x8*)(kp+512);
  kf[2]=*(const __attribute__((address_space(3))) bf16x8*)(kp+2048); kf[3]=*(const __attribute__((address_space(3))) bf16x8*)(kp+2560);
  kf[4]=*(const __attribute__((address_space(3))) bf16x8*)(kp+4096); kf[5]=*(const __attribute__((address_space(3))) bf16x8*)(kp+4608);
  kf[6]=*(const __attribute__((address_space(3))) bf16x8*)(kp+6144); kf[7]=*(const __attribute__((address_space(3))) bf16x8*)(kp+6656);
}
__device__ __forceinline__ void kload2(bf16x8*kf,lds_cptr kp,int j){ kf[2*j]=*(const __attribute__((address_space(3))) bf16x8*)(kp+j*2048); kf[2*j+1]=*(const __attribute__((address_space(3))) bf16x8*)(kp+j*2048+512); }
__device__ __forceinline__ s16x4 vtr(lds_cptr p){ return __builtin_bit_cast(s16x4,__builtin_amdgcn_ds_read_tr16_b64_v4i16((__attribute__((address_space(3))) v4i16_t*)p)); }
__device__ __forceinline__ float rowmax(const f32x16&p0,const f32x16&p1){
  float a=max3f(p0[0],p0[1],p1[0]),b=max3f(p0[2],p0[3],p1[1]);a=max3f(a,p1[2],p1[3]);
  #pragma unroll
  for(int r=4;r<16;r+=4){a=max3f(a,p0[r],p0[r+1]);b=max3f(b,p0[r+2],p0[r+3]);a=max3f(a,p1[r],p1[r+1]);b=max3f(b,p1[r+2],p1[r+3]);}
  const float m=max2f(a,b);
  auto rr=__builtin_amdgcn_permlane32_swap(__float_as_uint(m),__float_as_uint(m),false,false);
  return max2f(__uint_as_float(rr[0]),__uint_as_float(rr[1]));
}
__device__ __forceinline__ void pv(f32x16*o,int vb,bf16x8 pa0,bf16x8 pa1,bf16x8 pa2,bf16x8 pa3){
  #pragma unroll
  for(int d0=0;d0<2;++d0){s16x4 lo[4],hi[4];
    #pragma unroll
    for(int ks=0;ks<4;++ks){
      asm volatile("ds_read_b64_tr_b16 %0,%1 offset:%c2":"=&v"(lo[ks]):"v"(vb),"i"(d0*4096+ks*1024):"memory");
      asm volatile("ds_read_b64_tr_b16 %0,%1 offset:%c2":"=&v"(hi[ks]):"v"(vb),"i"(d0*4096+ks*1024+512):"memory");}
    asm volatile("s_waitcnt lgkmcnt(0)":::"memory");SBAR();
    #define PK(k) (bf16x8){lo[k][0],lo[k][1],lo[k][2],lo[k][3],hi[k][0],hi[k][1],hi[k][2],hi[k][3]}
    o[d0]=__builtin_amdgcn_mfma_f32_32x32x16_bf16(pa0,PK(0),o[d0],0,0,0);
    o[d0]=__builtin_amdgcn_mfma_f32_32x32x16_bf16(pa1,PK(1),o[d0],0,0,0);
    o[d0]=__builtin_amdgcn_mfma_f32_32x32x16_bf16(pa2,PK(2),o[d0],0,0,0);
    o[d0]=__builtin_amdgcn_mfma_f32_32x32x16_bf16(pa3,PK(3),o[d0],0,0,0);
    #undef PK
  }
}

#ifndef ATTN_STORE16
#define ATTN_STORE16(p,v) (*(u32x4*)(p)=(v))
#endif
template<int MODE,int THRL> __device__ __forceinline__ void attn_unit(int b,int h,int qb,const bf16*Q,const bf16*K,const bf16*V,bf16*O,char*shm,const bf16*KX,const float*relb){
  int tid_=threadIdx.x; asm volatile("":"+v"(tid_));
  const int tid=tid_,lane=tid&63,r32=lane&31,hi=lane>>5; const int wid=__builtin_amdgcn_readfirstlane(tid>>6);
  const long rowbase=(long)b*SEQ; const int q0=qb*QB;
  const bf16*Qw=Q+(rowbase+q0+wid*QBLK)*DM+h*D;
  const int kc0=(MODE==1)?((4*qb-8)>0?(4*qb-8):0):0;
  const bf16*Kh=K+(rowbase+(long)kc0*KVBLK)*DM+h*D,*Vh=V+(rowbase+(long)kc0*KVBLK)*DM+h*D;
  const unsigned lds0=(unsigned)(uintptr_t)shm;
  float*wsf=(float*)(shm+LDS_WS)+wid*64;
  const unsigned kvo=(unsigned)(lane*DM+wid*8)*2u, vvo=(unsigned)((16*(wid&3)+(lane>>2))*DM+(wid>>2)*32+(lane&3)*8)*2u;
  const unsigned kdst=lds0+LDS_K+wid*1024, vdst=lds0+LDS_V+wid*1024;
  #define TILE(s_) ((MODE==0)?(NT-1-(s_)):(s_))
  #define DMA_K(t,slot) glds16s(Kh+(long)TILE(t)*KVBLK*DM,kvo,(unsigned)__builtin_amdgcn_readfirstlane(kdst+(slot)))
  #define DMA_V(t,slot) glds16s(Vh+(long)TILE(t)*KVBLK*DM,vvo,(unsigned)__builtin_amdgcn_readfirstlane(vdst+(slot)))
  const bf16*xsrc=KX+((long)(b*NHEAD+h)*2*SEQ+(long)(wid>>2)*SEQ+16*(wid&3))*8; const unsigned xvo=(unsigned)lane*4u; const unsigned xdst=lds0+LDS_X+wid*256;
  #define DMA_E(t,slot) do{ if(MODE==0) glds4s(xsrc+(long)TILE(t)*KVBLK*8,xvo,(unsigned)__builtin_amdgcn_readfirstlane(xdst+((slot)>>2))); }while(0)
  const lds_cptr xp0=(lds_cptr)shm+LDS_X+hi*1024+r32*16;
  #define XLD(sl) do{ if(MODE==0){ ke0=*(const __attribute__((address_space(3))) bf16x8*)(xp0+((sl)>>2)); ke1=*(const __attribute__((address_space(3))) bf16x8*)(xp0+((sl)>>2)+512); } }while(0)
  #define WAITB_A() do{ if(MODE==0){WAIT_BAR(3);}else{WAIT_BAR(2);} }while(0)
  const int vb0=(int)(lds0+LDS_V)+((lane>>4)&1)*32+(lane&3)*8+(4*hi+((lane&15)>>2))*64;
  const char*Kbase=shm+LDS_K; bf16x8 kf[8];
  const lds_cptr shm3=(lds_cptr)shm; const lds_cptr kp0=shm3+LDS_K+hi*1024+r32*16; const lds_cptr vp0=shm3+LDS_V+((lane>>4)&1)*32+(lane&3)*8+(4*hi+((lane&15)>>2))*64;
  const int NT=(q0+QB)/KVBLK-kc0;
  if(MODE==1){ float*bt=(float*)(shm+LDS_BT); if(tid<257) bt[tid]=(relb[tid]-relb[256])*1.4426950408889634f; }
  u32x4 qev=(u32x4){0x3F803F80u,0x3F80u,0u,0u};
  bf16x8 ke0,ke1; { const u32x4 kc_=(hi==0)?(u32x4){0u,0x3F800000u,0x3F803F80u,0u}:(u32x4){0u,0u,0u,0u}; ke0=__builtin_bit_cast(bf16x8,kc_); ke1=ke0; }
  #define QE() __builtin_bit_cast(bf16x8,qev)
  #define SETQE() do{ const float nm_=-mhat; const unsigned a_=cvtpk_s(nm_,0.f)&0xffffu; const float r1_=nm_-__uint_as_float(a_<<16); const unsigned b_=cvtpk_s(r1_,0.f)&0xffffu; \
    const float r2_=r1_-__uint_as_float(b_<<16); const unsigned c_=cvtpk_s(r2_,0.f)&0xffffu; qev[1]=0x3F80u|(a_<<16); qev[2]=b_|(c_<<16); }while(0)
  DMA_K(0,0);DMA_E(0,0);DMA_V(0,0);DMA_K(1,SLOTB);DMA_E(1,SLOTB);
  bf16x8 qr[4];
  #pragma unroll
  for(int d0=0;d0<4;++d0)qr[d0]=*reinterpret_cast<const bf16x8*>(&Qw[(long)r32*DM+d0*16+hi*8]);
  float mhat=0.f,l_reg=0.f;f32x16 o[2];o[0]=f32x16{};o[1]=f32x16{};
  const int qrel=wid*QBLK+r32;
  const int cw=4*qb+(wid>>1);
  #define BMASK(P0,P1,t) do{ const int kc_=kc0+(t); if(kc_>cw||kc_<cw-8){ _Pragma("unroll") for(int r=0;r<16;++r){P0[r]=-INFINITY;P1[r]=-INFINITY;} } \
    else if(kc_>=cw-2){ const float*bt_=(const float*)(shm+LDS_BT); const int dq_=64*(cw-kc_)+32*(wid&1)+r32-4*hi; \
      _Pragma("unroll") for(int r=0;r<16;++r){ const int d0_=dq_-((r&3)+8*(r>>2)), d1_=d0_-32; P0[r]+=bt_[(d0_<128?d0_:128)+128]; P1[r]+=bt_[(d1_<128?d1_:128)+128]; } } }while(0)
  #define CMASK(P0,P1,t) do{ if(MODE==1){BMASK(P0,P1,t);} else {int jb_=3-(t); if(jb_>=0)cmask(P0,P1,jb_,qrel,hi);} }while(0)
  bool resc=false;
  #define START(P0,P1) do{ float rm=rowmax(P0,P1); rm=max2f(rm,-64.f); resc=false;     \
    { const float dl=rm; mhat=fadd_s(mhat,dl); \
      _Pragma("unroll") for(int r=0;r<16;++r){P0[r]=fsub_s(P0[r],dl);P1[r]=fsub_s(P1[r],dl);} \
      SETQE(); } \
    _Pragma("unroll") for(int r=0;r<16;++r)P0[r]=__builtin_amdgcn_exp2f(P0[r]); }while(0)
  #define RESC() do{ if(resc){ asm volatile("s_waitcnt lgkmcnt(0)":::"memory"); \
      _Pragma("unroll") for(int d_=0;d_<2;++d_) _Pragma("unroll") for(int r=0;r<16;++r)o[d_][r]*=wsf[crow(r,hi)]; } }while(0)
  f32x16 pA0,pA1,pB0,pB1;
  int sl_prev=0,sl_cur=0,sl_next=SLOTB;
  #define ROT() do{sl_prev=sl_cur;sl_cur=sl_next;sl_next=(sl_next==(NSLOT-1)*SLOTB)?0:sl_next+SLOTB;}while(0)
  DMA_K(2,2*SLOTB);DMA_E(2,2*SLOTB);
  if(MODE==0){WAIT_BAR(5);}else{WAIT_BAR(3);}
  XLD(0);
  qkt(pA0,pA1,Kbase,qr,ke0,ke1,QE(),r32,hi);asm volatile("s_nop 15\n\ts_nop 7":"+v"(pA0),"+v"(pA1));CMASK(pA0,pA1,0);
  START(pA0,pA1);
  _Pragma("unroll") for(int r=0;r<16;++r)pA1[r]=__builtin_amdgcn_exp2f(pA1[r]);
  WAIT_BAR(0);
  DMA_K(3,0);DMA_E(3,0);DMA_V(1,SLOTB);
  ROT();
  kload8(kf,kp0+sl_cur); XLD(sl_cur);
  WAITB_A();
  s16x4 vlo[8],vhi[8]; u32x4 pw0,pw1,pw2,pw3;
  #define PKW(P,B) cvtpk_s(P[B],P[B+1])
  #define PAF(k) __builtin_bit_cast(bf16x8,pw##k)
  #define VFR(i) (bf16x8){vlo[i][0],vlo[i][1],vlo[i][2],vlo[i][3],vhi[i][0],vhi[i][1],vhi[i][2],vhi[i][3]}
  #define PIN(x) asm volatile("":"+v"(x))
  #define MX3(a,b,c) __builtin_fmaxf(__builtin_fmaxf((a),(b)),(c))
  #define GAPA(MF,A0,A1,A2,A3,W0,W1,PW) do{ MF; sacc+=A0; sacc+=A1; sacc+=A2; sacc+=A3; PIN(sacc); W0; W1; PIN(PW); SBAR(); }while(0)
  #define EX(v) __builtin_amdgcn_exp2f(v)
  #define GAPB(MF,X,B) do{ MF; X[B]=EX(X[B]); X[B+1]=EX(X[B+1]); X[B+2]=EX(X[B+2]); X[B+3]=EX(X[B+3]); PIN(X); SBAR(); }while(0)
  #define VRD(i) do{ vlo[i]=vtr(vp_+(((i)>>2)*4096+((i)&3)*1024)); vhi[i]=vtr(vp_+(((i)>>2)*4096+((i)&3)*1024+512)); }while(0)
  #define KRD(G,j) do{ if(G){ kload2(kf,kp0+sl_next,j); SBAR(); } }while(0)
  #define STEP(C0,C1,P0,P1,t,GK,GV,GL) do{ SBAR(); \
    const lds_cptr vp_=vp0+sl_prev; \
    { const f32x16 z_=f32x16{}; C0=__builtin_amdgcn_mfma_f32_32x32x16_bf16(ke0,QE(),z_,0,0,0); C1=__builtin_amdgcn_mfma_f32_32x32x16_bf16(ke1,QE(),z_,0,0,0); } SBAR(); \
    VRD(0); SBAR(); float sacc=(P0[0]+P0[1]); \
    GAPA(C0=__builtin_amdgcn_mfma_f32_32x32x16_bf16(kf[0],qr[0],C0,0,0,0), P0[2],P0[3],P0[4],P0[5],     pw0[0]=PKW(P0,0), pw0[1]=PKW(P0,2), pw0); \
    VRD(4); SBAR(); GAPA(C1=__builtin_amdgcn_mfma_f32_32x32x16_bf16(kf[1],qr[0],C1,0,0,0), P0[6],P0[7],P0[8],P0[9],     pw0[2]=PKW(P0,4), pw0[3]=PKW(P0,6), pw0); \
    VRD(1); SBAR(); GAPA(C0=__builtin_amdgcn_mfma_f32_32x32x16_bf16(kf[2],qr[1],C0,0,0,0),   P0[10],P0[11],P0[12],P0[13], pw1[0]=PKW(P0,8), pw1[1]=PKW(P0,10), pw1); \
    VRD(5); SBAR(); GAPA(C1=__builtin_amdgcn_mfma_f32_32x32x16_bf16(kf[3],qr[1],C1,0,0,0),   P0[14],P0[15],P1[0],P1[1],   pw1[2]=PKW(P0,12),pw1[3]=PKW(P0,14), pw1); \
    VRD(2); SBAR(); GAPA(C0=__builtin_amdgcn_mfma_f32_32x32x16_bf16(kf[4],qr[2],C0,0,0,0),   P1[2],P1[3],P1[4],P1[5],     pw2[0]=PKW(P1,0), pw2[1]=PKW(P1,2), pw2); \
    VRD(6); SBAR(); GAPA(C1=__builtin_amdgcn_mfma_f32_32x32x16_bf16(kf[5],qr[2],C1,0,0,0),   P1[6],P1[7],P1[8],P1[9],     pw2[2]=PKW(P1,4), pw2[3]=PKW(P1,6), pw2); \
    VRD(3); SBAR(); GAPA(C0=__builtin_amdgcn_mfma_f32_32x32x16_bf16(kf[6],qr[3],C0,0,0,0),   P1[10],P1[11],P1[12],P1[13], pw3[0]=PKW(P1,8), pw3[1]=PKW(P1,10), pw3); \
    VRD(7); SBAR(); GAPA(C1=__builtin_amdgcn_mfma_f32_32x32x16_bf16(kf[7],qr[3],C1,0,0,0),   P1[14],P1[15],0.f,0.f,       pw3[2]=PKW(P1,12),pw3[3]=PKW(P1,14), pw3); \
    l_reg+=sacc; \
    if(GK){DMA_K((t)+3,sl_cur);DMA_E((t)+3,sl_cur);} if(GV){DMA_V((t)+1,sl_next);} \
    CMASK(C0,C1,t); \
    { float a=MX3(C0[0],C0[1],C1[0]),b=MX3(C0[2],C0[3],C1[1]); a=MX3(a,C1[2],C1[3]); \
      _Pragma("unroll") for(int r=4;r<16;r+=4){a=MX3(a,C0[r],C0[r+1]);b=MX3(b,C0[r+2],C0[r+3]);a=MX3(a,C1[r],C1[r+1]);b=MX3(b,C1[r+2],C1[r+3]);} \
      float rm=__builtin_fmaxf(a,b); { auto rr=__builtin_amdgcn_permlane32_swap(__float_as_uint(rm),__float_as_uint(rm),false,false); rm=__builtin_fmaxf(__uint_as_float(rr[0]),__uint_as_float(rr[1])); } \
      resc=false; \
      if(__builtin_expect(__any(rm>(float)THRL),0)){ const float dl=__builtin_fmaxf(rm,0.f); mhat+=dl; \
        _Pragma("unroll") for(int r=0;r<16;++r){C0[r]-=dl;C1[r]-=dl;} \
        SETQE(); \
        const float f=__builtin_amdgcn_exp2f(-dl); l_reg*=f; if(hi==0)wsf[r32]=f; resc=true; } } \
    SBAR(); \
    GAPB(o[0]=__builtin_amdgcn_mfma_f32_32x32x16_bf16(PAF(0),VFR(0),o[0],0,0,0), C0,0); \
    GAPB(o[1]=__builtin_amdgcn_mfma_f32_32x32x16_bf16(PAF(0),VFR(4),o[1],0,0,0), C0,4); \
    KRD(GL,0); GAPB(o[0]=__builtin_amdgcn_mfma_f32_32x32x16_bf16(PAF(1),VFR(1),o[0],0,0,0), C0,8); \
    KRD(GL,1); GAPB(o[1]=__builtin_amdgcn_mfma_f32_32x32x16_bf16(PAF(1),VFR(5),o[1],0,0,0), C0,12); \
    KRD(GL,2); GAPB(o[0]=__builtin_amdgcn_mfma_f32_32x32x16_bf16(PAF(2),VFR(2),o[0],0,0,0), C1,0); \
    KRD(GL,3); GAPB(o[1]=__builtin_amdgcn_mfma_f32_32x32x16_bf16(PAF(2),VFR(6),o[1],0,0,0), C1,4); \
    if(GL){ XLD(sl_next); SBAR(); } GAPB(o[0]=__builtin_amdgcn_mfma_f32_32x32x16_bf16(PAF(3),VFR(3),o[0],0,0,0), C1,8); \
    GAPB(o[1]=__builtin_amdgcn_mfma_f32_32x32x16_bf16(PAF(3),VFR(7),o[1],0,0,0), C1,12); \
    }while(0)
  int t=1;
  for(;t+5<NT;t+=2){
    STEP(pB0,pB1,pA0,pA1,t,true,true,true);     WAITB_A(); RESC(); ROT();
    STEP(pA0,pA1,pB0,pB1,t+1,true,true,true);   WAITB_A(); RESC(); ROT();
  }
  #define ENDW(tt) do{ if((tt)+3<NT){WAITB_A();} else if((tt)+2<NT){WAIT_BAR(1);} else {WAIT_BAR(0);} }while(0)
  for(;t+1<NT;t+=2){
    STEP(pB0,pB1,pA0,pA1,t,(t+3<NT),(t+1<NT),(t+1<NT));       ENDW(t);   RESC(); ROT();
    STEP(pA0,pA1,pB0,pB1,t+1,(t+4<NT),(t+2<NT),(t+2<NT));     ENDW(t+1); RESC(); ROT();
  }
  STEP(pB0,pB1,pA0,pA1,NT-1,false,false,false); RESC();
  { float sacc=pB0[0]+pB0[1]; _Pragma("unroll") for(int r=2;r<16;++r)sacc+=pB0[r]; _Pragma("unroll") for(int r=0;r<16;++r)sacc+=pB1[r]; l_reg+=sacc;
    pw0=(u32x4){PKW(pB0,0),PKW(pB0,2),PKW(pB0,4),PKW(pB0,6)};pw1=(u32x4){PKW(pB0,8),PKW(pB0,10),PKW(pB0,12),PKW(pB0,14)};pw2=(u32x4){PKW(pB1,0),PKW(pB1,2),PKW(pB1,4),PKW(pB1,6)};pw3=(u32x4){PKW(pB1,8),PKW(pB1,10),PKW(pB1,12),PKW(pB1,14)};
    SBAR(); pv(o,vb0+sl_cur,PAF(0),PAF(1),PAF(2),PAF(3)); }
  #undef PKW
  #undef PAF
  #undef VFR
  #undef PIN
  #undef MX3
  #undef GAPA
  #undef GAPB
  #undef EX
  #undef VRD
  #undef KRD
  #undef STEP
  #undef ENDW
  {auto rr=__builtin_amdgcn_permlane32_swap(__float_as_uint(l_reg),__float_as_uint(l_reg),false,false);l_reg=__uint_as_float(rr[0])+__uint_as_float(rr[1]);}
  if(hi==0)wsf[32+r32]=l_reg;asm volatile("s_waitcnt lgkmcnt(0)":::"memory");
  float rli[16];
  #pragma unroll
  for(int r=0;r<16;++r)rli[r]=__builtin_amdgcn_rcpf(wsf[32+crow(r,hi)]);
  bf16*Ow=O+(rowbase+q0+wid*QBLK)*DM+h*D;
  { bf16*stg=(bf16*)(shm+LDS_OST)+wid*2048;
    #pragma unroll
    for(int r=0;r<16;++r){const int orow=crow(r,hi);
      #pragma unroll
      for(int d0=0;d0<2;++d0)stg[orow*64+d0*32+r32]=__float2bfloat16(o[d0][r]*rli[r]);}
    asm volatile("s_waitcnt lgkmcnt(0)":::"memory");
    #pragma unroll
    for(int i=0;i<4;++i){const int row=i*8+(lane>>3),ch=lane&7; const u32x4 v=*(const u32x4*)(stg+row*64+ch*8); ATTN_STORE16(Ow+(long)row*DM+ch*8,v);} }
  asm volatile("s_waitcnt lgkmcnt(0)\n\ts_barrier":::"memory");
  #undef DMA_K
  #undef TILE
  #undef DMA_V
  #undef DMA_E
  #undef XLD
  #undef WAITB_A
  #undef QE
  #undef SETQE
  #undef BMASK
  #undef CMASK
  #undef START
  #undef RESC
  #undef ROT
}
constexpr int ATTN_LDS_BYTES=LDS_BYTES;
struct AttnTensors { const bf16* Q; const bf16* K; const bf16* V; bf16* O; const bf16* KX; const float* relb; };
struct AttnUnit { int bh; int qb; };
struct StaticOrder {
  int vcu;
  __device__ __forceinline__ explicit StaticOrder(int grid,int block):vcu((block%8)*(grid/8)+block/8){}
  __device__ __forceinline__ bool next(int i,AttnUnit&u)const{ if(i>=4)return false; const int s=vcu&7; u.bh=vcu>>3; u.qb=(i==0)?s:(i==1)?15-s:(i==2)?16+s:31-s; return true; }
  __device__ __forceinline__ bool next_band(int i,AttnUnit&u)const{ if(i>=4)return false; u.bh=vcu>>3; u.qb=(vcu&7)+8*i; return true; }
  __device__ __forceinline__ void a_ready(const AttnUnit&)const{}
  __device__ __forceinline__ void done(const AttnUnit&)const{}
};
template<int MODE,class Sched,int THRL=8> __device__ __forceinline__ void attn_phase(char*lds,const AttnTensors&T,const Sched&S){
  AttnUnit u;
  for(int i=0;(MODE==0?S.next(i,u):S.next_band(i,u));++i){ attn_unit<MODE,THRL>(u.bh/NHEAD,u.bh%NHEAD,u.qb,T.Q,T.K,T.V,T.O,lds,T.KX,T.relb+(MODE==1?(u.bh%NHEAD)*257:0)); }
}
#undef SBAR
#undef WAIT_BAR
}
namespace cg = cooperative_groups;
constexpr int NWAVES = 8;
#ifndef MK_PER_PHASE
#define MK_PER_PHASE 0
#endif
constexpr int N_PHASES = 12;
constexpr int MP = 16384, MS = 512, MT = MP + MS, DMODEL = 1024, DFF = 2816, NH = 16, SEQL = 8192;
constexpr int PAST = 1024, BPAST = 512, DECB = 32, DECT = 16;
constexpr size_t O_YP = 0, O_YS = 16777216, O_AKP = 17301504, O_AVP = 34078720, O_ALFP = 50855936, O_BKP = 51118080, O_BVP = 52166656,
                 O_AKS = 53215232, O_AVS = 53739520, O_ALFS = 54263808, O_BKS = 54272000, O_BVS = 71049216, O_END = 87826432;
constexpr size_t MiB = 1u << 20;
constexpr size_t WS_WQKV0 = 2 * MiB, WS_WO0 = 8 * MiB, WS_WGU0 = 10 * MiB, WS_WD0 = 21 * MiB, WS_WKVQ = 27 * MiB, WS_WO1 = 33 * MiB, WS_WGU1 = 35 * MiB, WS_WD1 = 46 * MiB;
constexpr size_t WS_SSP = 52 * MiB, SSP_STRIDE = 2 * MiB;
constexpr size_t WS_GS = 62 * MiB;
constexpr size_t WS_KX = 64 * MiB;
constexpr size_t WS_QO = 72 * MiB, WS_KB = 105 * MiB, WS_VB = 138 * MiB, WS_HB = 171 * MiB, WS_ACT = 204 * MiB, WS_END = 296 * MiB;
static_assert(WS_ACT + (size_t)MT * DFF * 2 <= WS_END && WS_QO + (size_t)MT * DMODEL * 2 <= WS_KB, "d_ws map");
constexpr int RING_BYTES = 131072, LDS_BYTES = 147456;
static_assert(attn_body::ATTN_LDS_BYTES <= RING_BYTES, "attention LDS");

#define GAS __attribute__((address_space(1)))
#define LAS __attribute__((address_space(3)))
typedef unsigned short bf16;
typedef unsigned v4u __attribute__((ext_vector_type(4)));
typedef float f32x4 __attribute__((ext_vector_type(4)));
typedef short bf16x8 __attribute__((ext_vector_type(8)));
#define LDS_WAIT() asm volatile("s_waitcnt lgkmcnt(0)" ::: "memory")
__device__ __forceinline__ unsigned f2bf(float f) { unsigned u = __builtin_bit_cast(unsigned, f); return (u + 0x7fffu + ((u >> 16) & 1u)) >> 16; }
__device__ __forceinline__ unsigned pk2(float lo, float hi) { return f2bf(lo) | (f2bf(hi) << 16); }
__device__ __forceinline__ float bf2f(unsigned short b) { return __uint_as_float((unsigned)b << 16); }

__device__ __forceinline__ void p0_transpose_item(const float* W, int ldw, int csrc, int k0, const float* gain, bf16* WT, int K, int drow, LAS float* scr, int lane) {
    float wv[32]; const float gl = gain ? gain[k0 + lane] : 1.f;
#pragma unroll
    for (int i = 0; i < 32; ++i) wv[i] = W[(size_t)(k0 + 2 * i + (lane >> 5)) * ldw + csrc + (lane & 31)];
#pragma unroll
    for (int i = 0; i < 32; ++i) { const int kk = 2 * i + (lane >> 5); scr[kk * 33 + (lane & 31)] = wv[i] * __shfl(gl, kk); }
    LDS_WAIT(); asm volatile("" ::: "memory");
    const int c = lane & 7;
#pragma unroll
    for (int j = 0; j < 4; ++j) { const int n = (lane >> 3) + 8 * j; const LAS float* s = scr + (8 * c) * 33 + n;
        v4u o; o.x = pk2(s[0 * 33], s[1 * 33]); o.y = pk2(s[2 * 33], s[3 * 33]); o.z = pk2(s[4 * 33], s[5 * 33]); o.w = pk2(s[6 * 33], s[7 * 33]);
        *(v4u*)(WT + (size_t)(drow + n) * K + k0 + 8 * c) = o; }
    LDS_WAIT(); asm volatile("" ::: "memory");
}
struct KArgs { const float* in[20]; float* out; unsigned char* ws; int ph_lo, ph_hi; };

__device__ __forceinline__ void p0_weight_item(const KArgs& a, int it, LAS float* scr, int lane) {
    unsigned char* ws = a.ws;
    constexpr int I_QKV = 16 * 96, I_O = 16 * 32, I_GU = 16 * 176, I_D = 44 * 32, I_Q1 = 16 * 32, I_KV = 16 * 64;
    const float* W; int ldw, ncols, K, roff = 0; const float* gain = nullptr; bf16* dst; bool perm = false;
    int r = it;
    if (r < I_QKV) { W = a.in[8]; ldw = 3088; ncols = 3072; K = 1024; gain = a.in[7]; dst = (bf16*)(ws + WS_WQKV0); }
    else if ((r -= I_QKV) < I_O) { W = a.in[10]; ldw = 1024; ncols = 1024; K = 1024; dst = (bf16*)(ws + WS_WO0); }
    else if ((r -= I_O) < I_GU) { W = a.in[17]; ldw = 5632; ncols = 5632; K = 1024; gain = a.in[16]; dst = (bf16*)(ws + WS_WGU0); perm = true; }
    else if ((r -= I_GU) < I_D) { W = a.in[18]; ldw = 1024; ncols = 1024; K = 2816; dst = (bf16*)(ws + WS_WD0); }
    else if ((r -= I_D) < I_Q1) { W = a.in[11]; ldw = 1024; ncols = 1024; K = 1024; gain = a.in[7] + 1024; dst = (bf16*)(ws + WS_WKVQ); }
    else if ((r -= I_Q1) < I_KV) { W = a.in[15]; ldw = 2048; ncols = 2048; K = 1024; gain = a.in[14]; dst = (bf16*)(ws + WS_WKVQ); roff = 1024; }
    else if ((r -= I_KV) < I_O) { W = a.in[13]; ldw = 1024; ncols = 1024; K = 1024; dst = (bf16*)(ws + WS_WO1); }
    else if ((r -= I_O) < I_GU) { W = a.in[17] + (size_t)1024 * 5632; ldw = 5632; ncols = 5632; K = 1024; gain = a.in[16] + 1024; dst = (bf16*)(ws + WS_WGU1); perm = true; }
    else { r -= I_GU; W = a.in[18] + (size_t)2816 * 1024; ldw = 1024; ncols = 1024; K = 2816; dst = (bf16*)(ws + WS_WD1); }
    const int nblk = ncols / 32, kb = r / nblk, nb = r % nblk, n0 = 32 * nb;
    int drow = roff + n0;
    if (perm) { drow = n0 < 2816 ? 256 * (n0 / 128) + (n0 % 128) : 256 * ((n0 - 2816) / 128) + 128 + ((n0 - 2816) % 128); }
    p0_transpose_item(W, ldw, n0, 64 * kb, gain, dst, K, drow, scr, lane);
}
constexpr int P0_FIRST = 16 * 96, P0_SECOND = P0_FIRST + 16 * 32 + 16 * 176 + 44 * 32 + 16 * 32 + 16 * 64;
constexpr int P0_NITEMS = 16 * 96 + 16 * 32 + 16 * 176 + 44 * 32 + 16 * 32 + 16 * 64 + 16 * 32 + 16 * 176 + 44 * 32;

__device__ __forceinline__ void p0_row_group(const KArgs& a, int g, const LAS unsigned char* wf, int lane) {
    const int fr = lane & 15, fq = lane >> 4;
    const int row = g * 16 + fr;
    const float* xr = (g < 1024 ? a.in[0] + (size_t)row * 1024 : a.in[1] + (size_t)(row - MP) * 1024) + 8 * fq;
    bf16* hb = (bf16*)(a.ws + WS_HB) + (size_t)row * 1024 + 8 * fq;
    f32x4 acc = {0.f, 0.f, 0.f, 0.f}; float ss = 0.f;
#pragma unroll 4
    for (int ks = 0; ks < 32; ++ks) {
        const f32x4 x0 = *(const f32x4*)(xr + 32 * ks), x1 = *(const f32x4*)(xr + 32 * ks + 4);
        ss += (x0[0] * x0[0] + x0[1] * x0[1]) + (x0[2] * x0[2] + x0[3] * x0[3]) + (x1[0] * x1[0] + x1[1] * x1[1]) + (x1[2] * x1[2] + x1[3] * x1[3]);
        v4u w; w.x = pk2(x0[0], x0[1]); w.y = pk2(x0[2], x0[3]); w.z = pk2(x1[0], x1[1]); w.w = pk2(x1[2], x1[3]);
        *(v4u*)(hb + 32 * ks) = w;
        const bf16x8 bfrag = *(const LAS bf16x8*)(wf + (ks * 64 + lane) * 16);
        acc = __builtin_amdgcn_mfma_f32_16x16x32_bf16(bfrag, __builtin_bit_cast(bf16x8, w), acc, 0, 0, 0);
    }
    ss += __shfl_xor(ss, 16); ss += __shfl_xor(ss, 32);
    float* ssp = (float*)(a.ws + WS_SSP) + (size_t)row * 16 + 4 * fq;
    *(f32x4*)ssp = (f32x4){fq == 0 ? ss : 0.f, 0.f, 0.f, 0.f};
    const float rstd = 1.0f / sqrtf(ss * (1.0f / 1024.0f) + 1e-6f);
    const f32x4 bf = *(const f32x4*)(a.in[9] + 4 * fq);
    f32x4 lf;
#pragma unroll
    for (int e = 0; e < 4; ++e) { const float z = acc[e] * rstd + bf[e]; lf[e] = fminf(z, 0.f) - log1pf(expf(-fabsf(z))); }
    float* lo = (g < 1024 ? a.out + O_ALFP + (size_t)row * 16 : a.out + O_ALFS + (size_t)(row - MP) * 16) + 4 * fq;
    *(f32x4*)lo = lf;
    if (g < 1024) {
#pragma unroll
        for (int o = 1; o < 16; o <<= 1) { lf[0] += __shfl_xor(lf[0], o); lf[1] += __shfl_xor(lf[1], o); lf[2] += __shfl_xor(lf[2], o); lf[3] += __shfl_xor(lf[3], o); }
        if (fr == 0) *(f32x4*)((float*)(a.ws + WS_GS) + g * 16 + 4 * fq) = lf;
    }
}

__device__ __forceinline__ void p1_scan(const KArgs& a, int v, LAS float* red, int tid) {
    const int batch = v >> 7, g0 = batch * 512, g1 = 4 * v, h = tid & 15, part = tid >> 4;
    const float* gs = (const float*)(a.ws + WS_GS);
    float s = 0.f;
    for (int g = g0 + part; g < g1; g += 32) s += gs[g * 16 + h];
    red[part * 16 + h] = s;
    __syncthreads();
    LAS float* lfs = red + 512;
    for (int e = tid; e < 1024; e += 512) lfs[e] = a.out[O_ALFP + (size_t)(64 * v) * 16 + e];
    __syncthreads();
    if (tid < 16) {
        float cum = 0.f;
        for (int p = 0; p < 32; ++p) cum += red[p * 16 + tid];
        bf16* kx = (bf16*)(a.ws + WS_KX) + ((size_t)(batch * 16 + tid) * 2 * SEQL) * 8;
        const int t0 = (64 * v) & (SEQL - 1);
#pragma unroll 8
        for (int r = 0; r < 64; ++r) {
            cum += lfs[r * 16 + tid];
            const float c = -cum * 1.4426950408889634f;
            const unsigned c1 = f2bf(c); const float r1 = c - bf2f((unsigned short)c1);
            const unsigned c2 = f2bf(r1); const float r2 = r1 - bf2f((unsigned short)c2);
            const unsigned c3 = f2bf(r2);
            *(v4u*)(kx + (size_t)(t0 + r) * 8) = (v4u){c1 | (c2 << 16), c3 | 0x3F800000u, 0x3F803F80u, 0u};
            *(v4u*)(kx + (size_t)(SEQL + t0 + r) * 8) = (v4u){0u, 0u, 0u, 0u};
        }
    }
    __syncthreads();
}

typedef float sf32x4 __attribute__((ext_vector_type(4)));
__device__ __forceinline__ bf16x8 pack8(const sf32x4 a, const sf32x4 b) {
    v4u w; w.x = attn_body::cvtpk_s(a[0], a[1]); w.y = attn_body::cvtpk_s(a[2], a[3]); w.z = attn_body::cvtpk_s(b[0], b[1]); w.w = attn_body::cvtpk_s(b[2], b[3]); return __builtin_bit_cast(bf16x8, w); }
template <int MODE> __device__ __forceinline__ void sample_attn(const KArgs& a, int b, int h, LAS unsigned char* lds, int tid) {
    constexpr int NC = MODE == 0 ? PAST : BPAST, NK = NC + 16, NKP = 1056, VRS = 80;
    constexpr float L2E = 1.4426950408889634f;
    LAS float* S = (LAS float*)lds;
    LAS float* bias = S + 16 * NKP;
    LAS float* rl = bias + NKP;
    LAS unsigned char* VT = (LAS unsigned char*)(rl + 16);
    const int lane = tid & 63, wid = __builtin_amdgcn_readfirstlane(tid >> 6), fr = lane & 15, fq = lane >> 4;
    const float* ck = a.in[MODE == 0 ? 2 : 5]; const float* cv = a.in[MODE == 0 ? 3 : 6];
    const float* nk = a.out + (MODE == 0 ? O_AKS + (size_t)(b * 16) * 1024 : O_BKS + (size_t)(b * 512 + 496) * 1024) + h * 64;
    const float* nv = a.out + (MODE == 0 ? O_AVS + (size_t)(b * 16) * 1024 : O_BVS + (size_t)(b * 512 + 496) * 1024) + h * 64;
    const bf16* qo = (const bf16*)(a.ws + WS_QO) + (size_t)(MP + b * 16) * 1024 + h * 64;
    const bf16x8 qf0 = *(const bf16x8*)(qo + (size_t)fr * 1024 + 8 * fq), qf1 = *(const bf16x8*)(qo + (size_t)fr * 1024 + 32 + 8 * fq);
    if (MODE == 0) {
        for (int j = tid; j < NK; j += 512) bias[j] = j < NC ? a.in[4][((size_t)b * NC + j) * 16 + h] : a.out[O_ALFS + (size_t)(b * 16 + (j - NC)) * 16 + h];
    } else {
        if (tid < 257) bias[tid] = a.in[12][h * 257 + tid] * L2E;
    }
    __syncthreads();
    if (MODE == 0) {
        if (wid == 0) { float carry = 0.f;
            for (int c = 0; c < (NK + 63) / 64; ++c) { const int j = 64 * c + lane; float v = j < NK ? bias[j] : 0.f;
#pragma unroll
                for (int o = 1; o < 64; o <<= 1) { const float t = __shfl_up(v, o); if (lane >= o) v += t; }
                v += carry; carry = __shfl(v, 63); if (j < NK) bias[j] = -v * L2E; } }
        __syncthreads();
    }
#pragma unroll 2
    for (int blk = wid; blk < NK / 16; blk += 8) {
        const int j0 = 16 * blk; const bool isnew = j0 >= NC;
        const float* kr = (isnew ? nk + (size_t)(j0 - NC + fr) * 1024 : ck + (((size_t)b * NC + j0 + fr) * 16 + h) * 64) + 8 * fq;
        const sf32x4 x0 = *(const sf32x4*)kr, x1 = *(const sf32x4*)(kr + 4), x2 = *(const sf32x4*)(kr + 32), x3 = *(const sf32x4*)(kr + 36);
        if (MODE == 1 && !isnew && j0 >= 16) { float* ok = a.out + O_BKS + (((size_t)b * 512 + (j0 + fr - 16)) * 16 + h) * 64 + 8 * fq;
            *(sf32x4*)ok = x0; *(sf32x4*)(ok + 4) = x1; *(sf32x4*)(ok + 32) = x2; *(sf32x4*)(ok + 36) = x3; }
        sf32x4 acc = {0.f, 0.f, 0.f, 0.f};
        acc = __builtin_amdgcn_mfma_f32_16x16x32_bf16(pack8(x0, x1), qf0, acc, 0, 0, 0);
        acc = __builtin_amdgcn_mfma_f32_16x16x32_bf16(pack8(x2, x3), qf1, acc, 0, 0, 0);
        if (MODE == 0) { const sf32x4 bv = *(const LAS sf32x4*)(bias + j0 + 4 * fq); acc = acc + bv;
            if (isnew) {
#pragma unroll
                for (int e = 0; e < 4; ++e) if (4 * fq + e > fr) acc[e] = -INFINITY; } }
        else {
#pragma unroll
            for (int e = 0; e < 4; ++e) { const int d = 512 + fr - (j0 + 4 * fq + e); acc[e] += bias[(d < 128 ? d : 128) + 128]; } }
        *(LAS sf32x4*)(S + fr * NKP + j0 + 4 * fq) = acc;
    }
    __syncthreads();
    for (int q = 2 * wid; q < 2 * wid + 2; ++q) { float m = -INFINITY;
        for (int j = lane; j < NK; j += 64) m = fmaxf(m, S[q * NKP + j]);
#pragma unroll
        for (int o = 1; o < 64; o <<= 1) m = fmaxf(m, __shfl_xor(m, o));
        float l = 0.f;
        for (int j = lane; j < NK; j += 64) { const float p = __builtin_amdgcn_exp2f(S[q * NKP + j] - m); S[q * NKP + j] = p; l += p; }
#pragma unroll
        for (int o = 1; o < 64; o <<= 1) l += __shfl_xor(l, o);
        if (lane == 0) rl[q] = 1.0f / l; }
    __syncthreads();
    { LAS unsigned char* vt = VT + wid * (64 * VRS);
        sf32x4 o[4];
#pragma unroll
        for (int db = 0; db < 4; ++db) o[db] = (sf32x4){0.f, 0.f, 0.f, 0.f};
        const int kr = lane >> 4, d4 = lane & 15;
        const int nit = NC / 256 + (wid == 7 ? 1 : 0);
        for (int it = 0; it < nit; ++it) {
            const bool isnew = it == NC / 256; const int c = isnew ? NC / 32 : wid + 8 * it;
            const int j0 = 32 * c; sf32x4 v4[8];
#pragma unroll
            for (int i = 0; i < 8; ++i) { const int key = 8 * (i >> 1) + 2 * kr + (i & 1);
                if (isnew) v4[i] = key < 16 ? *(const sf32x4*)(nv + (size_t)key * 1024 + 4 * d4) : (sf32x4){0.f, 0.f, 0.f, 0.f};
                else v4[i] = *(const sf32x4*)(cv + (((size_t)b * NC + j0 + key) * 16 + h) * 64 + 4 * d4); }
            if (MODE == 1 && !isnew) {
#pragma unroll
                for (int i = 0; i < 8; ++i) { const int j = j0 + 8 * (i >> 1) + 2 * kr + (i & 1); if (j >= 16) *(sf32x4*)(a.out + O_BVS + (((size_t)b * 512 + (j - 16)) * 16 + h) * 64 + 4 * d4) = v4[i]; } }
#pragma unroll
            for (int i = 0; i < 8; i += 2)
#pragma unroll
                for (int e = 0; e < 4; ++e) *(LAS unsigned*)(vt + (4 * d4 + e) * VRS + (8 * (i >> 1) + 2 * kr) * 2) = attn_body::cvtpk_s(v4[i][e], v4[i + 1][e]);
            bf16x8 pf;
            if (isnew && fq >= 2) pf = (bf16x8){0, 0, 0, 0, 0, 0, 0, 0};
            else { const sf32x4 p0 = *(const LAS sf32x4*)(S + fr * NKP + j0 + 8 * fq), p1 = *(const LAS sf32x4*)(S + fr * NKP + j0 + 8 * fq + 4); pf = pack8(p0, p1); }
#pragma unroll
            for (int db = 0; db < 4; ++db) { const bf16x8 vf = *(const LAS bf16x8*)(vt + (16 * db + fr) * VRS + fq * 16);
                o[db] = __builtin_amdgcn_mfma_f32_16x16x32_bf16(pf, vf, o[db], 0, 0, 0); }
        }
        LAS float* op = (LAS float*)vt;
#pragma unroll
        for (int db = 0; db < 4; ++db)
#pragma unroll
            for (int e = 0; e < 4; ++e) op[(4 * fq + e) * 64 + 16 * db + fr] = o[db][e]; }
    __syncthreads();
    for (int e = tid; e < 1024; e += 512) { const int q = e >> 6, d = e & 63; float o = 0.f;
#pragma unroll
        for (int w = 0; w < 8; ++w) o += ((const LAS float*)(VT + w * (64 * VRS)))[q * 64 + d];
        ((bf16*)(a.ws + WS_QO))[(size_t)(MP + b * 16 + q) * 1024 + h * 64 + d] = (bf16)f2bf(o * rl[q]); }
    __syncthreads();
}

#define RLX_AGENT __ATOMIC_RELAXED, __HIP_MEMORY_SCOPE_AGENT
#define XB_TMO      128
#define XB_XCNT(j)  (256  + 64 * (j))
#define XB_XSUB(j)  (1280 + 64 * (j))
#define XB_XGEN(j)  (2304 + 64 * (j))
#define XB_TOP      3328
#define XB_TOPGEN   3392
#define XCD_BAR_WORDS 3456
#define XB_SPIN_CAP (1u << 18)

__device__ __forceinline__ unsigned xb_ld(unsigned* p)              { return __hip_atomic_load(p, __ATOMIC_RELAXED, __HIP_MEMORY_SCOPE_AGENT); }
__device__ __forceinline__ unsigned xb_add(unsigned* p, unsigned v) { return __hip_atomic_fetch_add(p, v, __ATOMIC_RELAXED, __HIP_MEMORY_SCOPE_AGENT); }
__device__ __forceinline__ unsigned xb_xcc_id() { return (unsigned)__builtin_amdgcn_s_getreg((3 << 11) | 20) & 0xFu; }
#define XB_SPIN(cond, bar) do { unsigned _sp = 0; while (cond) { __builtin_amdgcn_s_sleep(1); \
    if ((++_sp & 255u) == 0u) { if (xb_ld(&(bar)[XB_TMO])) break; if (_sp > XB_SPIN_CAP) { atomicAdd(&(bar)[XB_TMO], 1u); break; } } } } while (0)

struct XcdBarrier {
    unsigned* bar; unsigned x;
    volatile LAS unsigned* st;
};

__device__ __forceinline__ XcdBarrier xcd_barrier_post(unsigned* bar, volatile LAS unsigned* st) {
    XcdBarrier b; b.bar = bar; b.x = xb_xcc_id(); b.st = st;
    if (threadIdx.x == 0) (void)xb_add(&bar[XB_XCNT(b.x)], 1u);
    return b;
}
__device__ __forceinline__ void xcd_barrier_complete(unsigned* bar, unsigned x, unsigned& nloc, unsigned& nx) {
    const unsigned G = gridDim.x * gridDim.y * gridDim.z;
    unsigned sum, cnt, mine, sp = 0u;
    for (;;) {
        sum = 0u; cnt = 0u; mine = 0u;
#pragma unroll
        for (unsigned j = 0; j < 16; ++j) { const unsigned c = xb_ld(&bar[XB_XCNT(j)]); sum += c; cnt += (c > 0u) ? 1u : 0u; mine = (j == x) ? c : mine; }
        if (sum == G) break;
        __builtin_amdgcn_s_sleep(1);
        if ((++sp & 255u) == 0u) { if (xb_ld(&bar[XB_TMO])) break; if (sp > XB_SPIN_CAP) { atomicAdd(&bar[XB_TMO], 1u); break; } }
    }
    nloc = mine > 0u ? mine : 1u; nx = cnt > 0u ? cnt : 1u;
}

__device__ __forceinline__ void xcd_barrier(const XcdBarrier& b) {
    asm volatile("s_waitcnt vmcnt(0)" ::: "memory");
    __syncthreads();
    if (threadIdx.x == 0) {
        unsigned* bar = b.bar;
        __builtin_amdgcn_s_waitcnt(0);
        unsigned nloc = b.st[0], nx = b.st[1];
        if (nloc == 0u) { xcd_barrier_complete(bar, b.x, nloc, nx); b.st[0] = nloc; b.st[1] = nx; }
        const unsigned old = xb_add(&bar[XB_XSUB(b.x)], 1u);
        const unsigned gen = old / nloc;
        if (old + 1u == (gen + 1u) * nloc) {
            __builtin_amdgcn_fence(__ATOMIC_RELEASE, "agent");
            asm volatile("s_waitcnt vmcnt(0)" ::: "memory");
            const unsigned og = xb_add(&bar[XB_TOP], 1u);
            const unsigned tg = og / nx;
            if (og + 1u == (tg + 1u) * nx) xb_add(&bar[XB_TOPGEN], 1u);
            else XB_SPIN(xb_ld(&bar[XB_TOPGEN]) == tg, bar);
            __builtin_amdgcn_fence(__ATOMIC_ACQUIRE, "agent");
            xb_add(&bar[XB_XGEN(b.x)], 1u);
            asm volatile("s_waitcnt vmcnt(0)" ::: "memory");
        } else {
            XB_SPIN(xb_ld(&bar[XB_XGEN(b.x)]) == gen, bar);
            __builtin_amdgcn_fence(__ATOMIC_ACQUIRE, "agent");
            asm volatile("s_waitcnt vmcnt(0)" ::: "memory");
        }
    }
    __syncthreads();
}

__device__ __forceinline__ KArgs load_args() {
#if !defined(__HIP_DEVICE_COMPILE__)
    return KArgs{};
#else
    auto p = __builtin_amdgcn_kernarg_segment_ptr(); asm volatile("" : "+s"(p)); return *(const __attribute__((address_space(4))) KArgs*)p;
#endif
}
__global__ void __launch_bounds__(NWAVES * 64, 2) fwd_mega(KArgs args_unused) {
    extern __shared__ __attribute__((aligned(16))) unsigned char lds[];
    LAS unsigned char* L = (LAS unsigned char*)lds;
    const int G = gridDim.x, bx = blockIdx.x, vcu = (G % 8 == 0) ? (bx % 8) * (G / 8) + bx / 8 : bx;
    int lo, hi; XcdBarrier xbar;
    { const KArgs a0 = load_args(); lo = a0.ph_lo; hi = a0.ph_hi;
      volatile LAS unsigned* st = (volatile LAS unsigned*)(L + RING_BYTES + 1024); if (threadIdx.x < 32) st[threadIdx.x] = 0u; __syncthreads();
      xbar = xcd_barrier_post((unsigned*)a0.ws + 4096, st); }
    if (hi > N_PHASES) cg::this_grid().sync();
#ifndef PHMASK
#define PHMASK 0xfff
#endif
#define IN(k) (((PHMASK >> (k)) & 1) && lo <= (k) && (k) < hi)
#define SEAM(k) do { if (IN(k) && IN((k) + 1)) { xcd_barrier(xbar); if ((PROBE_MASK >> 14) & 1) xcd_barrier(xbar); } } while (0)
#ifndef PROBE_MASK
#define PROBE_MASK 0
#endif
#define SEG_BEGIN(k) unsigned long long seg_t0_ = 0; if ((PROBE_MASK >> (k)) & 1) seg_t0_ = __builtin_amdgcn_s_memrealtime()
#define SEG_END(k) do { if ((PROBE_MASK >> (k)) & 1) { const unsigned long long t1_ = __builtin_amdgcn_s_memrealtime(), d_ = t1_ - seg_t0_; while (__builtin_amdgcn_s_memrealtime() - t1_ < d_) __builtin_amdgcn_s_sleep(8); } } while (0)
#define PHASE_ARGS() int tid = threadIdx.x; asm volatile("" : "+v"(tid)); const int lane = tid & 63, wave = __builtin_amdgcn_readfirstlane(tid >> 6); (void)lane; (void)wave; const KArgs args = load_args(); unsigned char* ws = args.ws; float* out = args.out; (void)out; \
    bf16* QO = (bf16*)(ws + WS_QO); bf16* KB = (bf16*)(ws + WS_KB); bf16* VB = (bf16*)(ws + WS_VB); bf16* HB = (bf16*)(ws + WS_HB); bf16* ACT = (bf16*)(ws + WS_ACT); (void)QO; (void)KB; (void)VB; (void)HB; (void)ACT
#define SSPN(i) ((float*)(ws + WS_SSP + (size_t)(i) * SSP_STRIDE))
#define SOFT_P(s_) ((unsigned*)ws + 8192 + 2048 * (s_))
#define SOFT_S(s_) ((unsigned*)ws + 8192 + 2048 * (s_) + 1088)
#define STW ((volatile LAS unsigned*)(L + RING_BYTES + 1024))
#define LARR ((LAS unsigned*)(L + RING_BYTES + 1024 + 64))

    if (IN(0)) {
        PHASE_ARGS();
        SEG_BEGIN(0);
        LAS unsigned char* wf = L + 98304;
        for (int e = tid; e < 32 * 64; e += NWAVES * 64) { const int ks = e >> 6, ln = e & 63, h = ln & 15, kq = ln >> 4, k0 = 32 * ks + 8 * kq; float v[8];
#pragma unroll
            for (int i = 0; i < 8; ++i) v[i] = args.in[8][(size_t)(k0 + i) * 3088 + 3072 + h] * args.in[7][k0 + i];
            *(LAS v4u*)(wf + e * 16) = (v4u){pk2(v[0], v[1]), pk2(v[2], v[3]), pk2(v[4], v[5]), pk2(v[6], v[7])}; }
        __syncthreads();
        { const int g = wave * G + vcu; if (g < MT / 16) p0_row_group(args, g, wf, lane); }
        LAS float* scr = (LAS float*)(L + wave * 8704);
        const int gw = vcu * NWAVES + wave, NGW = G * NWAVES;
        for (int it = gw; it < P0_FIRST; it += NGW) p0_weight_item(args, it, scr, lane);
        SEG_END(0);
    }
    SEAM(0);
    if (IN(1)) {
        PHASE_ARGS();
        SEG_BEGIN(1);
        p1_scan(args, vcu, (LAS float*)L, tid);
        pg8::Gemm g{HB, (const bf16*)(ws + WS_WQKV0), MT, 3072, 1024}; pg8::StaticOrder S; S.init(MT, 3072, G, bx);
        pg8::EpiQKV E{QO, KB, VB, out + O_AKP, out + O_AVP, out + O_AKS, out + O_AVS, SSPN(0), 0, attn_body::C2};
        pg8::gemm_phase<pg8::EpiQKV, pg8::StaticOrder, PG8_ALIGN, PG8_SP2>(L, g, S, E);
        { const int n4 = (MT / 256) * 12 - 3 * G;
          if (n4 >= 0 && n4 < G && bx >= n4) { LAS float* scr = (LAS float*)(L + wave * 8704); const int cw = (bx - n4) * NWAVES + wave, ncw = (G - n4) * NWAVES;
              for (int it = P0_FIRST + cw; it < P0_SECOND; it += ncw) p0_weight_item(args, it, scr, lane); } }
        SEG_END(1);
    }
    SEAM(1);
    if (IN(2)) {
        PHASE_ARGS();
        SEG_BEGIN(2);
        { SEG_BEGIN(12); for (int i = 0; i < 2; ++i) { const int u = 2 * vcu + i; if (u < DECB * NH) sample_attn<0>(args, u >> 4, u & 15, L, tid); } SEG_END(12); }
        const attn_body::AttnTensors AT{(const attn_body::bf16*)QO, (const attn_body::bf16*)KB, (const attn_body::bf16*)VB, (attn_body::bf16*)QO, (const attn_body::bf16*)(ws + WS_KX), args.in[12]};
        const attn_body::StaticOrder S(G, bx);
        attn_body::attn_phase<0, attn_body::StaticOrder>((char*)lds, AT, S);
        SEG_END(2);
    }
    SEAM(2);
    if (IN(3)) {
        PHASE_ARGS();
        SEG_BEGIN(3);
        pg8::Gemm g{QO, (const bf16*)(ws + WS_WO0), MT, 1024, 1024}; pg8::FlexOrder S; S.init(4, G, bx, 0, 0); S.arrP = SOFT_P(0); S.arrS = SOFT_S(0); S.larr = LARR; S.stw = STW;
        pg8::EpiRes E{args.in[0], args.in[1], out, HB, SSPN(1)};
        pg8::gemm_phase<pg8::EpiRes, pg8::FlexOrder, PG8_ALIGN, PG8_SP2>(L, g, S, E);
        SEG_END(3);
    }
    if (IN(4)) {
        PHASE_ARGS();
        SEG_BEGIN(4);
        pg8::Gemm g{HB, (const bf16*)(ws + WS_WGU0), MT, 5632, 1024}; pg8::FlexOrder S; S.init(22, G, bx, 0, 0, 176);     S.waitP = SOFT_P(0) + 1024; S.waitS = SOFT_S(0); S.tgtP = STW[1]; S.tgtS = 8u;
        pg8::EpiSwiGLU E{ACT, SSPN(1)};
        pg8::gemm_phase<pg8::EpiSwiGLU, pg8::FlexOrder, PG8_ALIGN, PG8_SP2>(L, g, S, E);
        SEG_END(4);
    }
    SEAM(4);
    if (IN(5)) {
        PHASE_ARGS();
        SEG_BEGIN(5);
        pg8::Gemm g{ACT, (const bf16*)(ws + WS_WD0), MT, 1024, 2816}; pg8::FlexOrder S; S.init(4, G, bx, 0, 0); S.arrP = SOFT_P(1); S.arrS = SOFT_S(1); S.larr = LARR; S.stw = STW;
        pg8::EpiRes E{out, out + (size_t)MP * 1024, out, HB, SSPN(2)};
        pg8::gemm_phase<pg8::EpiRes, pg8::FlexOrder, PG8_ALIGN, PG8_SP2>(L, g, S, E);
        SEG_END(5);
    }
    if (IN(6)) {
        PHASE_ARGS();
        SEG_BEGIN(6);
        pg8::Gemm g{HB, (const bf16*)(ws + WS_WKVQ), MT, 3072, 1024}; pg8::FlexOrder S; S.init(12, G, bx, 8, 1); S.waitP = SOFT_P(1) + 1024; S.waitS = SOFT_S(1); S.tgtP = STW[1]; S.tgtS = 8u;
        pg8::EpiQKV E{QO, KB, VB, out + O_BKP, out + O_BVP, out + O_BKS, out + O_BVS, SSPN(2), 1, attn_body::C2};
        pg8::gemm_phase<pg8::EpiQKV, pg8::FlexOrder, PG8_ALIGN, PG8_SP2>(L, g, S, E);
        { const int n4 = 8 + (784 - 3 * (G - 8));
          if (n4 >= 0 && n4 < G && bx >= n4) { LAS float* scr = (LAS float*)(L + wave * 8704); const int cw = (bx - n4) * NWAVES + wave, ncw = (G - n4) * NWAVES;
              for (int it = P0_SECOND + cw; it < P0_NITEMS; it += ncw) p0_weight_item(args, it, scr, lane); } }
        SEG_END(6);
    }
    SEAM(6);
    if (IN(7)) {
        PHASE_ARGS();
        SEG_BEGIN(7);
        { SEG_BEGIN(13); for (int i = 0; i < 2; ++i) { const int u = 2 * vcu + i; if (u < DECB * NH) sample_attn<1>(args, u >> 4, u & 15, L, tid); } SEG_END(13); }
        const attn_body::AttnTensors AT{(const attn_body::bf16*)QO, (const attn_body::bf16*)KB, (const attn_body::bf16*)VB, (attn_body::bf16*)QO, (const attn_body::bf16*)(ws + WS_KX), args.in[12]};
        const attn_body::StaticOrder S(G, bx);
        attn_body::attn_phase<1, attn_body::StaticOrder>((char*)lds, AT, S);
        SEG_END(7);
    }
    SEAM(7);
    if (IN(8)) {
        PHASE_ARGS();
        SEG_BEGIN(8);
        pg8::Gemm g{QO, (const bf16*)(ws + WS_WO1), MT, 1024, 1024}; pg8::FlexOrder S; S.init(4, G, bx, 0, 0); S.arrP = SOFT_P(2); S.arrS = SOFT_S(2); S.larr = LARR; S.stw = STW;
        pg8::EpiRes E{out, out + (size_t)MP * 1024, out, HB, SSPN(3)};
        pg8::gemm_phase<pg8::EpiRes, pg8::FlexOrder, PG8_ALIGN, PG8_SP2>(L, g, S, E);
        SEG_END(8);
    }
    if (IN(9)) {
        PHASE_ARGS();
        SEG_BEGIN(9);
        pg8::Gemm g{HB, (const bf16*)(ws + WS_WGU1), MT, 5632, 1024}; pg8::GuDeal S; S.init2(G, bx, 192); S.waitP = SOFT_P(2) + 1024; S.waitS = SOFT_S(2); S.tgtP = STW[1]; S.tgtS = 8u; S.arrS = SOFT_S(4); S.larr = LARR; S.stw = STW;
        pg8::EpiSwiGLU E{ACT, SSPN(3)};
        pg8::gemm_phase<pg8::EpiSwiGLU, pg8::GuDeal, PG8_ALIGN, PG8_SP2>(L, g, S, E);
        if (S.cp >= 248) {
            pg8::Gemm g2{ACT, (const bf16*)(ws + WS_WD1), MT, 1024, 2816}; pg8::OneUnitOrder S2{64 + (S.cp - 248) / 4, (S.cp - 248) % 4, SOFT_S(4), 44u};
            pg8::EpiRes E2{out, out + (size_t)MP * 1024, out, HB, SSPN(4)};
            pg8::gemm_phase<pg8::EpiRes, pg8::OneUnitOrder, PG8_ALIGN, PG8_SP2>(L, g2, S2, E2); }
        SEG_END(9);
    }
    SEAM(9);
    if (IN(10)) {
        PHASE_ARGS();
        SEG_BEGIN(10);
        pg8::Gemm g{ACT, (const bf16*)(ws + WS_WD1), MT, 1024, 2816}; pg8::FlexOrder S; S.init(4, G, bx, 0, 0); S.nmain = 256;
        pg8::EpiRes E{out, out + (size_t)MP * 1024, out, HB, SSPN(4)};
        pg8::gemm_phase<pg8::EpiRes, pg8::FlexOrder, PG8_ALIGN, PG8_SP2>(L, g, S, E);
        SEG_END(10);
    }
    SEAM(10);
    if (IN(11)) {
        PHASE_ARGS();
        SEG_BEGIN(11);
        const int gw = vcu * NWAVES + wave, NGW = G * NWAVES; const float* gf = args.in[19]; const float* ssp = SSPN(4);
        f32x4 gv[4];
#pragma unroll
        for (int j = 0; j < 4; ++j) gv[j] = *(const f32x4*)(gf + 256 * j + 4 * lane);
        for (int m = gw; m < MT; m += NGW) {
            float s = 0.f;
#pragma unroll
            for (int j = 0; j < 4; ++j) { const f32x4 p = *(const f32x4*)(ssp + (size_t)m * 16 + 4 * j); s += (p[0] + p[1]) + (p[2] + p[3]); }
            const float rstd = 1.0f / sqrtf(s * (1.0f / 1024.0f) + 1e-6f);
            float* r = out + (size_t)m * 1024 + 4 * lane;
#pragma unroll
            for (int j = 0; j < 4; ++j) { f32x4 v = *(f32x4*)(r + 256 * j); v = v * rstd * gv[j]; *(f32x4*)(r + 256 * j) = v; }
        }
        SEG_END(11);
    }
#undef IN
#undef SEAM
}

extern "C" void kernel_launch(void* const* d_in, const int* in_sizes, int n_in, void* d_out, int out_size, void* d_ws, size_t ws_size, hipStream_t stream) {
    static int grid = 0;
    if (grid == 0) {
        if (n_in != 20 || (size_t)out_size != O_END || ws_size < WS_END) { fprintf(stderr, "kernel_launch: unexpected shapes (n_in %d out %d ws %zu)\n", n_in, out_size, ws_size); grid = -1; return; }
        int dev = 0, cus = 0, per_cu = 0;
        hipGetDevice(&dev); hipDeviceGetAttribute(&cus, hipDeviceAttributeMultiprocessorCount, dev);
        if (hipFuncSetAttribute((const void*)fwd_mega, hipFuncAttributeMaxDynamicSharedMemorySize, LDS_BYTES) != hipSuccess) { fprintf(stderr, "kernel_launch: hipFuncSetAttribute failed\n"); grid = -1; return; }
        if (hipOccupancyMaxActiveBlocksPerMultiprocessor(&per_cu, (const void*)fwd_mega, NWAVES * 64, LDS_BYTES) != hipSuccess || per_cu < 1) { fprintf(stderr, "kernel_launch: occupancy query says %d\n", per_cu); per_cu = 1; }
        (void)hipGetLastError();
        grid = cus * per_cu;
        if (grid != 256) fprintf(stderr, "kernel_launch: grid %d (expected 256)\n", grid);
    }
    if (grid < 0) return;
    if (hipMemsetAsync(d_ws, 0, 131072, stream) != hipSuccess) { fprintf(stderr, "kernel_launch: memset failed\n"); return; }
    KArgs a{};
    for (int i = 0; i < 20; ++i) a.in[i] = (const float*)d_in[i];
    a.out = (float*)d_out; a.ws = (unsigned char*)d_ws;
#if MK_PER_PHASE
    for (int p = 0; p < N_PHASES; ++p) { a.ph_lo = p; a.ph_hi = p + 1; void* kargs[] = {&a};
        hipError_t e = hipLaunchCooperativeKernel((const void*)fwd_mega, dim3(grid), dim3(NWAVES * 64), kargs, LDS_BYTES, stream);
        if (e != hipSuccess) { fprintf(stderr, "kernel_launch: launch %d failed: %s\n", p, hipGetErrorString(e)); break; } }
#else
    a.ph_lo = 0; a.ph_hi = N_PHASES; void* kargs[] = {&a};
    hipError_t e = hipLaunchCooperativeKernel((const void*)fwd_mega, dim3(grid), dim3(NWAVES * 64), kargs, LDS_BYTES, stream);
    if (e != hipSuccess) fprintf(stderr, "kernel_launch: cooperative launch failed: %s (grid %d)\n", hipGetErrorString(e), grid);
#endif
}
```

```cpp
#include <hip/hip_cooperative_groups.h>
#include <hip/hip_runtime.h>
#include <cstdio>
#include <cstdint>
namespace pg8 {
#define PG8_LAS __attribute__((address_space(3)))
typedef unsigned short bf16_t;
typedef short bf16x8 __attribute__((ext_vector_type(8)));
typedef float f32x4 __attribute__((ext_vector_type(4)));
typedef unsigned u32x4 __attribute__((ext_vector_type(4)));
constexpr int BM = 256, BK = 64, HALF = 128, HTB = HALF * BK * 2  , STAGE_BYTES = 8 * HTB, NXCD = 8, WGM = 8;

__host__ __device__ __forceinline__ int lds_byte(int r, int c) { const int st = (r >> 4) * 2 + (c >> 5), rr = r & 15, cc = c & 31, ob = rr * 64 + cc * 2; return st * 1024 + (ob ^ (((ob >> 9) & 1) << 5)); }
__host__ __device__ __forceinline__ void stage_rc(int b, int& R, int& C) { const int st = b / 1024, sb = b % 1024, swz = sb ^ (((sb >> 9) & 1) << 5); R = (st >> 1) * 16 + swz / 64; C = (st & 1) * 32 + (swz % 64) / 2; }
__host__ __device__ __forceinline__ int perm32(int rho) { const int n = rho >> 4, i = rho & 15; return 8 * (i >> 2) + 4 * n + (i & 3); }

struct Unit { int pm, pn; };
struct Gemm { const bf16_t* A; const bf16_t* Bt; int M, N, K; };

struct StaticOrder {
    int nM, nN, nwg, G, c;
    __host__ __device__ void init(int M, int N, int G_, int c_) { nM = M / BM; nN = N / BM; nwg = nM * nN; G = G_; c = c_; }
    __host__ __device__ bool next(int i, Unit& u) const {
        const long L = (long)i * G + c; if (L >= nwg) return false;
        int wgid = (int)L; { const int q = nwg / NXCD, r = nwg % NXCD, xcd = wgid % NXCD, off = wgid / NXCD; wgid = (xcd < r ? xcd * (q + 1) : r * (q + 1) + (xcd - r) * q) + off; }
        const int nig = WGM * nN, gid = wgid / nig, fm = gid * WGM, gsz = (nM - fm) < WGM ? (nM - fm) : WGM;
        u.pm = fm + ((wgid % nig) % gsz); u.pn = (wgid % nig) / gsz; return true;
    }
    __device__ __forceinline__ void a_ready(const Unit&) const {}
    __device__ __forceinline__ void done(const Unit&) const {}
};

struct FlexOrder {
    int nN, nwg, nprompt, G, c, ns, ks, nmain;
    unsigned *arrP, *arrS, *waitP, *waitS; unsigned tgtP, tgtS; PG8_LAS unsigned* larr; volatile PG8_LAS unsigned* stw; mutable int acq;
    __device__ void init(int nN_, int G_, int c_, int ns_, int ks_, int rot = 0) { nN = nN_; nprompt = 64 * nN_; nwg = 66 * nN_; G = G_; c = (c_ + rot) % G_; ns = ns_; ks = ks_; nmain = nwg - ns_ * ks_;
        arrP = arrS = waitP = waitS = nullptr; tgtP = tgtS = 0u; larr = nullptr; stw = nullptr; acq = 0; }
    __device__ bool next(int i, Unit& u) const {
        int L;
        if (c >= ns) { L = i * (G - ns) + (c - ns); if (L >= nmain) return false; } else { if (i >= ks) return false; L = nmain + i * ns + c; }
        if (L < nprompt) { int wgid = L; { const int q = nprompt / NXCD, r = nprompt % NXCD, xcd = wgid % NXCD, off = wgid / NXCD; wgid = (xcd < r ? xcd * (q + 1) : r * (q + 1) + (xcd - r) * q) + off; }
            const int nig = WGM * nN, gid = wgid / nig, fm = gid * WGM, gsz = (64 - fm) < WGM ? (64 - fm) : WGM;
            u.pm = fm + ((wgid % nig) % gsz); u.pn = (wgid % nig) / gsz; }
        else { const int s = L - nprompt; u.pm = 64 + s / nN; u.pn = s % nN; }
        return true;
    }
    __device__ __forceinline__ void a_ready(const Unit& u) const {
        if (!waitP) return;
        const int bit = u.pm >= 64 ? 2 : 1; if (acq & bit) return;
        unsigned* p = bit == 1 ? waitP : waitS; const unsigned tgt = bit == 1 ? tgtP : tgtS; unsigned sp = 0;
        while (__hip_atomic_load(p, __ATOMIC_RELAXED, __HIP_MEMORY_SCOPE_AGENT) < tgt) { __builtin_amdgcn_s_sleep(4); if (++sp > (1u << 22)) break; }
        __builtin_amdgcn_fence(__ATOMIC_ACQUIRE, "agent"); asm volatile("s_waitcnt vmcnt(0)" ::: "memory");
        acq |= bit;
    }
    __device__ __forceinline__ void done(const Unit& u) const {
        if (u.pm >= 64 ? !arrS : !arrP) return;
        asm volatile("s_waitcnt vmcnt(0)" ::: "memory");
        if ((threadIdx.x & 63) == 0) {
            const unsigned old = __hip_atomic_fetch_add(larr, 1u, __ATOMIC_RELAXED, __HIP_MEMORY_SCOPE_WORKGROUP);
            if ((old & 7u) == 7u) {
                if (u.pm >= 64) { __builtin_amdgcn_fence(__ATOMIC_RELEASE, "agent"); asm volatile("s_waitcnt vmcnt(0)" ::: "memory");
                    __hip_atomic_fetch_add(arrS, 1u, __ATOMIC_RELAXED, __HIP_MEMORY_SCOPE_AGENT); }
                else {
                    const unsigned x = (unsigned)__builtin_amdgcn_s_getreg((3 << 11) | 20) & 0xFu, nloc = stw[0];
                    const unsigned o = __hip_atomic_fetch_add(arrP + 64 * x, 1u, __ATOMIC_RELAXED, __HIP_MEMORY_SCOPE_AGENT);
                    if (o + 1u == nloc) { __builtin_amdgcn_fence(__ATOMIC_RELEASE, "agent"); asm volatile("s_waitcnt vmcnt(0)" ::: "memory");
                        __hip_atomic_fetch_add(arrP + 1024, 1u, __ATOMIC_RELAXED, __HIP_MEMORY_SCOPE_AGENT); } } }
        }
    }
};

struct GuDeal : FlexOrder {
    int cp;
    __device__ void init2(int G_, int c_, int rot) { init(22, G_, c_, 0, 0, 0); cp = (c_ + rot) % G_; }
    __device__ bool next(int i, Unit& u) const {
        const int c = cp; int P = -1, s = -1;
        if (c < 128) { if (i < 6) P = i * 256 + c; }
        else if (c < 172) { if (i == 0) P = c; else if (i == 1) s = c - 128; else if (i < 6) P = (i - 1) * 256 + c; }
        else if (c < 248) { if (i < 5) P = i * 256 + c; else if (i == 5 && c < 188) P = c < 180 ? 3 * 256 + (c + 76) : 4 * 256 + (c + 68); }
        else { if (i < 3) P = i * 256 + c; }
        if (P < 0 && s < 0) return false;
        if (s >= 0) { u.pm = 64 + s / 22; u.pn = s % 22; return true; }
        int wgid = P; { const int q = 1408 / NXCD, xcd = wgid % NXCD, off = wgid / NXCD; wgid = xcd * q + off; }
        const int nig = WGM * 22, gid = wgid / nig, fm = gid * WGM;
        u.pm = fm + ((wgid % nig) % WGM); u.pn = (wgid % nig) / WGM; return true;
    }
};
struct OneUnitOrder {
    int pm, pn; unsigned* waitc; unsigned tgt;
    __device__ bool next(int i, Unit& u) const { if (i > 0) return false; u.pm = pm; u.pn = pn; return true; }
    __device__ __forceinline__ void a_ready(const Unit&) const { unsigned sp = 0;
        while (__hip_atomic_load(waitc, __ATOMIC_RELAXED, __HIP_MEMORY_SCOPE_AGENT) < tgt) { __builtin_amdgcn_s_sleep(4); if (++sp > (1u << 22)) break; }
        __builtin_amdgcn_fence(__ATOMIC_ACQUIRE, "agent"); asm volatile("s_waitcnt vmcnt(0)" ::: "memory"); }
    __device__ __forceinline__ void done(const Unit&) const {}
};

__device__ __forceinline__ unsigned cvt_pk_bf16(float lo, float hi) { unsigned r; asm volatile("v_cvt_pk_bf16_f32 %0, %1, %2" : "=v"(r) : "v"(lo), "v"(hi)); return r; }
__device__ __forceinline__ void st16(void* p, u32x4 v) {
#if defined(EPI_WT) && EPI_WT
    asm volatile("global_store_dwordx4 %0, %1, off sc1" : : "v"(p), "v"(v) : "memory");
#else
    *(u32x4*)p = v;
#endif
}
__device__ __forceinline__ void st16f(void* p, f32x4 v) { st16(p, __builtin_bit_cast(u32x4, v)); }
constexpr int MP_ROWS = 16384;
constexpr float RMS_EPS = 1e-6f;
__device__ __forceinline__ void row_rstd(float (&rs)[2][4], const float* ssp, int row0, int fq) {
#pragma unroll
    for (int ai = 0; ai < 2; ++ai)
#pragma unroll
        for (int m = 0; m < 4; ++m) { const f32x4 p = *(const f32x4*)(ssp + (size_t)(row0 + ai * HALF + m * 16) * 16 + 4 * fq);
            float s = (p[0] + p[1]) + (p[2] + p[3]); s += __shfl_xor(s, 16); s += __shfl_xor(s, 32);
            rs[ai][m] = 1.0f / sqrtf(s * (1.0f / 1024.0f) + RMS_EPS); }
}
struct EpiQKV {
    static constexpr bool PERM = true, AFTER_DRAIN = false;
    bf16_t *Qb, *Kb, *Vb; float *kp, *vp, *ks, *vs; const float* ssp; int layer; float qscale;
    __device__ __forceinline__ long frow(int row) const {
        if (layer == 0) return row < MP_ROWS ? (long)row * 1024 : (long)(row - MP_ROWS) * 1024;
        if (row < MP_ROWS) { const int t = row & 8191, b = row >> 13; return t >= 7680 ? (long)(b * 512 + t - 7680) * 1024 : -1; }
        const int sr = row - MP_ROWS; return (long)((sr >> 4) * 512 + 496 + (sr & 15)) * 1024;
    }
    __device__ __forceinline__ void operator()(const f32x4 (&acc)[2][2][4][2], const Unit& u, int wr, int wc, int fr, int fq) const {
        const int t = u.pn >> 2, colt = (u.pn & 3) * BM, row0 = u.pm * BM + wr * 64 + fr, col0 = colt + wc * 32 + 8 * fq;
        float rs[2][4]; row_rstd(rs, ssp, row0, fq);
        bf16_t* const qb_ = Qb; bf16_t* const kb_ = Kb; bf16_t* const vb_ = Vb; float* const kp_ = kp; float* const vp_ = vp; float* const ks_ = ks; float* const vs_ = vs;
        bf16_t* B = t == 0 ? qb_ : (t == 1 ? kb_ : vb_); const float sc = t == 0 ? qscale : 1.f;
        const bool prow = u.pm < 64;
        float* fb = t == 1 ? (prow ? kp_ : ks_) : (prow ? vp_ : vs_);
        const bool anyf = t > 0 && (layer == 0 || !prow || (u.pm & 31) >= 30);
#pragma unroll
        for (int ai = 0; ai < 2; ++ai)
#pragma unroll
            for (int m = 0; m < 4; ++m) { const int row = row0 + ai * HALF + m * 16; const float r = rs[ai][m];
                const long fo = anyf ? frow(row) : -1;
#pragma unroll
                for (int bj = 0; bj < 2; ++bj) { f32x4 v0 = acc[ai][bj][m][0] * r, v1 = acc[ai][bj][m][1] * r;
                    if (fo >= 0) { float* fp = fb + fo + col0 + bj * HALF; st16f(fp, v0); st16f(fp + 4, v1); }
                    v0 = v0 * sc; v1 = v1 * sc; u32x4 w; w.x = cvt_pk_bf16(v0[0], v0[1]); w.y = cvt_pk_bf16(v0[2], v0[3]); w.z = cvt_pk_bf16(v1[0], v1[1]); w.w = cvt_pk_bf16(v1[2], v1[3]);
                    st16(B + (size_t)row * 1024 + col0 + bj * HALF, w); } }
    }
};
struct EpiRes {
    static constexpr bool PERM = true, AFTER_DRAIN = false;
    const float *base_p, *base_s; float* H; bf16_t* HB; float* ssp;
    __device__ __forceinline__ void operator()(const f32x4 (&acc)[2][2][4][2], const Unit& u, int wr, int wc, int fr, int fq) const {
        const int col0 = u.pn * BM + wc * 32 + 8 * fq, rl0 = wr * 64 + fr;
        const float* base = u.pm < 64 ? base_p + (size_t)u.pm * BM * 1024 : base_s + (size_t)(u.pm - 64) * BM * 1024;
#pragma unroll
        for (int ai = 0; ai < 2; ++ai)
#pragma unroll
            for (int m = 0; m < 4; ++m) { const int rl = rl0 + ai * HALF + m * 16; const size_t row = (size_t)u.pm * BM + rl; float ss = 0.f;
#pragma unroll
                for (int bj = 0; bj < 2; ++bj) { const float* bp = base + (size_t)rl * 1024 + col0 + bj * HALF;
                    const f32x4 v0 = acc[ai][bj][m][0] + *(const f32x4*)bp, v1 = acc[ai][bj][m][1] + *(const f32x4*)(bp + 4);
                    ss += (v0[0] * v0[0] + v0[1] * v0[1]) + (v0[2] * v0[2] + v0[3] * v0[3]) + (v1[0] * v1[0] + v1[1] * v1[1]) + (v1[2] * v1[2] + v1[3] * v1[3]);
                    float* hp = H + row * 1024 + col0 + bj * HALF; st16f(hp, v0); st16f(hp + 4, v1);
                    u32x4 w; w.x = cvt_pk_bf16(v0[0], v0[1]); w.y = cvt_pk_bf16(v0[2], v0[3]); w.z = cvt_pk_bf16(v1[0], v1[1]); w.w = cvt_pk_bf16(v1[2], v1[3]);
                    st16(HB + row * 1024 + col0 + bj * HALF, w); }
                ss += __shfl_xor(ss, 16); ss += __shfl_xor(ss, 32);
                if (fq == 0) ssp[row * 16 + u.pn * 4 + wc] = ss;
                if (m & 1) asm volatile("" ::: "memory"); }
    }
};
struct EpiSwiGLU {
    static constexpr bool PERM = true, AFTER_DRAIN = false;
    bf16_t* ACT; const float* ssp;
    __device__ __forceinline__ void operator()(const f32x4 (&acc)[2][2][4][2], const Unit& u, int wr, int wc, int fr, int fq) const {
        const int row0 = u.pm * BM + wr * 64 + fr, col0 = u.pn * HALF + wc * 32 + 8 * fq;
        float rs[2][4]; row_rstd(rs, ssp, row0, fq);
#pragma unroll
        for (int ai = 0; ai < 2; ++ai)
#pragma unroll
            for (int m = 0; m < 4; ++m) { const int row = row0 + ai * HALF + m * 16; const float r = rs[ai][m]; float o[8];
#pragma unroll
                for (int n = 0; n < 2; ++n)
#pragma unroll
                    for (int e = 0; e < 4; ++e) { const float g = acc[ai][0][m][n][e] * r, up = acc[ai][1][m][n][e] * r;
                        o[n * 4 + e] = g * __builtin_amdgcn_rcpf(1.0f + __builtin_amdgcn_exp2f(g * -1.4426950408889634f)) * up; }
                u32x4 w; w.x = cvt_pk_bf16(o[0], o[1]); w.y = cvt_pk_bf16(o[2], o[3]); w.z = cvt_pk_bf16(o[4], o[5]); w.w = cvt_pk_bf16(o[6], o[7]);
                st16(ACT + (size_t)row * 2816 + col0, w); }
    }
};

template <class Epi, class Sched, bool ALIGN_EPI = false, bool SP2 = false>
__device__ __forceinline__ void gemm_phase(PG8_LAS unsigned char* lds, const Gemm g, const Sched& S, const Epi& E) {
    int tid_ = threadIdx.x; asm volatile("" : "+v"(tid_));
    const int tid = tid_, wid = __builtin_amdgcn_readfirstlane(tid >> 6), lane = tid & 63, wr = wid >> 2, wc = wid & 3, fr = lane & 15, fq = lane >> 4;
    const int K = g.K, nt = K / BK;
    unsigned voffA[2], voffB[2];
#pragma unroll
    for (int i = 0; i < 2; ++i) { int R, C; stage_rc(tid * 16 + i * 8192, R, C); const int Rb = Epi::PERM ? ((R & ~31) + perm32(R & 31)) : R;
        voffA[i] = (unsigned)(R * K + C) * 2u; voffB[i] = (unsigned)(Rb * K + C) * 2u; }
    const size_t kstep = (size_t)(BK * 2);
    const size_t hstep = (size_t)HALF * K * 2;
    const size_t tstep = 2 * hstep;
    const unsigned ldsw = (unsigned)wid * 1024u;
    const int aoff = lds_byte(wr * 64 + fr, fq * 8), boff = lds_byte(wc * 32 + fr, fq * 8);
#define PG8_SA(b, h) (((b) * 2 + (h)) * HTB)
#define PG8_SB(b, h) ((4 + (b) * 2 + (h)) * HTB)
#define PG8_STAGE(bufoff, gbase, voff) do { _Pragma("unroll") for (int _i = 0; _i < 2; ++_i) \
        __builtin_amdgcn_global_load_lds((const unsigned*)((const char*)(gbase) + (voff)[_i]), (PG8_LAS unsigned*)(lds + (bufoff) + ldsw + _i * 8192), 16, 0, 0); } while (0)
#define PG8_LDA(dst, b, h) do { _Pragma("unroll") for (int m = 0; m < 4; ++m) _Pragma("unroll") for (int k = 0; k < 2; ++k) dst[m][k] = *(const PG8_LAS bf16x8*)(lds + PG8_SA(b, h) + aoff + m * 2048 + k * 1024); } while (0)
#define PG8_LDB(dst, b, h) do { _Pragma("unroll") for (int n = 0; n < 2; ++n) _Pragma("unroll") for (int k = 0; k < 2; ++k) dst[n][k] = *(const PG8_LAS bf16x8*)(lds + PG8_SB(b, h) + boff + n * 2048 + k * 1024); } while (0)
#define PG8_MMA(ai, bj, At, Bt) do { __builtin_amdgcn_s_setprio(1); _Pragma("unroll") for (int m = 0; m < 4; ++m) _Pragma("unroll") for (int n = 0; n < 2; ++n) _Pragma("unroll") for (int k = 0; k < 2; ++k) \
        acc[ai][bj][m][n] = __builtin_amdgcn_mfma_f32_16x16x32_bf16(Bt[n][k], At[m][k], acc[ai][bj][m][n], 0, 0, 0); __builtin_amdgcn_s_setprio(0); } while (0)
#define PG8_WAIT_V(n) asm volatile("s_waitcnt vmcnt(" #n ")" ::: "memory")
#define PG8_WAIT_L(n) asm volatile("s_waitcnt lgkmcnt(" #n ")" ::: "memory")
#define PG8_BAR __builtin_amdgcn_s_barrier()
#define PG8_SCHED __builtin_amdgcn_sched_barrier(0)
    Unit cur, nxt; int ui = 0;
    if (!S.next(0, cur)) return;
    f32x4 acc[2][2][4][2];
#pragma unroll
    for (int a = 0; a < 2; ++a)
#pragma unroll
        for (int b = 0; b < 2; ++b)
#pragma unroll
            for (int m = 0; m < 4; ++m)
#pragma unroll
                for (int n = 0; n < 2; ++n) acc[a][b][m][n] = (f32x4){0.f, 0.f, 0.f, 0.f};
    bf16x8 At[4][2], B0[2][2], B1[2][2];
    const char* cA = (const char*)g.A + (size_t)cur.pm * tstep; const char* cB = (const char*)g.Bt + (size_t)cur.pn * tstep;
    S.a_ready(cur);
    if constexpr (SP2) {
        PG8_STAGE(PG8_SB(0, 0), cB, voffB); PG8_STAGE(PG8_SB(0, 1), cB + hstep, voffB); PG8_STAGE(PG8_SA(0, 0), cA, voffA); PG8_STAGE(PG8_SA(0, 1), cA + hstep, voffA);
        if (wr == 1) PG8_BAR;
        PG8_WAIT_V(2); PG8_BAR;
        PG8_STAGE(PG8_SB(1, 0), cB + kstep, voffB); PG8_STAGE(PG8_SA(1, 0), cA + kstep, voffA); PG8_STAGE(PG8_SB(1, 1), cB + hstep + kstep, voffB);
        PG8_WAIT_V(6); PG8_BAR;
    } else {
        PG8_STAGE(PG8_SB(0, 0), cB, voffB); PG8_STAGE(PG8_SA(0, 0), cA, voffA); PG8_STAGE(PG8_SB(0, 1), cB + hstep, voffB); PG8_STAGE(PG8_SA(0, 1), cA + hstep, voffA);
        if (wr == 1) PG8_BAR;
        PG8_WAIT_V(4); PG8_BAR;
        PG8_STAGE(PG8_SB(1, 0), cB + kstep, voffB); PG8_STAGE(PG8_SA(1, 0), cA + kstep, voffA); PG8_STAGE(PG8_SB(1, 1), cB + hstep + kstep, voffB);
        PG8_WAIT_V(6); PG8_BAR;
    }
    for (;;) {
        const bool has_next = S.next(ui + 1, nxt);
        const char* nA = has_next ? (const char*)g.A + (size_t)nxt.pm * tstep : cA; const char* nB = has_next ? (const char*)g.Bt + (size_t)nxt.pn * tstep : cB;
        for (int t = 0; t < nt; t += 2) {
            const bool last = (t == nt - 2);
            const char* a1 = cA + (size_t)(t + 1) * kstep;
            const char* a2 = last ? nA : cA + (size_t)(t + 2) * kstep; const char* b2 = last ? nB : cB + (size_t)(t + 2) * kstep;
            const char* a3 = a2 + kstep; const char* b3 = b2 + kstep;
            if (last && has_next) S.a_ready(nxt);
            if constexpr (SP2) {
            PG8_LDB(B0, 0, 0); PG8_LDB(B1, 0, 1); PG8_SCHED; PG8_LDA(At, 0, 0); PG8_STAGE(PG8_SA(1, 1), a1 + hstep, voffA);
            PG8_WAIT_V(8); PG8_WAIT_L(0); PG8_BAR; PG8_MMA(0, 0, At, B0); PG8_MMA(0, 1, At, B1); PG8_BAR; PG8_SCHED;
            PG8_LDA(At, 0, 1); PG8_STAGE(PG8_SB(0, 0), b2, voffB); PG8_STAGE(PG8_SB(0, 1), b2 + hstep, voffB); PG8_STAGE(PG8_SA(0, 0), a2, voffA);
            PG8_WAIT_V(8); PG8_WAIT_L(0); PG8_BAR; PG8_MMA(1, 0, At, B0); PG8_MMA(1, 1, At, B1); PG8_BAR; PG8_SCHED;
            PG8_LDB(B0, 1, 0); PG8_LDB(B1, 1, 1); PG8_SCHED; PG8_LDA(At, 1, 0); PG8_STAGE(PG8_SA(0, 1), a2 + hstep, voffA);
            PG8_WAIT_V(8); PG8_WAIT_L(0); PG8_BAR; PG8_MMA(0, 0, At, B0); PG8_MMA(0, 1, At, B1); PG8_BAR; PG8_SCHED;
            PG8_LDA(At, 1, 1); PG8_STAGE(PG8_SB(1, 0), b3, voffB); PG8_STAGE(PG8_SB(1, 1), b3 + hstep, voffB); PG8_STAGE(PG8_SA(1, 0), a3, voffA);
            PG8_WAIT_V(8); PG8_WAIT_L(0); PG8_BAR; PG8_MMA(1, 0, At, B0); PG8_MMA(1, 1, At, B1); PG8_BAR; PG8_SCHED;
            } else {
            PG8_LDB(B0, 0, 0); PG8_SCHED; PG8_LDA(At, 0, 0); PG8_STAGE(PG8_SA(1, 1), a1 + hstep, voffA);
            PG8_WAIT_L(8); PG8_BAR; PG8_WAIT_L(0); PG8_MMA(0, 0, At, B0); PG8_BAR; PG8_SCHED;
            PG8_LDB(B1, 0, 1); PG8_STAGE(PG8_SB(0, 0), b2, voffB);
            PG8_BAR; PG8_WAIT_L(0); PG8_MMA(0, 1, At, B1); PG8_BAR;
            PG8_LDA(At, 0, 1); PG8_STAGE(PG8_SA(0, 0), a2, voffA);
            PG8_BAR; PG8_WAIT_L(0); PG8_MMA(1, 0, At, B0); PG8_BAR; PG8_SCHED;
            PG8_STAGE(PG8_SB(0, 1), b2 + hstep, voffB);
            PG8_WAIT_V(6); PG8_BAR; PG8_MMA(1, 1, At, B1); PG8_BAR;
            PG8_LDB(B0, 1, 0); PG8_SCHED; PG8_LDA(At, 1, 0); PG8_STAGE(PG8_SA(0, 1), a2 + hstep, voffA);
            PG8_WAIT_L(8); PG8_BAR; PG8_WAIT_L(0); PG8_MMA(0, 0, At, B0); PG8_BAR; PG8_SCHED;
            PG8_LDB(B1, 1, 1); PG8_STAGE(PG8_SB(1, 0), b3, voffB);
            PG8_BAR; PG8_WAIT_L(0); PG8_MMA(0, 1, At, B1); PG8_BAR;
            PG8_LDA(At, 1, 1); PG8_STAGE(PG8_SA(1, 0), a3, voffA);
            PG8_BAR; PG8_WAIT_L(0); PG8_MMA(1, 0, At, B0); PG8_BAR; PG8_SCHED;
            PG8_STAGE(PG8_SB(1, 1), b3 + hstep, voffB);
            PG8_WAIT_V(6); PG8_BAR; PG8_MMA(1, 1, At, B1); PG8_BAR;
            }
        }
        if constexpr (ALIGN_EPI) { if (wr == 0) PG8_BAR; }
        if constexpr (!Epi::AFTER_DRAIN) { E(acc, cur, wr, wc, fr, fq); S.done(cur); }
        if (!has_next) break;
#pragma unroll
        for (int a = 0; a < 2; ++a)
#pragma unroll
            for (int b = 0; b < 2; ++b)
#pragma unroll
                for (int m = 0; m < 4; ++m)
#pragma unroll
                    for (int n = 0; n < 2; ++n) acc[a][b][m][n] = (f32x4){0.f, 0.f, 0.f, 0.f};
        cur = nxt; cA = nA; cB = nB; ++ui;
        if constexpr (ALIGN_EPI) { if (wr == 1) PG8_BAR; }
    }
    PG8_WAIT_V(0);
    if constexpr (!ALIGN_EPI) { if (wr == 0) PG8_BAR; }
    PG8_BAR;
    if constexpr (Epi::AFTER_DRAIN) { E.fused(acc, cur, wr, wc, fr, fq, lds, wid, lane); S.done(cur); }
#undef PG8_SA
#undef PG8_SB
#undef PG8_STAGE
#undef PG8_LDA
#undef PG8_LDB
#undef PG8_MMA
#undef PG8_WAIT_V
#undef PG8_WAIT_L
#undef PG8_BAR
#undef PG8_SCHED
}
}

#ifndef PG8_SP2
#define PG8_SP2 true
#endif
#ifndef PG8_ALIGN
#define PG8_ALIGN true
#endif
#include <hip/hip_bf16.h>
#include <cmath>
namespace attn_body {
using bf16=__hip_bfloat16;
using bf16x8=__attribute__((ext_vector_type(8)))short;
using s16x4=__attribute__((ext_vector_type(4)))short;
using f32x16=__attribute__((ext_vector_type(16)))float;
using u32x4=__attribute__((ext_vector_type(4)))unsigned;
constexpr int BATCH=2,NHEAD=16,SEQ=8192,D=64,DM=NHEAD*D;
constexpr int NW=8,QBLK=32,QB=QBLK*NW,KVBLK=64,NQB=SEQ/QB;
constexpr int ATTN_PITCH=DM, ATTN_UNIT_ROWS=QB;
__device__ __forceinline__ int crow(int r,int hi){return (r&3)+8*(r>>2)+4*hi;}
#define SBAR() __builtin_amdgcn_sched_barrier(0)
__device__ __forceinline__ void cmask(f32x16&p0,f32x16&p1,int jb,int qrel,int hi){
  const float NEG=-INFINITY; int kb=64*jb+4*hi;
  #pragma unroll
  for(int r=0;r<16;++r){int kv=kb+(r&3)+8*(r>>2); if(kv>qrel)p0[r]=NEG; if(kv+32>qrel)p1[r]=NEG;}
}

constexpr int NSLOT=3, SLOTB=8192;
constexpr int LDS_K=0, LDS_V=NSLOT*SLOTB, LDS_WS=2*NSLOT*SLOTB, LDS_OST=LDS_WS+NW*64*4, LDS_X=LDS_OST+NW*4096, LDS_BT=LDS_X+NSLOT*2048, LDS_BYTES=LDS_BT+2048;
constexpr float C2=0.125f*1.4426950408889634f;
__device__ __forceinline__ void glds16(const void*gsrc,unsigned lds_dst){unsigned keep;
  asm volatile("s_mov_b32 %0, m0\n\ts_mov_b32 m0, %2\n\ts_nop 0\n\tglobal_load_lds_dwordx4 %1, off\n\ts_mov_b32 m0, %0":"=&s"(keep):"v"(gsrc),"s"(lds_dst):"memory");}
__device__ __forceinline__ void glds16s(const void*sbase,unsigned voff,unsigned lds_dst){unsigned keep;
  asm volatile("s_mov_b32 %0, m0\n\ts_mov_b32 m0, %3\n\ts_nop 0\n\tglobal_load_lds_dwordx4 %1, %2\n\ts_mov_b32 m0, %0":"=&s"(keep):"v"(voff),"s"(sbase),"s"(lds_dst):"memory");}
__device__ __forceinline__ void glds4s(const void*sbase,unsigned voff,unsigned lds_dst){unsigned keep;
  asm volatile("s_mov_b32 %0, m0\n\ts_mov_b32 m0, %3\n\ts_nop 0\n\tglobal_load_lds_dword %1, %2\n\ts_mov_b32 m0, %0":"=&s"(keep):"v"(voff),"s"(sbase),"s"(lds_dst):"memory");}
__device__ __forceinline__ void glds4(const void*gsrc,unsigned lds_dst){unsigned keep;
  asm volatile("s_mov_b32 %0, m0\n\ts_mov_b32 m0, %2\n\ts_nop 0\n\tglobal_load_lds_dword %1, off\n\ts_mov_b32 m0, %0":"=&s"(keep):"v"(gsrc),"s"(lds_dst):"memory");}
__device__ __forceinline__ float max3f(float a,float b,float c){float r;asm("v_max3_f32 %0, %1, %2, %3":"=v"(r):"v"(a),"v"(b),"v"(c));return r;}
__device__ __forceinline__ float max2f(float a,float b){float r;asm("v_max_f32_e32 %0, %1, %2":"=v"(r):"v"(a),"v"(b));return r;}
__device__ __forceinline__ float fadd_s(float a,float b){float r;asm("v_add_f32_e32 %0, %1, %2":"=v"(r):"v"(a),"v"(b));return r;}
__device__ __forceinline__ float fsub_s(float a,float b){float r;asm("v_sub_f32_e32 %0, %1, %2":"=v"(r):"v"(a),"v"(b));return r;}
typedef float f32x2_t __attribute__((ext_vector_type(2))); typedef __bf16 bf16x2_t __attribute__((ext_vector_type(2)));
__device__ __forceinline__ unsigned cvtpk_s(float lo,float hi){f32x2_t v={lo,hi};bf16x2_t b=__builtin_convertvector(v,bf16x2_t);return __builtin_bit_cast(unsigned,b);}
#define WAIT_BAR(N) asm volatile("s_waitcnt vmcnt(" #N ") lgkmcnt(0)\n\ts_barrier":::"memory")

__device__ __forceinline__ void qkt(f32x16&p0,f32x16&p1,const char*Kslot,const bf16x8*qr,bf16x8 kx0,bf16x8 kx1,bf16x8 qe,int r32,int hi){
  const char*kb=Kslot+hi*1024+r32*16;
  #pragma unroll
  for(int d0=0;d0<4;++d0){
    const bf16x8 b0=*reinterpret_cast<const bf16x8*>(kb+d0*2048);
    const bf16x8 b1=*reinterpret_cast<const bf16x8*>(kb+d0*2048+512);
    if(d0==0){const f32x16 z=f32x16{};p0=__builtin_amdgcn_mfma_f32_32x32x16_bf16(kx0,qe,z,0,0,0);p1=__builtin_amdgcn_mfma_f32_32x32x16_bf16(kx1,qe,z,0,0,0);}
    {p0=__builtin_amdgcn_mfma_f32_32x32x16_bf16(b0,qr[d0],p0,0,0,0);p1=__builtin_amdgcn_mfma_f32_32x32x16_bf16(b1,qr[d0],p1,0,0,0);}}
}
typedef __attribute__((address_space(3))) const char* lds_cptr;
typedef short v4i16_t __attribute__((ext_vector_type(4)));
__device__ __forceinline__ void kload8(bf16x8*kf,lds_cptr kp){
  kf[0]=*(const __attribute__((address_space(3))) bf16x8*)(kp);      kf[1]=*(const __attribute__((address_space(3))) bf16x8*)(kp+512);
  kf[2]=*(const __attribute__((address_space(3))) bf16x8*)(kp+2048); kf[3]=*(const __attribute__((address_space(3))) bf16x8*)(kp+2560);
  kf[4]=*(const __attribute__((address_space(3))) bf16x8*)(kp+4096); kf[5]=*(const __attribute__((address_space(3))) bf16x8*)(kp+4608);
  kf[6]=*(const __attribute__((address_space(3))) bf16x8*)(kp+6144); kf[7]=*(const __attribute__((address_space(3))) bf16x8*)(kp+6656);
}
__device__ __forceinline__ void kload2(bf16x8*kf,lds_cptr kp,int j){ kf[2*j]=*(const __attribute__((address_space(3))) bf16x8*)(kp+j*2048); kf[2*j+1]=*(const __attribute__((address_space(3))) bf16x8*)(kp+j*2048+512); }
__device__ __forceinline__ s16x4 vtr(lds_cptr p){ return __builtin_bit_cast(s16x4,__builtin_amdgcn_ds_read_tr16_b64_v4i16((__attribute__((address_space(3))) v4i16_t*)p)); }
__device__ __forceinline__ float rowmax(const f32x16&p0,const f32x16&p1){
  float a=max3f(p0[0],p0[1],p1[0]),b=max3f(p0[2],p0[3],p1[1]);a=max3f(a,p1[2],p1[3]);
  #pragma unroll
  for(int r=4;r<16;r+=4){a=max3f(a,p0[r],p0[r+1]);b=max3f(b,p0[r+2],p0[r+3]);a=max3f(a,p1[r],p1[r+1]);b=max3f(b,p1[r+2],p1[r+3]);}
  const float m=max2f(a,b);
  auto rr=__builtin_amdgcn_permlane32_swap(__float_as_uint(m),__float_as_uint(m),false,false);
  return max2f(__uint_as_float(rr[0]),__uint_as_float(rr[1]));
}
__device__ __forceinline__ void pv(f32x16*o,int vb,bf16x8 pa0,bf16x8 pa1,bf16x8 pa2,bf16x8 pa3){
  #pragma unroll
  for(int d0=0;d0<2;++d0){s16x4 lo[4],hi[4];
    #pragma unroll
    for(int ks=0;ks<4;++ks){
      asm volatile("ds_read_b64_tr_b16 %0,%1 offset:%c2":"=&v"(lo[ks]):"v"(vb),"i"(d0*4096+ks*1024):"memory");
      asm volatile("ds_read_b64_tr_b16 %0,%1 offset:%c2":"=&v"(hi[ks]):"v"(vb),"i"(d0*4096+ks*1024+512):"memory");}
    asm volatile("s_waitcnt lgkmcnt(0)":::"memory");SBAR();
    #define PK(k) (bf16x8){lo[k][0],lo[k][1],lo[k][2],lo[k][3],hi[k][0],hi[k][1],hi[k][2],hi[k][3]}
    o[d0]=__builtin_amdgcn_mfma_f32_32x32x16_bf16(pa0,PK(0),o[d0],0,0,0);
    o[d0]=__builtin_amdgcn_mfma_f32_32x32x16_bf16(pa1,PK(1),o[d0],0,0,0);
    o[d0]=__builtin_amdgcn_mfma_f32_32x32x16_bf16(pa2,PK(2),o[d0],0,0,0);
    o[d0]=__builtin_amdgcn_mfma_f32_32x32x16_bf16(pa3,PK(3),o[d0],0,0,0);
    #undef PK
  }
}

#ifndef ATTN_STORE16
#define ATTN_STORE16(p,v) (*(u32x4*)(p)=(v))
#endif
template<int MODE,int THRL> __device__ __forceinline__ void attn_unit(int b,int h,int qb,const bf16*Q,const bf16*K,const bf16*V,bf16*O,char*shm,const bf16*KX,const float*relb){
  int tid_=threadIdx.x; asm volatile("":"+v"(tid_));
  const int tid=tid_,lane=tid&63,r32=lane&31,hi=lane>>5; const int wid=__builtin_amdgcn_readfirstlane(tid>>6);
  const long rowbase=(long)b*SEQ; const int q0=qb*QB;
  const bf16*Qw=Q+(rowbase+q0+wid*QBLK)*DM+h*D;
  const int kc0=(MODE==1)?((4*qb-8)>0?(4*qb-8):0):0;
  const bf16*Kh=K+(rowbase+(long)kc0*KVBLK)*DM+h*D,*Vh=V+(rowbase+(long)kc0*KVBLK)*DM+h*D;
  const unsigned lds0=(unsigned)(uintptr_t)shm;
  float*wsf=(float*)(shm+LDS_WS)+wid*64;
  const unsigned kvo=(unsigned)(lane*DM+wid*8)*2u, vvo=(unsigned)((16*(wid&3)+(lane>>2))*DM+(wid>>2)*32+(lane&3)*8)*2u;
  const unsigned kdst=lds0+LDS_K+wid*1024, vdst=lds0+LDS_V+wid*1024;
  #define TILE(s_) ((MODE==0)?(NT-1-(s_)):(s_))
  #define DMA_K(t,slot) glds16s(Kh+(long)TILE(t)*KVBLK*DM,kvo,(unsigned)__builtin_amdgcn_readfirstlane(kdst+(slot)))
  #define DMA_V(t,slot) glds16s(Vh+(long)TILE(t)*KVBLK*DM,vvo,(unsigned)__builtin_amdgcn_readfirstlane(vdst+(slot)))
  const bf16*xsrc=KX+((long)(b*NHEAD+h)*2*SEQ+(long)(wid>>2)*SEQ+16*(wid&3))*8; const unsigned xvo=(unsigned)lane*4u; const unsigned xdst=lds0+LDS_X+wid*256;
  #define DMA_E(t,slot) do{ if(MODE==0) glds4s(xsrc+(long)TILE(t)*KVBLK*8,xvo,(unsigned)__builtin_amdgcn_readfirstlane(xdst+((slot)>>2))); }while(0)
  const lds_cptr xp0=(lds_cptr)shm+LDS_X+hi*1024+r32*16;
  #define XLD(sl) do{ if(MODE==0){ ke0=*(const __attribute__((address_space(3))) bf16x8*)(xp0+((sl)>>2)); ke1=*(const __attribute__((address_space(3))) bf16x8*)(xp0+((sl)>>2)+512); } }while(0)
  #define WAITB_A() do{ if(MODE==0){WAIT_BAR(3);}else{WAIT_BAR(2);} }while(0)
  const int vb0=(int)(lds0+LDS_V)+((lane>>4)&1)*32+(lane&3)*8+(4*hi+((lane&15)>>2))*64;
  const char*Kbase=shm+LDS_K; bf16x8 kf[8];
  const lds_cptr shm3=(lds_cptr)shm; const lds_cptr kp0=shm3+LDS_K+hi*1024+r32*16; const lds_cptr vp0=shm3+LDS_V+((lane>>4)&1)*32+(lane&3)*8+(4*hi+((lane&15)>>2))*64;
  const int NT=(q0+QB)/KVBLK-kc0;
  if(MODE==1){ float*bt=(float*)(shm+LDS_BT); if(tid<257) bt[tid]=(relb[tid]-relb[256])*1.4426950408889634f; }
  u32x4 qev=(u32x4){0x3F803F80u,0x3F80u,0u,0u};
  bf16x8 ke0,ke1; { const u32x4 kc_=(hi==0)?(u32x4){0u,0x3F800000u,0x3F803F80u,0u}:(u32x4){0u,0u,0u,0u}; ke0=__builtin_bit_cast(bf16x8,kc_); ke1=ke0; }
  #define QE() __builtin_bit_cast(bf16x8,qev)
  #define SETQE() do{ const float nm_=-mhat; const unsigned a_=cvtpk_s(nm_,0.f)&0xffffu; const float r1_=nm_-__uint_as_float(a_<<16); const unsigned b_=cvtpk_s(r1_,0.f)&0xffffu; \
    const float r2_=r1_-__uint_as_float(b_<<16); const unsigned c_=cvtpk_s(r2_,0.f)&0xffffu; qev[1]=0x3F80u|(a_<<16); qev[2]=b_|(c_<<16); }while(0)
  DMA_K(0,0);DMA_E(0,0);DMA_V(0,0);DMA_K(1,SLOTB);DMA_E(1,SLOTB);
  bf16x8 qr[4];
  #pragma unroll
  for(int d0=0;d0<4;++d0)qr[d0]=*reinterpret_cast<const bf16x8*>(&Qw[(long)r32*DM+d0*16+hi*8]);
  float mhat=0.f,l_reg=0.f;f32x16 o[2];o[0]=f32x16{};o[1]=f32x16{};
  const int qrel=wid*QBLK+r32;
  const int cw=4*qb+(wid>>1);
  #define BMASK(P0,P1,t) do{ const int kc_=kc0+(t); if(kc_>cw||kc_<cw-8){ _Pragma("unroll") for(int r=0;r<16;++r){P0[r]=-INFINITY;P1[r]=-INFINITY;} } \
    else if(kc_>=cw-2){ const float*bt_=(const float*)(shm+LDS_BT); const int dq_=64*(cw-kc_)+32*(wid&1)+r32-4*hi; \
      _Pragma("unroll") for(int r=0;r<16;++r){ const int d0_=dq_-((r&3)+8*(r>>2)), d1_=d0_-32; P0[r]+=bt_[(d0_<128?d0_:128)+128]; P1[r]+=bt_[(d1_<128?d1_:128)+128]; } } }while(0)
  #define CMASK(P0,P1,t) do{ if(MODE==1){BMASK(P0,P1,t);} else {int jb_=3-(t); if(jb_>=0)cmask(P0,P1,jb_,qrel,hi);} }while(0)
  bool resc=false;
  #define START(P0,P1) do{ float rm=rowmax(P0,P1); rm=max2f(rm,-64.f); resc=false;     \
    { const float dl=rm; mhat=fadd_s(mhat,dl); \
      _Pragma("unroll") for(int r=0;r<16;++r){P0[r]=fsub_s(P0[r],dl);P1[r]=fsub_s(P1[r],dl);} \
      SETQE(); } \
    _Pragma("unroll") for(int r=0;r<16;++r)P0[r]=__builtin_amdgcn_exp2f(P0[r]); }while(0)
  #define RESC() do{ if(resc){ asm volatile("s_waitcnt lgkmcnt(0)":::"memory"); \
      _Pragma("unroll") for(int d_=0;d_<2;++d_) _Pragma("unroll") for(int r=0;r<16;++r)o[d_][r]*=wsf[crow(r,hi)]; } }while(0)
  f32x16 pA0,pA1,pB0,pB1;
  int sl_prev=0,sl_cur=0,sl_next=SLOTB;
  #define ROT() do{sl_prev=sl_cur;sl_cur=sl_next;sl_next=(sl_next==(NSLOT-1)*SLOTB)?0:sl_next+SLOTB;}while(0)
  DMA_K(2,2*SLOTB);DMA_E(2,2*SLOTB);
  if(MODE==0){WAIT_BAR(5);}else{WAIT_BAR(3);}
  XLD(0);
  qkt(pA0,pA1,Kbase,qr,ke0,ke1,QE(),r32,hi);asm volatile("s_nop 15\n\ts_nop 7":"+v"(pA0),"+v"(pA1));CMASK(pA0,pA1,0);
  START(pA0,pA1);
  _Pragma("unroll") for(int r=0;r<16;++r)pA1[r]=__builtin_amdgcn_exp2f(pA1[r]);
  WAIT_BAR(0);
  DMA_K(3,0);DMA_E(3,0);DMA_V(1,SLOTB);
  ROT();
  kload8(kf,kp0+sl_cur); XLD(sl_cur);
  WAITB_A();
  s16x4 vlo[8],vhi[8]; u32x4 pw0,pw1,pw2,pw3;
  #define PKW(P,B) cvtpk_s(P[B],P[B+1])
  #define PAF(k) __builtin_bit_cast(bf16x8,pw##k)
  #define VFR(i) (bf16x8){vlo[i][0],vlo[i][1],vlo[i][2],vlo[i][3],vhi[i][0],vhi[i][1],vhi[i][2],vhi[i][3]}
  #define PIN(x) asm volatile("":"+v"(x))
  #define MX3(a,b,c) __builtin_fmaxf(__builtin_fmaxf((a),(b)),(c))
  #define GAPA(MF,A0,A1,A2,A3,W0,W1,PW) do{ MF; sacc+=A0; sacc+=A1; sacc+=A2; sacc+=A3; PIN(sacc); W0; W1; PIN(PW); SBAR(); }while(0)
  #define EX(v) __builtin_amdgcn_exp2f(v)
  #define GAPB(MF,X,B) do{ MF; X[B]=EX(X[B]); X[B+1]=EX(X[B+1]); X[B+2]=EX(X[B+2]); X[B+3]=EX(X[B+3]); PIN(X); SBAR(); }while(0)
  #define VRD(i) do{ vlo[i]=vtr(vp_+(((i)>>2)*4096+((i)&3)*1024)); vhi[i]=vtr(vp_+(((i)>>2)*4096+((i)&3)*1024+512)); }while(0)
  #define KRD(G,j) do{ if(G){ kload2(kf,kp0+sl_next,j); SBAR(); } }while(0)
  #define STEP(C0,C1,P0,P1,t,GK,GV,GL) do{ SBAR(); \
    const lds_cptr vp_=vp0+sl_prev; \
    { const f32x16 z_=f32x16{}; C0=__builtin_amdgcn_mfma_f32_32x32x16_bf16(ke0,QE(),z_,0,0,0); C1=__builtin_amdgcn_mfma_f32_32x32x16_bf16(ke1,QE(),z_,0,0,0); } SBAR(); \
    VRD(0); SBAR(); float sacc=(P0[0]+P0[1]); \
    GAPA(C0=__builtin_amdgcn_mfma_f32_32x32x16_bf16(kf[0],qr[0],C0,0,0,0), P0[2],P0[3],P0[4],P0[5],     pw0[0]=PKW(P0,0), pw0[1]=PKW(P0,2), pw0); \
    VRD(4); SBAR(); GAPA(C1=__builtin_amdgcn_mfma_f32_32x32x16_bf16(kf[1],qr[0],C1,0,0,0), P0[6],P0[7],P0[8],P0[9],     pw0[2]=PKW(P0,4), pw0[3]=PKW(P0,6), pw0); \
    VRD(1); SBAR(); GAPA(C0=__builtin_amdgcn_mfma_f32_32x32x16_bf16(kf[2],qr[1],C0,0,0,0),   P0[10],P0[11],P0[12],P0[13], pw1[0]=PKW(P0,8), pw1[1]=PKW(P0,10), pw1); \
    VRD(5); SBAR(); GAPA(C1=__builtin_amdgcn_mfma_f32_32x32x16_bf16(kf[3],qr[1],C1,0,0,0),   P0[14],P0[15],P1[0],P1[1],   pw1[2]=PKW(P0,12),pw1[3]=PKW(P0,14), pw1); \
    VRD(2); SBAR(); GAPA(C0=__builtin_amdgcn_mfma_f32_32x32x16_bf16(kf[4],qr[2],C0,0,0,0),   P1[2],P1[3],P1[4],P1[5],     pw2[0]=PKW(P1,0), pw2[1]=PKW(P1,2), pw2); \
    VRD(6); SBAR(); GAPA(C1=__builtin_amdgcn_mfma_f32_32x32x16_bf16(kf[5],qr[2],C1,0,0,0),   P1[6],P1[7],P1[8],P1[9],     pw2[2]=PKW(P1,4), pw2[3]=PKW(P1,6), pw2); \
    VRD(3); SBAR(); GAPA(C0=__builtin_amdgcn_mfma_f32_32x32x16_bf16(kf[6],qr[3],C0,0,0,0),   P1[10],P1[11],P1[12],P1[13], pw3[0]=PKW(P1,8), pw3[1]=PKW(P1,10), pw3); \
    VRD(7); SBAR(); GAPA(C1=__builtin_amdgcn_mfma_f32_32x32x16_bf16(kf[7],qr[3],C1,0,0,0),   P1[14],P1[15],0.f,0.f,       pw3[2]=PKW(P1,12),pw3[3]=PKW(P1,14), pw3); \
    l_reg+=sacc; \
    if(GK){DMA_K((t)+3,sl_cur);DMA_E((t)+3,sl_cur);} if(GV){DMA_V((t)+1,sl_next);} \
    CMASK(C0,C1,t); \
    { float a=MX3(C0[0],C0[1],C1[0]),b=MX3(C0[2],C0[3],C1[1]); a=MX3(a,C1[2],C1[3]); \
      _Pragma("unroll") for(int r=4;r<16;r+=4){a=MX3(a,C0[r],C0[r+1]);b=MX3(b,C0[r+2],C0[r+3]);a=MX3(a,C1[r],C1[r+1]);b=MX3(b,C1[r+2],C1[r+3]);} \
      float rm=__builtin_fmaxf(a,b); { auto rr=__builtin_amdgcn_permlane32_swap(__float_as_uint(rm),__float_as_uint(rm),false,false); rm=__builtin_fmaxf(__uint_as_float(rr[0]),__uint_as_float(rr[1])); } \
      resc=false; \
      if(__builtin_expect(__any(rm>(float)THRL),0)){ const float dl=__builtin_fmaxf(rm,0.f); mhat+=dl; \
        _Pragma("unroll") for(int r=0;r<16;++r){C0[r]-=dl;C1[r]-=dl;} \
        SETQE(); \
        const float f=__builtin_amdgcn_exp2f(-dl); l_reg*=f; if(hi==0)wsf[r32]=f; resc=true; } } \
    SBAR(); \
    GAPB(o[0]=__builtin_amdgcn_mfma_f32_32x32x16_bf16(PAF(0),VFR(0),o[0],0,0,0), C0,0); \
    GAPB(o[1]=__builtin_amdgcn_mfma_f32_32x32x16_bf16(PAF(0),VFR(4),o[1],0,0,0), C0,4); \
    KRD(GL,0); GAPB(o[0]=__builtin_amdgcn_mfma_f32_32x32x16_bf16(PAF(1),VFR(1),o[0],0,0,0), C0,8); \
    KRD(GL,1); GAPB(o[1]=__builtin_amdgcn_mfma_f32_32x32x16_bf16(PAF(1),VFR(5),o[1],0,0,0), C0,12); \
    KRD(GL,2); GAPB(o[0]=__builtin_amdgcn_mfma_f32_32x32x16_bf16(PAF(2),VFR(2),o[0],0,0,0), C1,0); \
    KRD(GL,3); GAPB(o[1]=__builtin_amdgcn_mfma_f32_32x32x16_bf16(PAF(2),VFR(6),o[1],0,0,0), C1,4); \
    if(GL){ XLD(sl_next); SBAR(); } GAPB(o[0]=__builtin_amdgcn_mfma_f32_32x32x16_bf16(PAF(3),VFR(3),o[0],0,0,0), C1,8); \
    GAPB(o[1]=__builtin_amdgcn_mfma_f32_32x32x16_bf16(PAF(3),VFR(7),o[1],0,0,0), C1,12); \
    }while(0)
  int t=1;
  for(;t+5<NT;t+=2){
    STEP(pB0,pB1,pA0,pA1,t,true,true,true);     WAITB_A(); RESC(); ROT();
    STEP(pA0,pA1,pB0,pB1,t+1,true,true,true);   WAITB_A(); RESC(); ROT();
  }
  #define ENDW(tt) do{ if((tt)+3<NT){WAITB_A();} else if((tt)+2<NT){WAIT_BAR(1);} else {WAIT_BAR(0);} }while(0)
  for(;t+1<NT;t+=2){
    STEP(pB0,pB1,pA0,pA1,t,(t+3<NT),(t+1<NT),(t+1<NT));       ENDW(t);   RESC(); ROT();
    STEP(pA0,pA1,pB0,pB1,t+1,(t+4<NT),(t+2<NT),(t+2<NT));     ENDW(t+1); RESC(); ROT();
  }
  STEP(pB0,pB1,pA0,pA1,NT-1,false,false,false); RESC();
  { float sacc=pB0[0]+pB0[1]; _Pragma("unroll") for(int r=2;r<16;++r)sacc+=pB0[r]; _Pragma("unroll") for(int r=0;r<16;++r)sacc+=pB1[r]; l_reg+=sacc;
    pw0=(u32x4){PKW(pB0,0),PKW(pB0,2),PKW(pB0,4),PKW(pB0,6)};pw1=(u32x4){PKW(pB0,8),PKW(pB0,10),PKW(pB0,12),PKW(pB0,14)};pw2=(u32x4){PKW(pB1,0),PKW(pB1,2),PKW(pB1,4),PKW(pB1,6)};pw3=(u32x4){PKW(pB1,8),PKW(pB1,10),PKW(pB1,12),PKW(pB1,14)};
    SBAR(); pv(o,vb0+sl_cur,PAF(0),PAF(1),PAF(2),PAF(3)); }
  #undef PKW
  #undef PAF
  #undef VFR
  #undef PIN
  #undef MX3
  #undef GAPA
  #undef GAPB
  #undef EX
  #undef VRD
  #undef KRD
  #undef STEP
  #undef ENDW
  {auto rr=__builtin_amdgcn_permlane32_swap(__float_as_uint(l_reg),__float_as_uint(l_reg),false,false);l_reg=__uint_as_float(rr[0])+__uint_as_float(rr[1]);}
  if(hi==0)wsf[32+r32]=l_reg;asm volatile("s_waitcnt lgkmcnt(0)":::"memory");
  float rli[16];
  #pragma unroll
  for(int r=0;r<16;++r)rli[r]=__builtin_amdgcn_rcpf(wsf[32+crow(r,hi)]);
  bf16*Ow=O+(rowbase+q0+wid*QBLK)*DM+h*D;
  { bf16*stg=(bf16*)(shm+LDS_OST)+wid*2048;
    #pragma unroll
    for(int r=0;r<16;++r){const int orow=crow(r,hi);
      #pragma unroll
      for(int d0=0;d0<2;++d0)stg[orow*64+d0*32+r32]=__float2bfloat16(o[d0][r]*rli[r]);}
    asm volatile("s_waitcnt lgkmcnt(0)":::"memory");
    #pragma unroll
    for(int i=0;i<4;++i){const int row=i*8+(lane>>3),ch=lane&7; const u32x4 v=*(const u32x4*)(stg+row*64+ch*8); ATTN_STORE16(Ow+(long)row*DM+ch*8,v);} }
  asm volatile("s_waitcnt lgkmcnt(0)\n\ts_barrier":::"memory");
  #undef DMA_K
  #undef TILE
  #undef DMA_V
  #undef DMA_E
  #undef XLD
  #undef WAITB_A
  #undef QE
  #undef SETQE
  #undef BMASK
  #undef CMASK
  #undef START
  #undef RESC
  #undef ROT
}
constexpr int ATTN_LDS_BYTES=LDS_BYTES;
struct AttnTensors { const bf16* Q; const bf16* K; const bf16* V; bf16* O; const bf16* KX; const float* relb; };
struct AttnUnit { int bh; int qb; };
struct StaticOrder {
  int vcu;
  __device__ __forceinline__ explicit StaticOrder(int grid,int block):vcu((block%8)*(grid/8)+block/8){}
  __device__ __forceinline__ bool next(int i,AttnUnit&u)const{ if(i>=4)return false; const int s=vcu&7; u.bh=vcu>>3; u.qb=(i==0)?s:(i==1)?15-s:(i==2)?16+s:31-s; return true; }
  __device__ __forceinline__ bool next_band(int i,AttnUnit&u)const{ if(i>=4)return false; u.bh=vcu>>3; u.qb=(vcu&7)+8*i; return true; }
  __device__ __forceinline__ void a_ready(const AttnUnit&)const{}
  __device__ __forceinline__ void done(const AttnUnit&)const{}
};
template<int MODE,class Sched,int THRL=8> __device__ __forceinline__ void attn_phase(char*lds,const AttnTensors&T,const Sched&S,int i0=0,int i1=4){
  AttnUnit u;
  for(int i=i0;i<i1&&(MODE==0?S.next(i,u):S.next_band(i,u));++i){ attn_unit<MODE,THRL>(u.bh/NHEAD,u.bh%NHEAD,u.qb,T.Q,T.K,T.V,T.O,lds,T.KX,T.relb+(MODE==1?(u.bh%NHEAD)*257:0)); }
}
#undef SBAR
#undef WAIT_BAR
}
namespace cg = cooperative_groups;
constexpr int NWAVES = 8;
#ifndef MK_PER_PHASE
#define MK_PER_PHASE 0
#endif
constexpr int N_PHASES = 12;
constexpr int MP = 16384, MS = 512, MT = MP + MS, DMODEL = 1024, DFF = 2816, NH = 16, SEQL = 8192;
constexpr int PAST = 1024, BPAST = 512, DECB = 32, DECT = 16;
constexpr size_t O_YP = 0, O_YS = 16777216, O_AKP = 17301504, O_AVP = 34078720, O_ALFP = 50855936, O_BKP = 51118080, O_BVP = 52166656,
                 O_AKS = 53215232, O_AVS = 53739520, O_ALFS = 54263808, O_BKS = 54272000, O_BVS = 71049216, O_END = 87826432;
constexpr size_t MiB = 1u << 20;
constexpr size_t WS_WQKV0 = 2 * MiB, WS_WO0 = 8 * MiB, WS_WGU0 = 10 * MiB, WS_WD0 = 21 * MiB, WS_WKVQ = 27 * MiB, WS_WO1 = 33 * MiB, WS_WGU1 = 35 * MiB, WS_WD1 = 46 * MiB;
constexpr size_t WS_SSP = 52 * MiB, SSP_STRIDE = 2 * MiB;
constexpr size_t WS_GS = 62 * MiB;
constexpr size_t WS_KX = 64 * MiB;
constexpr size_t WS_QO = 72 * MiB, WS_KB = 105 * MiB, WS_VB = 138 * MiB, WS_HB = 171 * MiB, WS_ACT = 204 * MiB, WS_END = 296 * MiB;
static_assert(WS_ACT + (size_t)MT * DFF * 2 <= WS_END && WS_QO + (size_t)MT * DMODEL * 2 <= WS_KB, "d_ws map");
constexpr int RING_BYTES = 131072, LDS_BYTES = 147456;
static_assert(attn_body::ATTN_LDS_BYTES <= RING_BYTES, "attention LDS");

#define GAS __attribute__((address_space(1)))
#define LAS __attribute__((address_space(3)))
typedef unsigned short bf16;
typedef unsigned v4u __attribute__((ext_vector_type(4)));
typedef float f32x4 __attribute__((ext_vector_type(4)));
typedef short bf16x8 __attribute__((ext_vector_type(8)));
#define LDS_WAIT() asm volatile("s_waitcnt lgkmcnt(0)" ::: "memory")
__device__ __forceinline__ unsigned f2bf(float f) { unsigned u = __builtin_bit_cast(unsigned, f); return (u + 0x7fffu + ((u >> 16) & 1u)) >> 16; }
__device__ __forceinline__ unsigned pk2(float lo, float hi) { return f2bf(lo) | (f2bf(hi) << 16); }
__device__ __forceinline__ float bf2f(unsigned short b) { return __uint_as_float((unsigned)b << 16); }

__device__ __forceinline__ void p0_transpose_item(const float* W, int ldw, int csrc, int k0, const float* gain, bf16* WT, int K, int drow, LAS float* scr, int lane) {
    float wv[32]; const float gl = gain ? gain[k0 + lane] : 1.f;
#pragma unroll
    for (int i = 0; i < 32; ++i) wv[i] = W[(size_t)(k0 + 2 * i + (lane >> 5)) * ldw + csrc + (lane & 31)];
#pragma unroll
    for (int i = 0; i < 32; ++i) { const int kk = 2 * i + (lane >> 5); scr[kk * 33 + (lane & 31)] = wv[i] * __shfl(gl, kk); }
    LDS_WAIT(); asm volatile("" ::: "memory");
    const int c = lane & 7;
#pragma unroll
    for (int j = 0; j < 4; ++j) { const int n = (lane >> 3) + 8 * j; const LAS float* s = scr + (8 * c) * 33 + n;
        v4u o; o.x = pk2(s[0 * 33], s[1 * 33]); o.y = pk2(s[2 * 33], s[3 * 33]); o.z = pk2(s[4 * 33], s[5 * 33]); o.w = pk2(s[6 * 33], s[7 * 33]);
        *(v4u*)(WT + (size_t)(drow + n) * K + k0 + 8 * c) = o; }
    LDS_WAIT(); asm volatile("" ::: "memory");
}
struct KArgs { const float* in[20]; float* out; unsigned char* ws; int ph_lo, ph_hi; };

__device__ __forceinline__ void p0_weight_item(const KArgs& a, int it, LAS float* scr, int lane) {
    unsigned char* ws = a.ws;
    constexpr int I_QKV = 16 * 96, I_O = 16 * 32, I_GU = 16 * 176, I_D = 44 * 32, I_Q1 = 16 * 32, I_KV = 16 * 64;
    const float* W; int ldw, ncols, K, roff = 0; const float* gain = nullptr; bf16* dst; bool perm = false;
    int r = it;
    if (r < I_QKV) { W = a.in[8]; ldw = 3088; ncols = 3072; K = 1024; gain = a.in[7]; dst = (bf16*)(ws + WS_WQKV0); }
    else if ((r -= I_QKV) < I_O) { W = a.in[10]; ldw = 1024; ncols = 1024; K = 1024; dst = (bf16*)(ws + WS_WO0); }
    else if ((r -= I_O) < I_GU) { W = a.in[17]; ldw = 5632; ncols = 5632; K = 1024; gain = a.in[16]; dst = (bf16*)(ws + WS_WGU0); perm = true; }
    else if ((r -= I_GU) < I_D) { W = a.in[18]; ldw = 1024; ncols = 1024; K = 2816; dst = (bf16*)(ws + WS_WD0); }
    else if ((r -= I_D) < I_Q1) { W = a.in[11]; ldw = 1024; ncols = 1024; K = 1024; gain = a.in[7] + 1024; dst = (bf16*)(ws + WS_WKVQ); }
    else if ((r -= I_Q1) < I_KV) { W = a.in[15]; ldw = 2048; ncols = 2048; K = 1024; gain = a.in[14]; dst = (bf16*)(ws + WS_WKVQ); roff = 1024; }
    else if ((r -= I_KV) < I_O) { W = a.in[13]; ldw = 1024; ncols = 1024; K = 1024; dst = (bf16*)(ws + WS_WO1); }
    else if ((r -= I_O) < I_GU) { W = a.in[17] + (size_t)1024 * 5632; ldw = 5632; ncols = 5632; K = 1024; gain = a.in[16] + 1024; dst = (bf16*)(ws + WS_WGU1); perm = true; }
    else { r -= I_GU; W = a.in[18] + (size_t)2816 * 1024; ldw = 1024; ncols = 1024; K = 2816; dst = (bf16*)(ws + WS_WD1); }
    const int nblk = ncols / 32, kb = r / nblk, nb = r % nblk, n0 = 32 * nb;
    int drow = roff + n0;
    if (perm) { drow = n0 < 2816 ? 256 * (n0 / 128) + (n0 % 128) : 256 * ((n0 - 2816) / 128) + 128 + ((n0 - 2816) % 128); }
    p0_transpose_item(W, ldw, n0, 64 * kb, gain, dst, K, drow, scr, lane);
}
constexpr int P0_FIRST = 16 * 96, P0_SECOND = P0_FIRST + 16 * 32 + 16 * 176 + 44 * 32 + 16 * 32 + 16 * 64;
constexpr int P0_NITEMS = 16 * 96 + 16 * 32 + 16 * 176 + 44 * 32 + 16 * 32 + 16 * 64 + 16 * 32 + 16 * 176 + 44 * 32;

__device__ __forceinline__ void p0_row_group(const KArgs& a, int g, const LAS unsigned char* wf, int lane) {
    const int fr = lane & 15, fq = lane >> 4;
    const int row = g * 16 + fr;
    const float* xr = (g < 1024 ? a.in[0] + (size_t)row * 1024 : a.in[1] + (size_t)(row - MP) * 1024) + 8 * fq;
    bf16* hb = (bf16*)(a.ws + WS_HB) + (size_t)row * 1024 + 8 * fq;
    f32x4 acc = {0.f, 0.f, 0.f, 0.f}; float ss = 0.f;
#pragma unroll 8
    for (int ks = 0; ks < 32; ++ks) {
        const f32x4 x0 = *(const f32x4*)(xr + 32 * ks), x1 = *(const f32x4*)(xr + 32 * ks + 4);
        ss += (x0[0] * x0[0] + x0[1] * x0[1]) + (x0[2] * x0[2] + x0[3] * x0[3]) + (x1[0] * x1[0] + x1[1] * x1[1]) + (x1[2] * x1[2] + x1[3] * x1[3]);
        v4u w; w.x = pk2(x0[0], x0[1]); w.y = pk2(x0[2], x0[3]); w.z = pk2(x1[0], x1[1]); w.w = pk2(x1[2], x1[3]);
        *(v4u*)(hb + 32 * ks) = w;
        const bf16x8 bfrag = *(const LAS bf16x8*)(wf + (ks * 64 + lane) * 16);
        acc = __builtin_amdgcn_mfma_f32_16x16x32_bf16(bfrag, __builtin_bit_cast(bf16x8, w), acc, 0, 0, 0);
    }
    ss += __shfl_xor(ss, 16); ss += __shfl_xor(ss, 32);
    float* ssp = (float*)(a.ws + WS_SSP) + (size_t)row * 16 + 4 * fq;
    *(f32x4*)ssp = (f32x4){fq == 0 ? ss : 0.f, 0.f, 0.f, 0.f};
    const float rstd = 1.0f / sqrtf(ss * (1.0f / 1024.0f) + 1e-6f);
    const f32x4 bf = *(const f32x4*)(a.in[9] + 4 * fq);
    f32x4 lf;
#pragma unroll
    for (int e = 0; e < 4; ++e) { const float z = acc[e] * rstd + bf[e]; lf[e] = fminf(z, 0.f) - log1pf(expf(-fabsf(z))); }
    float* lo = (g < 1024 ? a.out + O_ALFP + (size_t)row * 16 : a.out + O_ALFS + (size_t)(row - MP) * 16) + 4 * fq;
    *(f32x4*)lo = lf;
    if (g < 1024) {
#pragma unroll
        for (int o = 1; o < 16; o <<= 1) { lf[0] += __shfl_xor(lf[0], o); lf[1] += __shfl_xor(lf[1], o); lf[2] += __shfl_xor(lf[2], o); lf[3] += __shfl_xor(lf[3], o); }
        if (fr == 0) *(f32x4*)((float*)(a.ws + WS_GS) + g * 16 + 4 * fq) = lf;
    }
}

__device__ __forceinline__ void p1_scan(const KArgs& a, int v, LAS float* red, int tid) {
    const int batch = v >> 7, g0 = batch * 512, g1 = 4 * v, h = tid & 15, part = tid >> 4;
    const float* gs = (const float*)(a.ws + WS_GS);
    float s = 0.f;
    for (int g = g0 + part; g < g1; g += 32) s += gs[g * 16 + h];
    red[part * 16 + h] = s;
    __syncthreads();
    LAS float* lfs = red + 512;
    for (int e = tid; e < 1024; e += 512) lfs[e] = a.out[O_ALFP + (size_t)(64 * v) * 16 + e];
    __syncthreads();
    if (tid < 16) {
        float cum = 0.f;
        for (int p = 0; p < 32; ++p) cum += red[p * 16 + tid];
        bf16* kx = (bf16*)(a.ws + WS_KX) + ((size_t)(batch * 16 + tid) * 2 * SEQL) * 8;
        const int t0 = (64 * v) & (SEQL - 1);
#pragma unroll 8
        for (int r = 0; r < 64; ++r) {
            cum += lfs[r * 16 + tid];
            const float c = -cum * 1.4426950408889634f;
            const unsigned c1 = f2bf(c); const float r1 = c - bf2f((unsigned short)c1);
            const unsigned c2 = f2bf(r1); const float r2 = r1 - bf2f((unsigned short)c2);
            const unsigned c3 = f2bf(r2);
            *(v4u*)(kx + (size_t)(t0 + r) * 8) = (v4u){c1 | (c2 << 16), c3 | 0x3F800000u, 0x3F803F80u, 0u};
            *(v4u*)(kx + (size_t)(SEQL + t0 + r) * 8) = (v4u){0u, 0u, 0u, 0u};
        }
    }
    __syncthreads();
}

typedef float sf32x4 __attribute__((ext_vector_type(4)));
__device__ __forceinline__ bf16x8 pack8(const sf32x4 a, const sf32x4 b) {
    v4u w; w.x = attn_body::cvtpk_s(a[0], a[1]); w.y = attn_body::cvtpk_s(a[2], a[3]); w.z = attn_body::cvtpk_s(b[0], b[1]); w.w = attn_body::cvtpk_s(b[2], b[3]); return __builtin_bit_cast(bf16x8, w); }
template <int MODE> __device__ __forceinline__ void sample_attn(const KArgs& a, int b, int h, LAS unsigned char* lds, int tid) {
    constexpr int NC = MODE == 0 ? PAST : BPAST, NK = NC + 16, NKP = 1056, VRS = 80;
    constexpr float L2E = 1.4426950408889634f;
    LAS float* S = (LAS float*)lds;
    LAS float* bias = S + 16 * NKP;
    LAS float* rl = bias + NKP;
    LAS unsigned char* VT = (LAS unsigned char*)(rl + 16);
    const int lane = tid & 63, wid = __builtin_amdgcn_readfirstlane(tid >> 6), fr = lane & 15, fq = lane >> 4;
    const float* ck = a.in[MODE == 0 ? 2 : 5]; const float* cv = a.in[MODE == 0 ? 3 : 6];
    const float* nk = a.out + (MODE == 0 ? O_AKS + (size_t)(b * 16) * 1024 : O_BKS + (size_t)(b * 512 + 496) * 1024) + h * 64;
    const float* nv = a.out + (MODE == 0 ? O_AVS + (size_t)(b * 16) * 1024 : O_BVS + (size_t)(b * 512 + 496) * 1024) + h * 64;
    const bf16* qo = (const bf16*)(a.ws + WS_QO) + (size_t)(MP + b * 16) * 1024 + h * 64;
    const bf16x8 qf0 = *(const bf16x8*)(qo + (size_t)fr * 1024 + 8 * fq), qf1 = *(const bf16x8*)(qo + (size_t)fr * 1024 + 32 + 8 * fq);
    if (MODE == 0) {
        for (int j = tid; j < NK; j += 512) bias[j] = j < NC ? a.in[4][((size_t)b * NC + j) * 16 + h] : a.out[O_ALFS + (size_t)(b * 16 + (j - NC)) * 16 + h];
    } else {
        if (tid < 257) bias[tid] = a.in[12][h * 257 + tid] * L2E;
    }
    __syncthreads();
    if (MODE == 0) {
        if (wid == 0) { float carry = 0.f;
            for (int c = 0; c < (NK + 63) / 64; ++c) { const int j = 64 * c + lane; float v = j < NK ? bias[j] : 0.f;
#pragma unroll
                for (int o = 1; o < 64; o <<= 1) { const float t = __shfl_up(v, o); if (lane >= o) v += t; }
                v += carry; carry = __shfl(v, 63); if (j < NK) bias[j] = -v * L2E; } }
        __syncthreads();
    }
#pragma unroll 2
    for (int blk = wid; blk < NK / 16; blk += 8) {
        const int j0 = 16 * blk; const bool isnew = j0 >= NC;
        const float* kr = (isnew ? nk + (size_t)(j0 - NC + fr) * 1024 : ck + (((size_t)b * NC + j0 + fr) * 16 + h) * 64) + 8 * fq;
        const sf32x4 x0 = *(const sf32x4*)kr, x1 = *(const sf32x4*)(kr + 4), x2 = *(const sf32x4*)(kr + 32), x3 = *(const sf32x4*)(kr + 36);
        if (MODE == 1 && !isnew && j0 >= 16) { float* ok = a.out + O_BKS + (((size_t)b * 512 + (j0 + fr - 16)) * 16 + h) * 64 + 8 * fq;
            *(sf32x4*)ok = x0; *(sf32x4*)(ok + 4) = x1; *(sf32x4*)(ok + 32) = x2; *(sf32x4*)(ok + 36) = x3; }
        sf32x4 acc = {0.f, 0.f, 0.f, 0.f};
        acc = __builtin_amdgcn_mfma_f32_16x16x32_bf16(pack8(x0, x1), qf0, acc, 0, 0, 0);
        acc = __builtin_amdgcn_mfma_f32_16x16x32_bf16(pack8(x2, x3), qf1, acc, 0, 0, 0);
        if (MODE == 0) { const sf32x4 bv = *(const LAS sf32x4*)(bias + j0 + 4 * fq); acc = acc + bv;
            if (isnew) {
#pragma unroll
                for (int e = 0; e < 4; ++e) if (4 * fq + e > fr) acc[e] = -INFINITY; } }
        else {
#pragma unroll
            for (int e = 0; e < 4; ++e) { const int d = 512 + fr - (j0 + 4 * fq + e); acc[e] += bias[(d < 128 ? d : 128) + 128]; } }
        *(LAS sf32x4*)(S + fr * NKP + j0 + 4 * fq) = acc;
    }
    __syncthreads();
    for (int q = 2 * wid; q < 2 * wid + 2; ++q) { float m = -INFINITY;
        for (int j = lane; j < NK; j += 64) m = fmaxf(m, S[q * NKP + j]);
#pragma unroll
        for (int o = 1; o < 64; o <<= 1) m = fmaxf(m, __shfl_xor(m, o));
        float l = 0.f;
        for (int j = lane; j < NK; j += 64) { const float p = __builtin_amdgcn_exp2f(S[q * NKP + j] - m); S[q * NKP + j] = p; l += p; }
#pragma unroll
        for (int o = 1; o < 64; o <<= 1) l += __shfl_xor(l, o);
        if (lane == 0) rl[q] = 1.0f / l; }
    __syncthreads();
    { LAS unsigned char* vt = VT + wid * (64 * VRS);
        sf32x4 o[4];
#pragma unroll
        for (int db = 0; db < 4; ++db) o[db] = (sf32x4){0.f, 0.f, 0.f, 0.f};
        const int kr = lane >> 4, d4 = lane & 15;
        const int nit = NC / 256 + (wid == 7 ? 1 : 0);
        for (int it = 0; it < nit; ++it) {
            const bool isnew = it == NC / 256; const int c = isnew ? NC / 32 : wid + 8 * it;
            const int j0 = 32 * c; sf32x4 v4[8];
#pragma unroll
            for (int i = 0; i < 8; ++i) { const int key = 8 * (i >> 1) + 2 * kr + (i & 1);
                if (isnew) v4[i] = key < 16 ? *(const sf32x4*)(nv + (size_t)key * 1024 + 4 * d4) : (sf32x4){0.f, 0.f, 0.f, 0.f};
                else v4[i] = *(const sf32x4*)(cv + (((size_t)b * NC + j0 + key) * 16 + h) * 64 + 4 * d4); }
            if (MODE == 1 && !isnew) {
#pragma unroll
                for (int i = 0; i < 8; ++i) { const int j = j0 + 8 * (i >> 1) + 2 * kr + (i & 1); if (j >= 16) *(sf32x4*)(a.out + O_BVS + (((size_t)b * 512 + (j - 16)) * 16 + h) * 64 + 4 * d4) = v4[i]; } }
#pragma unroll
            for (int i = 0; i < 8; i += 2)
#pragma unroll
                for (int e = 0; e < 4; ++e) *(LAS unsigned*)(vt + (4 * d4 + e) * VRS + (8 * (i >> 1) + 2 * kr) * 2) = attn_body::cvtpk_s(v4[i][e], v4[i + 1][e]);
            bf16x8 pf;
            if (isnew && fq >= 2) pf = (bf16x8){0, 0, 0, 0, 0, 0, 0, 0};
            else { const sf32x4 p0 = *(const LAS sf32x4*)(S + fr * NKP + j0 + 8 * fq), p1 = *(const LAS sf32x4*)(S + fr * NKP + j0 + 8 * fq + 4); pf = pack8(p0, p1); }
#pragma unroll
            for (int db = 0; db < 4; ++db) { const bf16x8 vf = *(const LAS bf16x8*)(vt + (16 * db + fr) * VRS + fq * 16);
                o[db] = __builtin_amdgcn_mfma_f32_16x16x32_bf16(pf, vf, o[db], 0, 0, 0); }
        }
        LAS float* op = (LAS float*)vt;
#pragma unroll
        for (int db = 0; db < 4; ++db)
#pragma unroll
            for (int e = 0; e < 4; ++e) op[(4 * fq + e) * 64 + 16 * db + fr] = o[db][e]; }
    __syncthreads();
    for (int e = tid; e < 1024; e += 512) { const int q = e >> 6, d = e & 63; float o = 0.f;
#pragma unroll
        for (int w = 0; w < 8; ++w) o += ((const LAS float*)(VT + w * (64 * VRS)))[q * 64 + d];
        ((bf16*)(a.ws + WS_QO))[(size_t)(MP + b * 16 + q) * 1024 + h * 64 + d] = (bf16)f2bf(o * rl[q]); }
    __syncthreads();
}

#define RLX_AGENT __ATOMIC_RELAXED, __HIP_MEMORY_SCOPE_AGENT
#define XB_TMO      128
#define XB_XCNT(j)  (256  + 64 * (j))
#define XB_XSUB(j)  (1280 + 64 * (j))
#define XB_XGEN(j)  (2304 + 64 * (j))
#define XB_TOP      3328
#define XB_TOPGEN   3392
#define XCD_BAR_WORDS 3456
#define XB_SPIN_CAP (1u << 18)

__device__ __forceinline__ unsigned xb_ld(unsigned* p)              { return __hip_atomic_load(p, __ATOMIC_RELAXED, __HIP_MEMORY_SCOPE_AGENT); }
__device__ __forceinline__ unsigned xb_add(unsigned* p, unsigned v) { return __hip_atomic_fetch_add(p, v, __ATOMIC_RELAXED, __HIP_MEMORY_SCOPE_AGENT); }
__device__ __forceinline__ unsigned xb_xcc_id() { return (unsigned)__builtin_amdgcn_s_getreg((3 << 11) | 20) & 0xFu; }
#define XB_SPIN(cond, bar) do { unsigned _sp = 0; while (cond) { __builtin_amdgcn_s_sleep(1); \
    if ((++_sp & 255u) == 0u) { if (xb_ld(&(bar)[XB_TMO])) break; if (_sp > XB_SPIN_CAP) { atomicAdd(&(bar)[XB_TMO], 1u); break; } } } } while (0)

struct XcdBarrier {
    unsigned* bar; unsigned x;
    volatile LAS unsigned* st;
};

__device__ __forceinline__ XcdBarrier xcd_barrier_post(unsigned* bar, volatile LAS unsigned* st) {
    XcdBarrier b; b.bar = bar; b.x = xb_xcc_id(); b.st = st;
    if (threadIdx.x == 0) (void)xb_add(&bar[XB_XCNT(b.x)], 1u);
    return b;
}
__device__ __forceinline__ void xcd_barrier_complete(unsigned* bar, unsigned x, unsigned& nloc, unsigned& nx) {
    const unsigned G = gridDim.x * gridDim.y * gridDim.z;
    unsigned sum, cnt, mine, sp = 0u;
    for (;;) {
        sum = 0u; cnt = 0u; mine = 0u;
#pragma unroll
        for (unsigned j = 0; j < 16; ++j) { const unsigned c = xb_ld(&bar[XB_XCNT(j)]); sum += c; cnt += (c > 0u) ? 1u : 0u; mine = (j == x) ? c : mine; }
        if (sum == G) break;
        __builtin_amdgcn_s_sleep(1);
        if ((++sp & 255u) == 0u) { if (xb_ld(&bar[XB_TMO])) break; if (sp > XB_SPIN_CAP) { atomicAdd(&bar[XB_TMO], 1u); break; } }
    }
    nloc = mine > 0u ? mine : 1u; nx = cnt > 0u ? cnt : 1u;
}

__device__ __forceinline__ void xcd_barrier(const XcdBarrier& b) {
    asm volatile("s_waitcnt vmcnt(0)" ::: "memory");
    __syncthreads();
    if (threadIdx.x == 0) {
        unsigned* bar = b.bar;
        __builtin_amdgcn_s_waitcnt(0);
        unsigned nloc = b.st[0], nx = b.st[1];
        if (nloc == 0u) { xcd_barrier_complete(bar, b.x, nloc, nx); b.st[0] = nloc; b.st[1] = nx; }
        const unsigned old = xb_add(&bar[XB_XSUB(b.x)], 1u);
        const unsigned gen = old / nloc;
        if (old + 1u == (gen + 1u) * nloc) {
            __builtin_amdgcn_fence(__ATOMIC_RELEASE, "agent");
            asm volatile("s_waitcnt vmcnt(0)" ::: "memory");
            const unsigned og = xb_add(&bar[XB_TOP], 1u);
            const unsigned tg = og / nx;
            if (og + 1u == (tg + 1u) * nx) xb_add(&bar[XB_TOPGEN], 1u);
            else XB_SPIN(xb_ld(&bar[XB_TOPGEN]) == tg, bar);
            __builtin_amdgcn_fence(__ATOMIC_ACQUIRE, "agent");
            xb_add(&bar[XB_XGEN(b.x)], 1u);
            asm volatile("s_waitcnt vmcnt(0)" ::: "memory");
        } else {
            XB_SPIN(xb_ld(&bar[XB_XGEN(b.x)]) == gen, bar);
            __builtin_amdgcn_fence(__ATOMIC_ACQUIRE, "agent");
            asm volatile("s_waitcnt vmcnt(0)" ::: "memory");
        }
    }
    __syncthreads();
}

__device__ __forceinline__ KArgs load_args() {
#if !defined(__HIP_DEVICE_COMPILE__)
    return KArgs{};
#else
    auto p = __builtin_amdgcn_kernarg_segment_ptr(); asm volatile("" : "+s"(p)); return *(const __attribute__((address_space(4))) KArgs*)p;
#endif
}
__global__ void __launch_bounds__(NWAVES * 64, 2) fwd_mega(KArgs args_unused) {
    extern __shared__ __attribute__((aligned(16))) unsigned char lds[];
    LAS unsigned char* L = (LAS unsigned char*)lds;
    const int G = gridDim.x, bx = blockIdx.x, vcu = (G % 8 == 0) ? (bx % 8) * (G / 8) + bx / 8 : bx;
    int lo, hi; XcdBarrier xbar;
    { const KArgs a0 = load_args(); lo = a0.ph_lo; hi = a0.ph_hi;
      volatile LAS unsigned* st = (volatile LAS unsigned*)(L + RING_BYTES + 1024); if (threadIdx.x < 32) st[threadIdx.x] = 0u; __syncthreads();
      xbar = xcd_barrier_post((unsigned*)a0.ws + 4096, st); }
    if (hi > N_PHASES) cg::this_grid().sync();
#ifndef PHMASK
#define PHMASK 0xfff
#endif
#define IN(k) (((PHMASK >> (k)) & 1) && lo <= (k) && (k) < hi)
#define SEAM(k) do { if (IN(k) && IN((k) + 1)) { xcd_barrier(xbar); if ((PROBE_MASK >> 14) & 1) xcd_barrier(xbar); } } while (0)
#ifndef PROBE_MASK
#define PROBE_MASK 0
#endif
#define SEG_BEGIN(k) unsigned long long seg_t0_ = 0; if ((PROBE_MASK >> (k)) & 1) seg_t0_ = __builtin_amdgcn_s_memrealtime()
#define SEG_END(k) do { if ((PROBE_MASK >> (k)) & 1) { const unsigned long long t1_ = __builtin_amdgcn_s_memrealtime(), d_ = t1_ - seg_t0_; while (__builtin_amdgcn_s_memrealtime() - t1_ < d_) __builtin_amdgcn_s_sleep(8); } } while (0)
#define PHASE_ARGS() int tid = threadIdx.x; asm volatile("" : "+v"(tid)); const int lane = tid & 63, wave = __builtin_amdgcn_readfirstlane(tid >> 6); (void)lane; (void)wave; const KArgs args = load_args(); unsigned char* ws = args.ws; float* out = args.out; (void)out; \
    bf16* QO = (bf16*)(ws + WS_QO); bf16* KB = (bf16*)(ws + WS_KB); bf16* VB = (bf16*)(ws + WS_VB); bf16* HB = (bf16*)(ws + WS_HB); bf16* ACT = (bf16*)(ws + WS_ACT); (void)QO; (void)KB; (void)VB; (void)HB; (void)ACT
#define SSPN(i) ((float*)(ws + WS_SSP + (size_t)(i) * SSP_STRIDE))
#define SOFT_P(s_) ((unsigned*)ws + 8192 + 2048 * (s_))
#define SOFT_S(s_) ((unsigned*)ws + 8192 + 2048 * (s_) + 1088)
#define STW ((volatile LAS unsigned*)(L + RING_BYTES + 1024))
#define LARR ((LAS unsigned*)(L + RING_BYTES + 1024 + 64))

    if (IN(0)) {
        PHASE_ARGS();
        SEG_BEGIN(0);
        LAS unsigned char* wf = L + 98304;
        for (int e = tid; e < 32 * 64; e += NWAVES * 64) { const int ks = e >> 6, ln = e & 63, h = ln & 15, kq = ln >> 4, k0 = 32 * ks + 8 * kq; float v[8];
#pragma unroll
            for (int i = 0; i < 8; ++i) v[i] = args.in[8][(size_t)(k0 + i) * 3088 + 3072 + h] * args.in[7][k0 + i];
            *(LAS v4u*)(wf + e * 16) = (v4u){pk2(v[0], v[1]), pk2(v[2], v[3]), pk2(v[4], v[5]), pk2(v[6], v[7])}; }
        __syncthreads();
        { const int g = wave * G + vcu; if (g < MT / 16) p0_row_group(args, g, wf, lane); }
        LAS float* scr = (LAS float*)(L + wave * 8704);
        const int gw = vcu * NWAVES + wave, NGW = G * NWAVES;
        for (int it = gw; it < P0_FIRST; it += NGW) p0_weight_item(args, it, scr, lane);
        SEG_END(0);
    }
    SEAM(0);
    if (IN(1)) {
        PHASE_ARGS();
        SEG_BEGIN(1);
        p1_scan(args, vcu, (LAS float*)L, tid);
        pg8::Gemm g{HB, (const bf16*)(ws + WS_WQKV0), MT, 3072, 1024}; pg8::StaticOrder S; S.init(MT, 3072, G, bx);
        pg8::EpiQKV E{QO, KB, VB, out + O_AKP, out + O_AVP, out + O_AKS, out + O_AVS, SSPN(0), 0, attn_body::C2};
        pg8::gemm_phase<pg8::EpiQKV, pg8::StaticOrder, PG8_ALIGN, PG8_SP2>(L, g, S, E);
        { const int n4 = (MT / 256) * 12 - 3 * G;
          if (n4 >= 0 && n4 < G && bx >= n4) { LAS float* scr = (LAS float*)(L + wave * 8704); const int cw = (bx - n4) * NWAVES + wave, ncw = (G - n4) * NWAVES;
              for (int it = P0_FIRST + cw; it < P0_SECOND; it += ncw) p0_weight_item(args, it, scr, lane); } }
        SEG_END(1);
    }
    SEAM(1);
    if (IN(2)) {
        PHASE_ARGS();
        SEG_BEGIN(2);
        const attn_body::AttnTensors AT{(const attn_body::bf16*)QO, (const attn_body::bf16*)KB, (const attn_body::bf16*)VB, (attn_body::bf16*)QO, (const attn_body::bf16*)(ws + WS_KX), args.in[12]};
        const attn_body::StaticOrder S(G, bx);
        const int ssl = vcu % 5;
        attn_body::attn_phase<0, attn_body::StaticOrder>((char*)lds, AT, S, 0, ssl);
        { SEG_BEGIN(12); for (int i = 0; i < 2; ++i) { const int u = 2 * vcu + i; if (u < DECB * NH) sample_attn<0>(args, u >> 4, u & 15, L, tid); } SEG_END(12); }
        attn_body::attn_phase<0, attn_body::StaticOrder>((char*)lds, AT, S, ssl, 4);
        SEG_END(2);
    }
    SEAM(2);
    if (IN(3)) {
        PHASE_ARGS();
        SEG_BEGIN(3);
        pg8::Gemm g{QO, (const bf16*)(ws + WS_WO0), MT, 1024, 1024}; pg8::FlexOrder S; S.init(4, G, bx, 0, 0); S.arrP = SOFT_P(0); S.arrS = SOFT_S(0); S.larr = LARR; S.stw = STW;
        pg8::EpiRes E{args.in[0], args.in[1], out, HB, SSPN(1)};
        pg8::gemm_phase<pg8::EpiRes, pg8::FlexOrder, PG8_ALIGN, PG8_SP2>(L, g, S, E);
        SEG_END(3);
    }
    if (IN(4)) {
        PHASE_ARGS();
        SEG_BEGIN(4);
        pg8::Gemm g{HB, (const bf16*)(ws + WS_WGU0), MT, 5632, 1024}; pg8::FlexOrder S; S.init(22, G, bx, 0, 0, 176);     S.waitP = SOFT_P(0) + 1024; S.waitS = SOFT_S(0); S.tgtP = STW[1]; S.tgtS = 8u;
        pg8::EpiSwiGLU E{ACT, SSPN(1)};
        pg8::gemm_phase<pg8::EpiSwiGLU, pg8::FlexOrder, PG8_ALIGN, PG8_SP2>(L, g, S, E);
        SEG_END(4);
    }
    SEAM(4);
    if (IN(5)) {
        PHASE_ARGS();
        SEG_BEGIN(5);
        pg8::Gemm g{ACT, (const bf16*)(ws + WS_WD0), MT, 1024, 2816}; pg8::FlexOrder S; S.init(4, G, bx, 0, 0); S.arrP = SOFT_P(1); S.arrS = SOFT_S(1); S.larr = LARR; S.stw = STW;
        pg8::EpiRes E{out, out + (size_t)MP * 1024, out, HB, SSPN(2)};
        pg8::gemm_phase<pg8::EpiRes, pg8::FlexOrder, PG8_ALIGN, PG8_SP2>(L, g, S, E);
        SEG_END(5);
    }
    if (IN(6)) {
        PHASE_ARGS();
        SEG_BEGIN(6);
        pg8::Gemm g{HB, (const bf16*)(ws + WS_WKVQ), MT, 3072, 1024}; pg8::FlexOrder S; S.init(12, G, bx, 8, 1); S.waitP = SOFT_P(1) + 1024; S.waitS = SOFT_S(1); S.tgtP = STW[1]; S.tgtS = 8u;
        pg8::EpiQKV E{QO, KB, VB, out + O_BKP, out + O_BVP, out + O_BKS, out + O_BVS, SSPN(2), 1, attn_body::C2};
        pg8::gemm_phase<pg8::EpiQKV, pg8::FlexOrder, PG8_ALIGN, PG8_SP2>(L, g, S, E);
        { const int n4 = 8 + (784 - 3 * (G - 8));
          if (n4 >= 0 && n4 < G && bx >= n4) { LAS float* scr = (LAS float*)(L + wave * 8704); const int cw = (bx - n4) * NWAVES + wave, ncw = (G - n4) * NWAVES;
              for (int it = P0_SECOND + cw; it < P0_NITEMS; it += ncw) p0_weight_item(args, it, scr, lane); } }
        SEG_END(6);
    }
    SEAM(6);
    if (IN(7)) {
        PHASE_ARGS();
        SEG_BEGIN(7);
        const attn_body::AttnTensors AT{(const attn_body::bf16*)QO, (const attn_body::bf16*)KB, (const attn_body::bf16*)VB, (attn_body::bf16*)QO, (const attn_body::bf16*)(ws + WS_KX), args.in[12]};
        const attn_body::StaticOrder S(G, bx);
        const int ssl = vcu % 5;
        attn_body::attn_phase<1, attn_body::StaticOrder>((char*)lds, AT, S, 0, ssl);
        { SEG_BEGIN(13); for (int i = 0; i < 2; ++i) { const int u = 2 * vcu + i; if (u < DECB * NH) sample_attn<1>(args, u >> 4, u & 15, L, tid); } SEG_END(13); }
        attn_body::attn_phase<1, attn_body::StaticOrder>((char*)lds, AT, S, ssl, 4);
        SEG_END(7);
    }
    SEAM(7);
    if (IN(8)) {
        PHASE_ARGS();
        SEG_BEGIN(8);
        pg8::Gemm g{QO, (const bf16*)(ws + WS_WO1), MT, 1024, 1024}; pg8::FlexOrder S; S.init(4, G, bx, 0, 0); S.arrP = SOFT_P(2); S.arrS = SOFT_S(2); S.larr = LARR; S.stw = STW;
        pg8::EpiRes E{out, out + (size_t)MP * 1024, out, HB, SSPN(3)};
        pg8::gemm_phase<pg8::EpiRes, pg8::FlexOrder, PG8_ALIGN, PG8_SP2>(L, g, S, E);
        SEG_END(8);
    }
    if (IN(9)) {
        PHASE_ARGS();
        SEG_BEGIN(9);
        pg8::Gemm g{HB, (const bf16*)(ws + WS_WGU1), MT, 5632, 1024}; pg8::GuDeal S; S.init2(G, bx, 192); S.waitP = SOFT_P(2) + 1024; S.waitS = SOFT_S(2); S.tgtP = STW[1]; S.tgtS = 8u; S.arrS = SOFT_S(4); S.larr = LARR; S.stw = STW;
        pg8::EpiSwiGLU E{ACT, SSPN(3)};
        pg8::gemm_phase<pg8::EpiSwiGLU, pg8::GuDeal, PG8_ALIGN, PG8_SP2>(L, g, S, E);
        if (S.cp >= 248) {
            pg8::Gemm g2{ACT, (const bf16*)(ws + WS_WD1), MT, 1024, 2816}; pg8::OneUnitOrder S2{64 + (S.cp - 248) / 4, (S.cp - 248) % 4, SOFT_S(4), 44u};
            pg8::EpiRes E2{out, out + (size_t)MP * 1024, out, HB, SSPN(4)};
            pg8::gemm_phase<pg8::EpiRes, pg8::OneUnitOrder, PG8_ALIGN, PG8_SP2>(L, g2, S2, E2); }
        SEG_END(9);
    }
    SEAM(9);
    if (IN(10)) {
        PHASE_ARGS();
        SEG_BEGIN(10);
        pg8::Gemm g{ACT, (const bf16*)(ws + WS_WD1), MT, 1024, 2816}; pg8::FlexOrder S; S.init(4, G, bx, 0, 0); S.nmain = 256;
        pg8::EpiRes E{out, out + (size_t)MP * 1024, out, HB, SSPN(4)};
        pg8::gemm_phase<pg8::EpiRes, pg8::FlexOrder, PG8_ALIGN, PG8_SP2>(L, g, S, E);
        SEG_END(10);
    }
    SEAM(10);
    if (IN(11)) {
        PHASE_ARGS();
        SEG_BEGIN(11);
        const int gw = vcu * NWAVES + wave, NGW = G * NWAVES; const float* gf = args.in[19]; const float* ssp = SSPN(4);
        f32x4 gv[4];
#pragma unroll
        for (int j = 0; j < 4; ++j) gv[j] = *(const f32x4*)(gf + 256 * j + 4 * lane);
        for (int m = gw; m < MT; m += NGW) {
            float s = 0.f;
#pragma unroll
            for (int j = 0; j < 4; ++j) { const f32x4 p = *(const f32x4*)(ssp + (size_t)m * 16 + 4 * j); s += (p[0] + p[1]) + (p[2] + p[3]); }
            const float rstd = 1.0f / sqrtf(s * (1.0f / 1024.0f) + 1e-6f);
            float* r = out + (size_t)m * 1024 + 4 * lane;
#pragma unroll
            for (int j = 0; j < 4; ++j) { f32x4 v = *(f32x4*)(r + 256 * j); v = v * rstd * gv[j]; *(f32x4*)(r + 256 * j) = v; }
        }
        SEG_END(11);
    }
#undef IN
#undef SEAM
}

extern "C" void kernel_launch(void* const* d_in, const int* in_sizes, int n_in, void* d_out, int out_size, void* d_ws, size_t ws_size, hipStream_t stream) {
    static int grid = 0;
    if (grid == 0) {
        if (n_in != 20 || (size_t)out_size != O_END || ws_size < WS_END) { fprintf(stderr, "kernel_launch: unexpected shapes (n_in %d out %d ws %zu)\n", n_in, out_size, ws_size); grid = -1; return; }
        int dev = 0, cus = 0, per_cu = 0;
        hipGetDevice(&dev); hipDeviceGetAttribute(&cus, hipDeviceAttributeMultiprocessorCount, dev);
        if (hipFuncSetAttribute((const void*)fwd_mega, hipFuncAttributeMaxDynamicSharedMemorySize, LDS_BYTES) != hipSuccess) { fprintf(stderr, "kernel_launch: hipFuncSetAttribute failed\n"); grid = -1; return; }
        if (hipOccupancyMaxActiveBlocksPerMultiprocessor(&per_cu, (const void*)fwd_mega, NWAVES * 64, LDS_BYTES) != hipSuccess || per_cu < 1) { fprintf(stderr, "kernel_launch: occupancy query says %d\n", per_cu); per_cu = 1; }
        (void)hipGetLastError();
        grid = cus * per_cu;
        if (grid != 256) fprintf(stderr, "kernel_launch: grid %d (expected 256)\n", grid);
    }
    if (grid < 0) return;
    if (hipMemsetAsync(d_ws, 0, 131072, stream) != hipSuccess) { fprintf(stderr, "kernel_launch: memset failed\n"); return; }
    KArgs a{};
    for (int i = 0; i < 20; ++i) a.in[i] = (const float*)d_in[i];
    a.out = (float*)d_out; a.ws = (unsigned char*)d_ws;
#if MK_PER_PHASE
    for (int p = 0; p < N_PHASES; ++p) { a.ph_lo = p; a.ph_hi = p + 1; void* kargs[] = {&a};
        hipError_t e = hipLaunchCooperativeKernel((const void*)fwd_mega, dim3(grid), dim3(NWAVES * 64), kargs, LDS_BYTES, stream);
        if (e != hipSuccess) { fprintf(stderr, "kernel_launch: launch %d failed: %s\n", p, hipGetErrorString(e)); break; } }
#else
    a.ph_lo = 0; a.ph_hi = N_PHASES; void* kargs[] = {&a};
    hipError_t e = hipLaunchCooperativeKernel((const void*)fwd_mega, dim3(grid), dim3(NWAVES * 64), kargs, LDS_BYTES, stream);
    if (e != hipSuccess) fprintf(stderr, "kernel_launch: cooperative launch failed: %s (grid %d)\n", hipGetErrorString(e), grid);
#endif
}
```
